# Optimizing an MI355X kernel written in HIP

```python
import jax, jax.numpy as jnp
from jax import lax
import numpy as np

D_MODEL = 2048
BATCH = 1
SEQ = 8192
DEPTH = 2

GRID_W = 64
CTX_LEN = 256
N_HEADS_NA = 8
HEAD_DIM = 128
D_NA = N_HEADS_NA * HEAD_DIM
WIN_R = 8
WIN_C = 16
N_FOURIER_GROUPS = 4
FOURIER_GROUP = 128
D_FOURIER = N_FOURIER_GROUPS * FOURIER_GROUP
D_CONV = 512
CONV_WIDTH = 31
D_FF = 5632
D_IN = 3 * D_NA + D_FOURIER + 2 * D_CONV
N_BRANCH = 3
N_MOD = 9
ALPHA = (2 * DEPTH) ** 0.25
BETA = (8 * DEPTH) ** -0.25
LN_EPS = 1e-5
NEG_INF = -1e30

kernel_name = "hybrid_na_fnet_conformer_diffusion_block"


def layer_norm(x, g, b):
    xf = x.astype(jnp.float32)
    mu = xf.mean(-1, keepdims=True)
    var = jnp.square(xf - mu).mean(-1, keepdims=True)
    y = (xf - mu) * lax.rsqrt(var + LN_EPS)
    return (y * g.astype(jnp.float32) + b.astype(jnp.float32)).astype(x.dtype)


def modulate(x, shift, scale):
    return x * (1 + scale) + shift


def swiglu(h, w1, w3, w2):
    return (jax.nn.silu(h @ w1) * (h @ w3)) @ w2


def ffn_sublayer(z, m, j, w1, w3, w2, g, b):
    h = modulate(z, m[:, :, 3 * j], m[:, :, 3 * j + 1])
    y = swiglu(h, w1, w3, w2)
    return layer_norm(ALPHA * z + 0.5 * m[:, :, 3 * j + 2] * y, g, b)


def split_in(z):
    b_, n, _ = z.shape
    heads = lambda t: t.reshape(b_, n, N_HEADS_NA, HEAD_DIM)
    q = heads(z[..., 0:D_NA])
    k = heads(z[..., D_NA:2 * D_NA])
    v = heads(z[..., 2 * D_NA:3 * D_NA])
    o = 3 * D_NA
    f = z[..., o:o + D_FOURIER]
    o += D_FOURIER
    a = z[..., o:o + D_CONV]
    g = z[..., o + D_CONV:o + 2 * D_CONV]
    return q, k, v, f, a, g


def fourier_mix(f):
    b_, n, _ = f.shape
    fg = f.astype(jnp.float32).reshape(b_, n, N_FOURIER_GROUPS, FOURIER_GROUP)
    out = jnp.fft.fft2(fg, axes=(1, 3), norm="ortho").real
    return out.reshape(b_, n, D_FOURIER).astype(f.dtype)


def conv_module(a, g, w_dw, b_dw, ln_g, ln_b):
    u = a * jax.nn.sigmoid(g)
    y = lax.conv_general_dilated(
        u, w_dw[:, None, :], window_strides=(1,),
        padding=[(CONV_WIDTH // 2, CONV_WIDTH // 2)],
        dimension_numbers=("NWC", "WIO", "NWC"),
        feature_group_count=D_CONV)
    y = y + b_dw
    return jax.nn.silu(layer_norm(y, ln_g, ln_b))


def neighbourhood_attention(q, k, v, k_ctx, v_ctx, rpb):
    b_, n, h_, dh = q.shape
    rows = n // GRID_W
    wr = min(WIN_R, rows)
    scale = dh ** -0.5

    def grid(t):
        return t.reshape(b_, rows, GRID_W, h_, dh).transpose(0, 3, 1, 2, 4)

    qg, kg, vg = grid(q), grid(k), grid(v)
    r = jnp.arange(rows)
    r0 = jnp.clip(r - wr // 2, 0, rows - wr)
    row_idx = r0[:, None] + jnp.arange(wr)[None, :]
    n_band = wr * GRID_W
    k_band = kg[:, :, row_idx].reshape(b_, h_, rows, n_band, dh)
    v_band = vg[:, :, row_idx].reshape(b_, h_, rows, n_band, dh)

    cq = jnp.arange(GRID_W)
    c0 = jnp.clip(cq - WIN_C // 2, 0, GRID_W - WIN_C)
    col_ok = (cq[None, :] >= c0[:, None]) & (cq[None, :] < c0[:, None] + WIN_C)
    dc_i = jnp.clip(cq[None, :] - cq[:, None], -(WIN_C - 1), WIN_C - 1) + WIN_C - 1
    dr_i = row_idx - r[:, None] + WIN_R - 1
    bias = rpb.astype(jnp.float32)[:, dr_i[:, :, None, None], dc_i[None, None, :, :]]
    bias = jnp.where(col_ok[None, None, None], bias, NEG_INF)
    bias = bias.transpose(0, 1, 3, 2, 4).reshape(h_, rows, GRID_W, n_band)

    s_lat = jnp.einsum('bhrqd,bhrkd->bhrqk', qg, k_band,
                       preferred_element_type=jnp.float32) * scale + bias[None]
    s_ctx = jnp.einsum('bhrqd,bchd->bhrqc', qg, k_ctx,
                       preferred_element_type=jnp.float32) * scale
    p = jax.nn.softmax(jnp.concatenate([s_lat, s_ctx], axis=-1), axis=-1)
    p_lat = p[..., :n_band].astype(v.dtype)
    p_ctx = p[..., n_band:].astype(v.dtype)
    o = (jnp.einsum('bhrqk,bhrkd->bhrqd', p_lat, v_band)
         + jnp.einsum('bhrqc,bchd->bhrqd', p_ctx, v_ctx))
    return o.transpose(0, 2, 3, 1, 4).reshape(b_, n, h_ * dh)


def context_attention(q, k, v):
    b_, n, h_, dh = q.shape
    s = jnp.einsum('bqhd,bkhd->bhqk', q, k, preferred_element_type=jnp.float32) * (dh ** -0.5)
    p = jax.nn.softmax(s, axis=-1).astype(v.dtype)
    return jnp.einsum('bhqk,bkhd->bqhd', p, v).reshape(b_, n, h_ * dh)


def merge_branches(h, y_na, y_f, y_c, w_gate, b_gate, w_b_na, w_b_f, w_b_c, w_o):
    b_, n, _ = h.shape
    gates = jax.nn.sigmoid(h @ w_gate + b_gate).reshape(b_, n, N_BRANCH, D_MODEL)
    m = (gates[:, :, 0] * (y_na @ w_b_na)
         + gates[:, :, 1] * (y_f @ w_b_f)
         + gates[:, :, 2] * (y_c @ w_b_c))
    return m @ w_o


def setup_inputs(seed: int = 0) -> dict:
    key = jax.random.key(seed)
    ks = jax.random.split(key, 32)
    nrm = lambda k, shape, s: jax.random.normal(k, shape, jnp.float32) * s
    L = DEPTH
    return {
        "x": nrm(ks[0], (BATCH, SEQ, D_MODEL), 1.0),
        "c": nrm(ks[1], (BATCH, D_MODEL), 1.0),
        "ctx": nrm(ks[2], (BATCH, CTX_LEN, D_MODEL), 1.0),
        "c_ctx": nrm(ks[3], (D_MODEL,), 1.0),
        "w_ada": nrm(ks[4], (L, D_MODEL, N_MOD * D_MODEL), 0.5 * D_MODEL ** -0.5),
        "b_ada": nrm(ks[5], (L, N_MOD * D_MODEL), 0.02),
        "ffn1_w1": nrm(ks[6], (L, D_MODEL, D_FF), D_MODEL ** -0.5),
        "ffn1_w3": nrm(ks[7], (L, D_MODEL, D_FF), D_MODEL ** -0.5),
        "ffn1_w2": nrm(ks[8], (L, D_FF, D_MODEL), BETA * D_FF ** -0.5),
        "ffn2_w1": nrm(ks[9], (L, D_MODEL, D_FF), D_MODEL ** -0.5),
        "ffn2_w3": nrm(ks[10], (L, D_MODEL, D_FF), D_MODEL ** -0.5),
        "ffn2_w2": nrm(ks[11], (L, D_FF, D_MODEL), BETA * D_FF ** -0.5),
        "w_in": nrm(ks[12], (L, D_MODEL, D_IN), D_MODEL ** -0.5),
        "w_dw": nrm(ks[13], (L, CONV_WIDTH, D_CONV), CONV_WIDTH ** -0.5),
        "b_dw": nrm(ks[14], (L, D_CONV), 0.02),
        "conv_ln_g": 1.0 + nrm(ks[15], (L, D_CONV), 0.02),
        "conv_ln_b": nrm(ks[16], (L, D_CONV), 0.02),
        "rpb": nrm(ks[17], (L, N_HEADS_NA, 2 * WIN_R - 1, 2 * WIN_C - 1), 0.1),
        "w_gate": nrm(ks[18], (L, D_MODEL, N_BRANCH * D_MODEL), D_MODEL ** -0.5),
        "b_gate": nrm(ks[19], (L, N_BRANCH * D_MODEL), 0.02),
        "w_b_na": nrm(ks[20], (L, D_NA, D_MODEL), BETA * D_NA ** -0.5),
        "w_b_f": nrm(ks[21], (L, D_FOURIER, D_MODEL), BETA * D_FOURIER ** -0.5),
        "w_b_c": nrm(ks[22], (L, D_CONV, D_MODEL), BETA * D_CONV ** -0.5),
        "w_o": nrm(ks[23], (L, D_MODEL, D_MODEL), BETA * D_MODEL ** -0.5),
        "ln_g": 1.0 + nrm(ks[24], (L, 3, D_MODEL), 0.02),
        "ln_b": nrm(ks[25], (L, 3, D_MODEL), 0.02),
    }


def reference(x, c, ctx, c_ctx, w_ada, b_ada, ffn1_w1, ffn1_w3, ffn1_w2, ffn2_w1, ffn2_w3, ffn2_w2,
              w_in, w_dw, b_dw, conv_ln_g, conv_ln_b, rpb, w_gate, b_gate, w_b_na, w_b_f, w_b_c,
              w_o, ln_g, ln_b):
    b_ = x.shape[0]
    xc = ctx
    for l in range(DEPTH):
        last = l == DEPTH - 1
        mod = (jax.nn.silu(c) @ w_ada[l] + b_ada[l]).reshape(b_, 1, N_MOD, D_MODEL)
        modc = (jax.nn.silu(c_ctx) @ w_ada[l] + b_ada[l]).reshape(1, 1, N_MOD, D_MODEL)

        x = ffn_sublayer(x, mod, 0, ffn1_w1[l], ffn1_w3[l], ffn1_w2[l], ln_g[l, 0], ln_b[l, 0])
        xc = ffn_sublayer(xc, modc, 0, ffn1_w1[l], ffn1_w3[l], ffn1_w2[l], ln_g[l, 0], ln_b[l, 0])

        h = modulate(x, mod[:, :, 3], mod[:, :, 4])
        hc = modulate(xc, modc[:, :, 3], modc[:, :, 4])
        q, k, v, f, a, g = split_in(h @ w_in[l])
        if last:
            kv_c = (hc @ w_in[l][:, D_NA:3 * D_NA]).reshape(b_, -1, 2, N_HEADS_NA, HEAD_DIM)
            kc, vc = kv_c[:, :, 0], kv_c[:, :, 1]
        else:
            qc, kc, vc, fc, ac, gc = split_in(hc @ w_in[l])

        y_na = neighbourhood_attention(q, k, v, kc, vc, rpb[l])
        y_f = fourier_mix(f)
        y_c = conv_module(a, g, w_dw[l], b_dw[l], conv_ln_g[l], conv_ln_b[l])
        out = merge_branches(h, y_na, y_f, y_c, w_gate[l], b_gate[l], w_b_na[l], w_b_f[l], w_b_c[l], w_o[l])
        x = layer_norm(ALPHA * x + mod[:, :, 5] * out, ln_g[l, 1], ln_b[l, 1])

        if not last:
            yc_na = context_attention(qc, kc, vc)
            yc_f = fourier_mix(fc)
            yc_c = conv_module(ac, gc, w_dw[l], b_dw[l], conv_ln_g[l], conv_ln_b[l])
            outc = merge_branches(hc, yc_na, yc_f, yc_c, w_gate[l], b_gate[l], w_b_na[l], w_b_f[l], w_b_c[l], w_o[l])
            xc = layer_norm(ALPHA * xc + modc[:, :, 5] * outc, ln_g[l, 1], ln_b[l, 1])

        x = ffn_sublayer(x, mod, 1, ffn2_w1[l], ffn2_w3[l], ffn2_w2[l], ln_g[l, 2], ln_b[l, 2])
        if not last:
            xc = ffn_sublayer(xc, modc, 1, ffn2_w1[l], ffn2_w3[l], ffn2_w2[l], ln_g[l, 2], ln_b[l, 2])
    return x
```

```cpp
#include <hip/hip_runtime.h>
#include <cstdio>
#include <cstdint>

#ifndef MK_DIAG
#define MK_DIAG 0
#endif
#ifndef MK_PER_PHASE
#define MK_PER_PHASE 0
#endif

namespace pg8 {
#define PG8_LAS __attribute__((address_space(3)))
typedef unsigned short bf16_t;
typedef short bf16x8 __attribute__((ext_vector_type(8)));
typedef float f32x4 __attribute__((ext_vector_type(4)));
typedef unsigned u32x4 __attribute__((ext_vector_type(4)));
constexpr int BM = 256, BK = 64, HALF = 128, HTB = HALF * BK * 2  , STAGE_BYTES = 8 * HTB, NXCD = 8, WGM = 8;

__host__ __device__ __forceinline__ int lds_byte(int r, int c) { const int st = (r >> 4) * 2 + (c >> 5), rr = r & 15, cc = c & 31, ob = rr * 64 + cc * 2; return st * 1024 + (ob ^ (((ob >> 9) & 1) << 5)); }
__host__ __device__ __forceinline__ void stage_rc(int b, int& R, int& C) { const int st = b / 1024, sb = b % 1024, swz = sb ^ (((sb >> 9) & 1) << 5); R = (st >> 1) * 16 + swz / 64; C = (st & 1) * 32 + (swz % 64) / 2; }
__host__ __device__ __forceinline__ int perm32(int rho) { const int n = rho >> 4, i = rho & 15; return 8 * (i >> 2) + 4 * n + (i & 3); }

struct Unit { int pm, pn; };
struct Gemm { const bf16_t* A; const bf16_t* Bt; int lda, ldb, K; };

struct StaticOrder {
    int nM, nN, nwg, G, c;
    __host__ __device__ void init(int nM_, int nN_, int G_, int c_) { nM = nM_; nN = nN_; nwg = nM * nN; G = G_; c = c_; }
    __host__ __device__ bool next(int i, Unit& u) const {
        const long L = (long)i * G + c; if (L >= nwg) return false;
        int wgid = (int)L; { const int q = nwg / NXCD, r = nwg % NXCD, xcd = wgid % NXCD, off = wgid / NXCD; wgid = (xcd < r ? xcd * (q + 1) : r * (q + 1) + (xcd - r) * q) + off; }
        const int nig = WGM * nN, gid = wgid / nig, fm = gid * WGM, gsz = (nM - fm) < WGM ? (nM - fm) : WGM;
        u.pm = fm + ((wgid % nig) % gsz); u.pn = (wgid % nig) / gsz; return true;
    }
    __device__ __forceinline__ void a_ready(const Unit&) const {}
    __device__ __forceinline__ void done(const Unit&) const {}
};

typedef float f32x2_t __attribute__((ext_vector_type(2))); typedef __bf16 bf16x2_t __attribute__((ext_vector_type(2)));
__device__ __forceinline__ unsigned cvt_pk_bf16(float lo, float hi) { const f32x2_t v = {lo, hi}; const bf16x2_t b = __builtin_convertvector(v, bf16x2_t); return __builtin_bit_cast(unsigned, b); }
__device__ __forceinline__ float sigmoid_f(float x) { return __builtin_amdgcn_rcpf(1.0f + __builtin_amdgcn_exp2f(-1.4426950408889634f * x)); }
__device__ __forceinline__ float bf_lo(unsigned w) { return __builtin_bit_cast(float, w << 16); }
__device__ __forceinline__ float bf_hi(unsigned w) { return __builtin_bit_cast(float, w & 0xffff0000u); }
constexpr int CTX_PM = 32;

struct EpiSwiGLU {
    static constexpr bool PERM = true, AFTER_DRAIN = false, MIDK = false; static constexpr int T1 = 0, T2 = 0;
    bf16_t* O; int ldc;
    __device__ __forceinline__ void mid(f32x4 (&)[2][2][4][2], const Unit&, int, int, int, int, int) const {}
    __device__ __forceinline__ void operator()(const f32x4 (&acc)[2][2][4][2], const Unit& u, int wr, int wc, int fr, int fq) const {
        const int row0 = u.pm * BM + wr * 64 + fr, col0 = u.pn * HALF + wc * 32 + 8 * fq;
#pragma unroll
        for (int ai = 0; ai < 2; ++ai)
#pragma unroll
            for (int m = 0; m < 4; ++m) {
                bf16_t* rowp = O + (size_t)(row0 + ai * HALF + m * 16) * ldc + col0;
                float g[8];
#pragma unroll
                for (int n = 0; n < 2; ++n)
#pragma unroll
                    for (int j = 0; j < 4; ++j) { const float a = acc[ai][0][m][n][j], b = acc[ai][1][m][n][j]; g[n * 4 + j] = a * sigmoid_f(a) * b; }
                u32x4 w; w.x = cvt_pk_bf16(g[0], g[1]); w.y = cvt_pk_bf16(g[2], g[3]); w.z = cvt_pk_bf16(g[4], g[5]); w.w = cvt_pk_bf16(g[6], g[7]);
                *(u32x4*)rowp = w; }
    }
};
struct EpiResid {
    static constexpr bool PERM = false, AFTER_DRAIN = false, MIDK = false; static constexpr int T1 = 0, T2 = 0;
    const float* X; float* T; int ldc; const float* gate_lat; const float* gate_ctx; float gmul, alpha;
    __device__ __forceinline__ void mid(f32x4 (&)[2][2][4][2], const Unit&, int, int, int, int, int) const {}
    __device__ __forceinline__ void operator()(const f32x4 (&acc)[2][2][4][2], const Unit& u, int wr, int wc, int fr, int fq) const {
        const int row0 = u.pm * BM + wr * 64 + fr, col0 = u.pn * BM + wc * 32 + 4 * fq;
        const float* gv = (u.pm >= CTX_PM) ? gate_ctx : gate_lat;
        f32x4 gg[2][2];
#pragma unroll
        for (int bj = 0; bj < 2; ++bj)
#pragma unroll
            for (int n = 0; n < 2; ++n) gg[bj][n] = *(const f32x4*)(gv + col0 + bj * HALF + n * 16) * gmul;
#pragma unroll
        for (int ai = 0; ai < 2; ++ai)
#pragma unroll
            for (int m = 0; m < 4; ++m) { const size_t off = (size_t)(row0 + ai * HALF + m * 16) * ldc + col0;
#pragma unroll
                for (int bj = 0; bj < 2; ++bj)
#pragma unroll
                    for (int n = 0; n < 2; ++n) { const f32x4 xv = *(const f32x4*)(X + off + bj * HALF + n * 16);
                        *(f32x4*)(T + off + bj * HALF + n * 16) = xv * alpha + acc[ai][bj][m][n] * gg[bj][n]; }
                if (m & 1) asm volatile("" ::: "memory"); }
    }
};
template <int ACT> struct EpiBf16 {
    static constexpr bool PERM = true, AFTER_DRAIN = false, MIDK = false; static constexpr int T1 = 0, T2 = 0;
    bf16_t* O; int ldc; const float* bias;
    __device__ __forceinline__ void mid(f32x4 (&)[2][2][4][2], const Unit&, int, int, int, int, int) const {}
    __device__ __forceinline__ void operator()(const f32x4 (&acc)[2][2][4][2], const Unit& u, int wr, int wc, int fr, int fq) const {
        const int row0 = u.pm * BM + wr * 64 + fr, col0 = u.pn * BM + wc * 32 + 8 * fq;
        f32x4 bv[2][2];
#pragma unroll
        for (int bj = 0; bj < 2; ++bj)
#pragma unroll
            for (int n = 0; n < 2; ++n) bv[bj][n] = bias ? *(const f32x4*)(bias + col0 + bj * HALF + 4 * n) : (f32x4){0.f, 0.f, 0.f, 0.f};
#pragma unroll
        for (int ai = 0; ai < 2; ++ai)
#pragma unroll
            for (int m = 0; m < 4; ++m) { bf16_t* rowp = O + (size_t)(row0 + ai * HALF + m * 16) * ldc + col0;
#pragma unroll
                for (int bj = 0; bj < 2; ++bj) { f32x4 v0 = acc[ai][bj][m][0] + bv[bj][0], v1 = acc[ai][bj][m][1] + bv[bj][1];
                    if (ACT == 1) {
#pragma unroll
                        for (int j = 0; j < 4; ++j) { v0[j] = sigmoid_f(v0[j]); v1[j] = sigmoid_f(v1[j]); } }
                    u32x4 w; w.x = cvt_pk_bf16(v0[0], v0[1]); w.y = cvt_pk_bf16(v0[2], v0[3]); w.z = cvt_pk_bf16(v1[0], v1[1]); w.w = cvt_pk_bf16(v1[2], v1[3]);
                    *(u32x4*)(rowp + bj * HALF) = w; } }
    }
};
struct EpiBranch {
    static constexpr bool PERM = true, AFTER_DRAIN = false, MIDK = true; static constexpr int T1 = 16, T2 = 24;
    bf16_t* O; int ldc; const bf16_t* gates; int ldg;
    __device__ __forceinline__ static void ld8(const bf16_t* p, float (&g)[8]) { const u32x4 w = *(const u32x4*)p;
        g[0] = bf_lo(w.x); g[1] = bf_hi(w.x); g[2] = bf_lo(w.y); g[3] = bf_hi(w.y); g[4] = bf_lo(w.z); g[5] = bf_hi(w.z); g[6] = bf_lo(w.w); g[7] = bf_hi(w.w);
#pragma unroll
        for (int j = 0; j < 8; ++j) g[j] = fmaxf(g[j], 1e-20f); }
    __device__ __forceinline__ void mid(f32x4 (&acc)[2][2][4][2], const Unit& u, int t, int wr, int wc, int fr, int fq) const {
        int row0 = u.pm * BM + wr * 64 + fr; asm volatile("" : "+v"(row0));
        const int col0 = u.pn * BM + wc * 32 + 8 * fq;
        const int bnum = (t == T1) ? 0 : 1;
#pragma unroll
        for (int ai = 0; ai < 2; ++ai)
#pragma unroll
            for (int m = 0; m < 4; ++m) { const bf16_t* gp = gates + (size_t)(row0 + ai * HALF + m * 16) * ldg + col0 + bnum * 2048;
#pragma unroll
                for (int bj = 0; bj < 2; ++bj) { float gn[8], gd[8]; ld8(gp + bj * HALF, gn); ld8(gp + bj * HALF + 2048, gd);
#pragma unroll
                    for (int n = 0; n < 2; ++n)
#pragma unroll
                        for (int j = 0; j < 4; ++j) acc[ai][bj][m][n][j] *= gn[n * 4 + j] * __builtin_amdgcn_rcpf(gd[n * 4 + j]); }
                asm volatile("" ::: "memory"); }
    }
    __device__ __forceinline__ void operator()(const f32x4 (&acc)[2][2][4][2], const Unit& u, int wr, int wc, int fr, int fq) const {
        const int row0 = u.pm * BM + wr * 64 + fr, col0 = u.pn * BM + wc * 32 + 8 * fq;
#pragma unroll
        for (int ai = 0; ai < 2; ++ai)
#pragma unroll
            for (int m = 0; m < 4; ++m) { const size_t r = (size_t)(row0 + ai * HALF + m * 16); const bf16_t* gp = gates + r * ldg + col0 + 2 * 2048; bf16_t* rowp = O + r * ldc + col0;
#pragma unroll
                for (int bj = 0; bj < 2; ++bj) { float g2[8]; ld8(gp + bj * HALF, g2);
                    const f32x4 v0 = acc[ai][bj][m][0], v1 = acc[ai][bj][m][1];
                    u32x4 w; w.x = cvt_pk_bf16(v0[0] * g2[0], v0[1] * g2[1]); w.y = cvt_pk_bf16(v0[2] * g2[2], v0[3] * g2[3]); w.z = cvt_pk_bf16(v1[0] * g2[4], v1[1] * g2[5]); w.w = cvt_pk_bf16(v1[2] * g2[6], v1[3] * g2[7]);
                    *(u32x4*)(rowp + bj * HALF) = w; }
                asm volatile("" ::: "memory"); }
    }
};
template <class Epi, class Sched, bool ALIGN_EPI = false, bool SP2 = false>
__device__ __forceinline__ void gemm_phase(PG8_LAS unsigned char* lds, const Gemm g, const Sched& S, const Epi& E) {
    int tid_ = threadIdx.x; asm volatile("" : "+v"(tid_));
    const int tid = tid_, wid = __builtin_amdgcn_readfirstlane(tid >> 6), lane = tid & 63, wr = wid >> 2, wc = wid & 3, fr = lane & 15, fq = lane >> 4;
    const int K = g.K, nt = K / BK;
    unsigned voffA[2], voffB[2];
#pragma unroll
    for (int i = 0; i < 2; ++i) { int R, C; stage_rc(tid * 16 + i * 8192, R, C); const int Rb = Epi::PERM ? ((R & ~31) + perm32(R & 31)) : R;
        voffA[i] = (unsigned)(R * g.lda + C) * 2u; voffB[i] = (unsigned)(Rb * g.ldb + C) * 2u; }
    const size_t kstep = (size_t)(BK * 2);
    const size_t hstepA = (size_t)HALF * g.lda * 2, hstepB = (size_t)HALF * g.ldb * 2;
    const size_t tstepA = 2 * hstepA, tstepB = 2 * hstepB;
    const unsigned ldsw = (unsigned)wid * 1024u;
    const int aoff = lds_byte(wr * 64 + fr, fq * 8), boff = lds_byte(wc * 32 + fr, fq * 8);
#define PG8_SA(b, h) (((b) * 2 + (h)) * HTB)
#define PG8_SB(b, h) ((4 + (b) * 2 + (h)) * HTB)
#define PG8_STAGE(bufoff, gbase, voff) do { _Pragma("unroll") for (int _i = 0; _i < 2; ++_i) \
        __builtin_amdgcn_global_load_lds((const unsigned*)((const char*)(gbase) + (voff)[_i]), (PG8_LAS unsigned*)(lds + (bufoff) + ldsw + _i * 8192), 16, 0, 0); } while (0)
#define PG8_LDA(dst, b, h) do { _Pragma("unroll") for (int m = 0; m < 4; ++m) _Pragma("unroll") for (int k = 0; k < 2; ++k) dst[m][k] = *(const PG8_LAS bf16x8*)(lds + PG8_SA(b, h) + aoff + m * 2048 + k * 1024); } while (0)
#define PG8_LDB(dst, b, h) do { _Pragma("unroll") for (int n = 0; n < 2; ++n) _Pragma("unroll") for (int k = 0; k < 2; ++k) dst[n][k] = *(const PG8_LAS bf16x8*)(lds + PG8_SB(b, h) + boff + n * 2048 + k * 1024); } while (0)
#define PG8_MMA(ai, bj, At, Bt) do { __builtin_amdgcn_s_setprio(1); _Pragma("unroll") for (int m = 0; m < 4; ++m) _Pragma("unroll") for (int n = 0; n < 2; ++n) _Pragma("unroll") for (int k = 0; k < 2; ++k) \
        acc[ai][bj][m][n] = __builtin_amdgcn_mfma_f32_16x16x32_bf16(Bt[n][k], At[m][k], acc[ai][bj][m][n], 0, 0, 0); __builtin_amdgcn_s_setprio(0); } while (0)
#define PG8_WAIT_V(n) asm volatile("s_waitcnt vmcnt(" #n ")" ::: "memory")
#define PG8_WAIT_L(n) asm volatile("s_waitcnt lgkmcnt(" #n ")" ::: "memory")
#define PG8_BAR __builtin_amdgcn_s_barrier()
#define PG8_SCHED __builtin_amdgcn_sched_barrier(0)
    Unit cur, nxt; int ui = 0;
    if (!S.next(0, cur)) return;
    f32x4 acc[2][2][4][2];
#pragma unroll
    for (int a = 0; a < 2; ++a)
#pragma unroll
        for (int b = 0; b < 2; ++b)
#pragma unroll
            for (int m = 0; m < 4; ++m)
#pragma unroll
                for (int n = 0; n < 2; ++n) acc[a][b][m][n] = (f32x4){0.f, 0.f, 0.f, 0.f};
    bf16x8 At[4][2], B0[2][2], B1[2][2];
    const char* cA = (const char*)g.A + (size_t)cur.pm * tstepA; const char* cB = (const char*)g.Bt + (size_t)cur.pn * tstepB;
    S.a_ready(cur);
    if constexpr (SP2) {
        PG8_STAGE(PG8_SB(0, 0), cB, voffB); PG8_STAGE(PG8_SB(0, 1), cB + hstepB, voffB); PG8_STAGE(PG8_SA(0, 0), cA, voffA); PG8_STAGE(PG8_SA(0, 1), cA + hstepA, voffA);
        if (wr == 1) PG8_BAR;
        PG8_WAIT_V(2); PG8_BAR;
        PG8_STAGE(PG8_SB(1, 0), cB + kstep, voffB); PG8_STAGE(PG8_SA(1, 0), cA + kstep, voffA); PG8_STAGE(PG8_SB(1, 1), cB + hstepB + kstep, voffB);
        PG8_WAIT_V(6); PG8_BAR;
    } else {
        PG8_STAGE(PG8_SB(0, 0), cB, voffB); PG8_STAGE(PG8_SA(0, 0), cA, voffA); PG8_STAGE(PG8_SB(0, 1), cB + hstepB, voffB); PG8_STAGE(PG8_SA(0, 1), cA + hstepA, voffA);
        if (wr == 1) PG8_BAR;
        PG8_WAIT_V(4); PG8_BAR;
        PG8_STAGE(PG8_SB(1, 0), cB + kstep, voffB); PG8_STAGE(PG8_SA(1, 0), cA + kstep, voffA); PG8_STAGE(PG8_SB(1, 1), cB + hstepB + kstep, voffB);
        PG8_WAIT_V(6); PG8_BAR;
    }
    for (;;) {
        const bool has_next = S.next(ui + 1, nxt);
        const char* nA = has_next ? (const char*)g.A + (size_t)nxt.pm * tstepA : cA; const char* nB = has_next ? (const char*)g.Bt + (size_t)nxt.pn * tstepB : cB;
        for (int t = 0; t < nt; t += 2) {
            if constexpr (Epi::MIDK) { if (t == Epi::T1 || t == Epi::T2) E.mid(acc, cur, t, wr, wc, fr, fq); }
            const bool last = (t == nt - 2);
            const char* a1 = cA + (size_t)(t + 1) * kstep;
            const char* a2 = last ? nA : cA + (size_t)(t + 2) * kstep; const char* b2 = last ? nB : cB + (size_t)(t + 2) * kstep;
            const char* a3 = a2 + kstep; const char* b3 = b2 + kstep;
            if (last && has_next) S.a_ready(nxt);
            if constexpr (SP2) {
            PG8_LDB(B0, 0, 0); PG8_LDB(B1, 0, 1); PG8_SCHED; PG8_LDA(At, 0, 0); PG8_STAGE(PG8_SA(1, 1), a1 + hstepA, voffA);
            PG8_WAIT_V(8); PG8_WAIT_L(0); PG8_BAR; PG8_MMA(0, 0, At, B0); PG8_MMA(0, 1, At, B1); PG8_BAR; PG8_SCHED;
            PG8_LDA(At, 0, 1); PG8_STAGE(PG8_SB(0, 0), b2, voffB); PG8_STAGE(PG8_SB(0, 1), b2 + hstepB, voffB); PG8_STAGE(PG8_SA(0, 0), a2, voffA);
            PG8_WAIT_V(8); PG8_WAIT_L(0); PG8_BAR; PG8_MMA(1, 0, At, B0); PG8_MMA(1, 1, At, B1); PG8_BAR; PG8_SCHED;
            PG8_LDB(B0, 1, 0); PG8_LDB(B1, 1, 1); PG8_SCHED; PG8_LDA(At, 1, 0); PG8_STAGE(PG8_SA(0, 1), a2 + hstepA, voffA);
            PG8_WAIT_V(8); PG8_WAIT_L(0); PG8_BAR; PG8_MMA(0, 0, At, B0); PG8_MMA(0, 1, At, B1); PG8_BAR; PG8_SCHED;
            PG8_LDA(At, 1, 1); PG8_STAGE(PG8_SB(1, 0), b3, voffB); PG8_STAGE(PG8_SB(1, 1), b3 + hstepB, voffB); PG8_STAGE(PG8_SA(1, 0), a3, voffA);
            PG8_WAIT_V(8); PG8_WAIT_L(0); PG8_BAR; PG8_MMA(1, 0, At, B0); PG8_MMA(1, 1, At, B1); PG8_BAR; PG8_SCHED;
            } else {
            PG8_LDB(B0, 0, 0); PG8_SCHED; PG8_LDA(At, 0, 0); PG8_STAGE(PG8_SA(1, 1), a1 + hstepA, voffA);
            PG8_WAIT_L(8); PG8_BAR; PG8_WAIT_L(0); PG8_MMA(0, 0, At, B0); PG8_BAR; PG8_SCHED;
            PG8_LDB(B1, 0, 1); PG8_STAGE(PG8_SB(0, 0), b2, voffB);
            PG8_BAR; PG8_WAIT_L(0); PG8_MMA(0, 1, At, B1); PG8_BAR;
            PG8_LDA(At, 0, 1); PG8_STAGE(PG8_SA(0, 0), a2, voffA);
            PG8_BAR; PG8_WAIT_L(0); PG8_MMA(1, 0, At, B0); PG8_BAR; PG8_SCHED;
            PG8_STAGE(PG8_SB(0, 1), b2 + hstepB, voffB);
            PG8_WAIT_V(6); PG8_BAR; PG8_MMA(1, 1, At, B1); PG8_BAR;
            PG8_LDB(B0, 1, 0); PG8_SCHED; PG8_LDA(At, 1, 0); PG8_STAGE(PG8_SA(0, 1), a2 + hstepA, voffA);
            PG8_WAIT_L(8); PG8_BAR; PG8_WAIT_L(0); PG8_MMA(0, 0, At, B0); PG8_BAR; PG8_SCHED;
            PG8_LDB(B1, 1, 1); PG8_STAGE(PG8_SB(1, 0), b3, voffB);
            PG8_BAR; PG8_WAIT_L(0); PG8_MMA(0, 1, At, B1); PG8_BAR;
            PG8_LDA(At, 1, 1); PG8_STAGE(PG8_SA(1, 0), a3, voffA);
            PG8_BAR; PG8_WAIT_L(0); PG8_MMA(1, 0, At, B0); PG8_BAR; PG8_SCHED;
            PG8_STAGE(PG8_SB(1, 1), b3 + hstepB, voffB);
            PG8_WAIT_V(6); PG8_BAR; PG8_MMA(1, 1, At, B1); PG8_BAR;
            }
        }
        if constexpr (ALIGN_EPI) { if (wr == 0) PG8_BAR; }
        if constexpr (!Epi::AFTER_DRAIN) { E(acc, cur, wr, wc, fr, fq); S.done(cur); }
        if (!has_next) break;
#pragma unroll
        for (int a = 0; a < 2; ++a)
#pragma unroll
            for (int b = 0; b < 2; ++b)
#pragma unroll
                for (int m = 0; m < 4; ++m)
#pragma unroll
                    for (int n = 0; n < 2; ++n) acc[a][b][m][n] = (f32x4){0.f, 0.f, 0.f, 0.f};
        cur = nxt; cA = nA; cB = nB; ++ui;
        if constexpr (ALIGN_EPI) { if (wr == 1) PG8_BAR; }
    }
    PG8_WAIT_V(0);
    if constexpr (!ALIGN_EPI) { if (wr == 0) PG8_BAR; }
    PG8_BAR;
    if constexpr (Epi::AFTER_DRAIN) { E.fused(acc, cur, wr, wc, fr, fq, lds, wid, lane); S.done(cur); }
#undef PG8_SA
#undef PG8_SB
#undef PG8_STAGE
#undef PG8_LDA
#undef PG8_LDB
#undef PG8_MMA
#undef PG8_WAIT_V
#undef PG8_WAIT_L
#undef PG8_BAR
#undef PG8_SCHED
}
}

#ifndef PG8_SP2
#define PG8_SP2 true
#endif
#ifndef PG8_ALIGN
#define PG8_ALIGN true
#endif

constexpr int NWAVES = 8;
constexpr int DM = 2048, SEQ = 8192, CTX = 256, DEPTH = 2, GRID_W = 64, NROWS = SEQ / GRID_W;
constexpr int MTOT = SEQ + CTX;
constexpr int NH = 8, HD = 128, DNA = 1024, WIN_R = 8, WIN_C = 16;
constexpr int DFOUR = 512, FG = 128, DCONV = 512, CONVW = 31;
constexpr int DFF = 5632, DIN = 4608, NMODU = 6;
constexpr int ADA_N = 9 * DM;
constexpr float LN_EPS = 1e-5f, ALPHA = 1.4142135623730951f;
constexpr int ZQ = 0, ZK = DNA, ZV = 2 * DNA, ZF = 3 * DNA, ZA = 3 * DNA + DFOUR, ZG = 3 * DNA + DFOUR + DCONV;
constexpr int YNA = 0, YF = DNA, YC = DNA + DFOUR;

enum { I_X = 0, I_C, I_CTX, I_CCTX, I_WADA, I_BADA, I_F1W1, I_F1W3, I_F1W2, I_F2W1, I_F2W3, I_F2W2, I_WIN, I_WDW, I_BDW, I_CLNG, I_CLNB, I_RPB, I_WGATE, I_BGATE, I_WBNA, I_WBF, I_WBC, I_WO, I_LNG, I_LNB, N_IN };

constexpr size_t MiB = 1u << 20;
constexpr size_t WS_CTL = 0, CTL_ZERO_BYTES = 1 * MiB;
constexpr int MODP_CH = 16;
constexpr size_t WS_MODP = 2 * MiB;
constexpr size_t WS_MOD = 6 * MiB;
constexpr size_t WS_W = 8 * MiB;
constexpr size_t WL_W13A = 0, WL_W2A = 44 * MiB, WL_W13B = 66 * MiB, WL_W2B = 110 * MiB, WL_WIN = 132 * MiB, WL_WG = 150 * MiB, WL_WB = 174 * MiB, WL_WO = 182 * MiB, WL_SIZE = 190 * MiB;
constexpr size_t WS_X = 388 * MiB;
constexpr size_t WS_T = 454 * MiB;
constexpr size_t WS_H = 520 * MiB;
constexpr size_t WS_G = 553 * MiB;
constexpr size_t WS_ZIN = 644 * MiB;
constexpr size_t WS_YALL = 719 * MiB;
constexpr size_t WS_GATES = 752 * MiB;
constexpr size_t WS_MB = 851 * MiB;
constexpr size_t WS_FY = 884 * MiB;
constexpr size_t WS_END = 917 * MiB;
static_assert(WS_W + 2 * WL_SIZE <= WS_X && WS_G + (size_t)MTOT * DFF * 2 <= WS_ZIN && WS_ZIN + (size_t)MTOT * DIN * 2 <= WS_YALL && WS_GATES + (size_t)MTOT * 3 * DM * 2 <= WS_MB && WS_FY + (size_t)MTOT * DFOUR * 8 <= WS_END, "d_ws map");
constexpr int CW_TMO = 0, CW_BAR = 4096;

constexpr int RING_OFF = 0, RING_BYTES = 131072;
constexpr int LDSCTL_OFF = RING_BYTES, MISC_OFF = LDSCTL_OFF + 320;
constexpr int LDS_BYTES = 147456;

#define GAS __attribute__((address_space(1)))
#define LAS __attribute__((address_space(3)))
typedef unsigned short bf16;
typedef unsigned v4u __attribute__((ext_vector_type(4)));
typedef unsigned v2u __attribute__((ext_vector_type(2)));
typedef float f32x4 __attribute__((ext_vector_type(4)));
typedef float f32x2 __attribute__((ext_vector_type(2)));
typedef short bf16x8 __attribute__((ext_vector_type(8)));
typedef GAS unsigned gu32;
#define RLX_AGENT __ATOMIC_RELAXED, __HIP_MEMORY_SCOPE_AGENT
#define LDS_WAIT() asm volatile("s_waitcnt lgkmcnt(0)" ::: "memory")
#define VM_WAIT() asm volatile("s_waitcnt vmcnt(0)" ::: "memory")
__device__ __forceinline__ unsigned f2bf(float f) { unsigned u = __builtin_bit_cast(unsigned, f); return (u + 0x7fffu + ((u >> 16) & 1u)) >> 16; }
__device__ __forceinline__ unsigned pk2(float lo, float hi) { return f2bf(lo) | (f2bf(hi) << 16); }
__device__ __forceinline__ float bf2f(bf16 b) { return __builtin_bit_cast(float, (unsigned)b << 16); }
__device__ __forceinline__ float sigm(float x) { return 1.0f / (1.0f + __expf(-x)); }
__device__ __forceinline__ float wave_sum(float v) {
#pragma unroll
    for (int o = 1; o < 64; o <<= 1) v += __shfl_xor(v, o);
    return v;
}
__device__ __forceinline__ float wave_max(float v) {
#pragma unroll
    for (int o = 1; o < 64; o <<= 1) v = fmaxf(v, __shfl_xor(v, o));
    return v;
}
#define XB_TMO      128
#define XB_XCNT(j)  (256  + 64 * (j))
#define XB_XSUB(j)  (1280 + 64 * (j))
#define XB_XGEN(j)  (2304 + 64 * (j))
#define XB_TOP      3328
#define XB_TOPGEN   3392
#define XCD_BAR_WORDS 3456
#define XB_SPIN_CAP (1u << 18)

__device__ __forceinline__ unsigned xb_ld(unsigned* p)              { return __hip_atomic_load(p, __ATOMIC_RELAXED, __HIP_MEMORY_SCOPE_AGENT); }
__device__ __forceinline__ unsigned xb_add(unsigned* p, unsigned v) { return __hip_atomic_fetch_add(p, v, __ATOMIC_RELAXED, __HIP_MEMORY_SCOPE_AGENT); }
__device__ __forceinline__ unsigned xb_xcc_id() { return (unsigned)__builtin_amdgcn_s_getreg((3 << 11) | 20) & 0xFu; }
#define XB_SPIN(cond, bar) do { unsigned _sp = 0; while (cond) { __builtin_amdgcn_s_sleep(1); \
    if ((++_sp & 255u) == 0u) { if (xb_ld(&(bar)[XB_TMO])) break; if (_sp > XB_SPIN_CAP) { atomicAdd(&(bar)[XB_TMO], 1u); break; } } } } while (0)

struct XcdBarrier {
    unsigned* bar; unsigned x;
    volatile LAS unsigned* st;
};

__device__ __forceinline__ XcdBarrier xcd_barrier_post(unsigned* bar, volatile LAS unsigned* st) {
    XcdBarrier b; b.bar = bar; b.x = xb_xcc_id(); b.st = st;
    if (threadIdx.x == 0) (void)xb_add(&bar[XB_XCNT(b.x)], 1u);
    return b;
}
__device__ __forceinline__ void xcd_barrier_complete(unsigned* bar, unsigned x, unsigned& nloc, unsigned& nx) {
    const unsigned G = gridDim.x * gridDim.y * gridDim.z;
    unsigned sum, cnt, mine, sp = 0u;
    for (;;) {
        sum = 0u; cnt = 0u; mine = 0u;
#pragma unroll
        for (unsigned j = 0; j < 16; ++j) { const unsigned c = xb_ld(&bar[XB_XCNT(j)]); sum += c; cnt += (c > 0u) ? 1u : 0u; mine = (j == x) ? c : mine; }
        if (sum == G) break;
        __builtin_amdgcn_s_sleep(1);
        if ((++sp & 255u) == 0u) { if (xb_ld(&bar[XB_TMO])) break; if (sp > XB_SPIN_CAP) { atomicAdd(&bar[XB_TMO], 1u); break; } }
    }
    nloc = mine > 0u ? mine : 1u; nx = cnt > 0u ? cnt : 1u;
}

__device__ __forceinline__ void xcd_barrier(const XcdBarrier& b) {
    asm volatile("s_waitcnt vmcnt(0)" ::: "memory");
    __syncthreads();
    if (threadIdx.x == 0) {
        unsigned* bar = b.bar;
        __builtin_amdgcn_s_waitcnt(0);
        unsigned nloc = b.st[0], nx = b.st[1];
        if (nloc == 0u) { xcd_barrier_complete(bar, b.x, nloc, nx); b.st[0] = nloc; b.st[1] = nx; }
        const unsigned old = xb_add(&bar[XB_XSUB(b.x)], 1u);
        const unsigned gen = old / nloc;
        if (old + 1u == (gen + 1u) * nloc) {
            __builtin_amdgcn_fence(__ATOMIC_RELEASE, "agent");
            asm volatile("s_waitcnt vmcnt(0)" ::: "memory");
            const unsigned og = xb_add(&bar[XB_TOP], 1u);
            const unsigned tg = og / nx;
            if (og + 1u == (tg + 1u) * nx) xb_add(&bar[XB_TOPGEN], 1u);
            else XB_SPIN(xb_ld(&bar[XB_TOPGEN]) == tg, bar);
            __builtin_amdgcn_fence(__ATOMIC_ACQUIRE, "agent");
            xb_add(&bar[XB_XGEN(b.x)], 1u);
            asm volatile("s_waitcnt vmcnt(0)" ::: "memory");
        } else {
            XB_SPIN(xb_ld(&bar[XB_XGEN(b.x)]) == gen, bar);
            __builtin_amdgcn_fence(__ATOMIC_ACQUIRE, "agent");
            asm volatile("s_waitcnt vmcnt(0)" ::: "memory");
        }
    }
    __syncthreads();
}


struct Ctx {
    LAS unsigned char* lds; int tid, lane, wave, bx, G, gw, NGW;
};
struct Args { const float* in[26]; float* out; unsigned char* ws; int ph_lo, ph_hi, use_bar, pad; };
typedef const __attribute__((address_space(4))) Args* KAp;
__device__ __forceinline__ KAp ka_opaque() { KAp p = (KAp)__builtin_amdgcn_kernarg_segment_ptr(); asm volatile("" : "+s"(p)); return p; }

__device__ __forceinline__ void p0_transpose_item(const float* W, int N, bf16* WT, int ldk, int koff, int grp, int gstride, int goff, LAS float* scr, int item, int lane) {
    const int nblk = N / 32, kb = item / nblk, nb = item % nblk, k0 = 64 * kb, n0 = 32 * nb;
#pragma unroll 8
    for (int i = 0; i < 32; ++i) { const int kk = 2 * i + (lane >> 5); scr[kk * 33 + (lane & 31)] = W[(size_t)(k0 + kk) * N + n0 + (lane & 31)]; }
    LDS_WAIT(); asm volatile("" ::: "memory");
    const int c = lane & 7;
#pragma unroll
    for (int j = 0; j < 4; ++j) { const int n = (lane >> 3) + 8 * j; const LAS float* s = scr + (8 * c) * 33 + n;
        v4u o; o.x = pk2(s[0 * 33], s[1 * 33]); o.y = pk2(s[2 * 33], s[3 * 33]); o.z = pk2(s[4 * 33], s[5 * 33]); o.w = pk2(s[6 * 33], s[7 * 33]);
        const int nn = n0 + n, drow = (nn / grp) * gstride + goff + (nn % grp);
        *(GAS v4u*)(WT + (size_t)drow * ldk + koff + k0 + 8 * c) = o; }
    LDS_WAIT(); asm volatile("" ::: "memory");
}
constexpr int TI_FF = (DM / 64) * (DFF / 32);
constexpr int TI_IN = (DM / 64) * (DIN / 32), TI_G = (DM / 64) * (3 * DM / 32), TI_BNA = (DNA / 64) * (DM / 32), TI_BF = (DFOUR / 64) * (DM / 32), TI_BC = (DCONV / 64) * (DM / 32), TI_O = (DM / 64) * (DM / 32);
constexpr int TI_LAYER = 6 * TI_FF + TI_IN + TI_G + TI_BNA + TI_BF + TI_BC + TI_O;
constexpr int MOD_CB = NMODU * DM / 256;
constexpr int MODI = DEPTH * MOD_CB * MODP_CH;

__device__ __forceinline__ void p0_prologue(const Ctx& F) {
    const KAp ka = ka_opaque(); unsigned char* const ws = ka->ws;
    LAS float* scr = (LAS float*)(F.lds + RING_OFF + F.wave * 16384);
    const int NIT = MODI + DEPTH * TI_LAYER;
    for (int it = F.gw; it < NIT; it += F.NGW) {
        if (it < MODI) {
            const int l = it / (MOD_CB * MODP_CH), r = it % (MOD_CB * MODP_CH), cb = r / MODP_CH, kc = r % MODP_CH;
            const float* cv = ka->in[I_C]; const float* cc = ka->in[I_CCTX];
            const float a0 = cv[kc * 128 + F.lane], a1 = cv[kc * 128 + 64 + F.lane], b0 = cc[kc * 128 + F.lane], b1 = cc[kc * 128 + 64 + F.lane];
            const float sl0 = a0 * sigm(a0), sl1 = a1 * sigm(a1), sc0 = b0 * sigm(b0), sc1 = b1 * sigm(b1);
            const float* W = ka->in[I_WADA] + (size_t)l * DM * ADA_N + (size_t)(kc * 128) * ADA_N + cb * 256 + 4 * F.lane;
            f32x4 aL = {0.f, 0.f, 0.f, 0.f}, aC = {0.f, 0.f, 0.f, 0.f};
#pragma unroll 8
            for (int k = 0; k < 64; ++k) { const f32x4 w = *(const GAS f32x4*)(W + (size_t)k * ADA_N); aL += w * __shfl(sl0, k); aC += w * __shfl(sc0, k); }
#pragma unroll 8
            for (int k = 0; k < 64; ++k) { const f32x4 w = *(const GAS f32x4*)(W + (size_t)(64 + k) * ADA_N); aL += w * __shfl(sl1, k); aC += w * __shfl(sc1, k); }
            float* P = (float*)(ws + WS_MODP);
            *(GAS f32x4*)(P + (size_t)((kc * 2 + l) * 2 + 0) * (NMODU * DM) + cb * 256 + 4 * F.lane) = aL;
            *(GAS f32x4*)(P + (size_t)((kc * 2 + l) * 2 + 1) * (NMODU * DM) + cb * 256 + 4 * F.lane) = aC;
            continue;
        }
        int r = it - MODI; const int l = r / TI_LAYER; r -= l * TI_LAYER;
        unsigned char* wl = ws + WS_W + (size_t)l * WL_SIZE;
        const float* W; int N; bf16* WT; int ldk, koff = 0, grp, gstride = 0, goff = 0;
        if (r < TI_FF) { W = ka->in[I_F1W1] + (size_t)l * DM * DFF; N = DFF; WT = (bf16*)(wl + WL_W13A); ldk = DM; grp = 128; gstride = 256; goff = 0; }
        else if ((r -= TI_FF) < TI_FF) { W = ka->in[I_F1W3] + (size_t)l * DM * DFF; N = DFF; WT = (bf16*)(wl + WL_W13A); ldk = DM; grp = 128; gstride = 256; goff = 128; }
        else if ((r -= TI_FF) < TI_FF) { W = ka->in[I_F1W2] + (size_t)l * DFF * DM; N = DM; WT = (bf16*)(wl + WL_W2A); ldk = DFF; grp = DM; }
        else if ((r -= TI_FF) < TI_FF) { W = ka->in[I_F2W1] + (size_t)l * DM * DFF; N = DFF; WT = (bf16*)(wl + WL_W13B); ldk = DM; grp = 128; gstride = 256; goff = 0; }
        else if ((r -= TI_FF) < TI_FF) { W = ka->in[I_F2W3] + (size_t)l * DM * DFF; N = DFF; WT = (bf16*)(wl + WL_W13B); ldk = DM; grp = 128; gstride = 256; goff = 128; }
        else if ((r -= TI_FF) < TI_FF) { W = ka->in[I_F2W2] + (size_t)l * DFF * DM; N = DM; WT = (bf16*)(wl + WL_W2B); ldk = DFF; grp = DM; }
        else if ((r -= TI_FF) < TI_IN) { W = ka->in[I_WIN] + (size_t)l * DM * DIN; N = DIN; WT = (bf16*)(wl + WL_WIN); ldk = DM; grp = DIN; }
        else if ((r -= TI_IN) < TI_G) { W = ka->in[I_WGATE] + (size_t)l * DM * 3 * DM; N = 3 * DM; WT = (bf16*)(wl + WL_WG); ldk = DM; grp = 3 * DM; }
        else if ((r -= TI_G) < TI_BNA) { W = ka->in[I_WBNA] + (size_t)l * DNA * DM; N = DM; WT = (bf16*)(wl + WL_WB); ldk = DM; grp = DM; koff = 0; }
        else if ((r -= TI_BNA) < TI_BF) { W = ka->in[I_WBF] + (size_t)l * DFOUR * DM; N = DM; WT = (bf16*)(wl + WL_WB); ldk = DM; grp = DM; koff = DNA; }
        else if ((r -= TI_BF) < TI_BC) { W = ka->in[I_WBC] + (size_t)l * DCONV * DM; N = DM; WT = (bf16*)(wl + WL_WB); ldk = DM; grp = DM; koff = DNA + DFOUR; }
        else { r -= TI_BC; W = ka->in[I_WO] + (size_t)l * DM * DM; N = DM; WT = (bf16*)(wl + WL_WO); ldk = DM; grp = DM; }
        p0_transpose_item(W, N, WT, ldk, koff, grp, gstride, goff, scr, r, F.lane);
    }
}

__device__ __forceinline__ const float* mod_vec(unsigned char* ws, int l, int s, int i) { return (const float*)(ws + WS_MOD) + (size_t)((l * 2 + s) * NMODU + i) * DM; }
__device__ __forceinline__ void p1_prologue(const Ctx& F) {
    const KAp ka = ka_opaque(); unsigned char* const ws = ka->ws;
    const float* P = (const float*)(ws + WS_MODP); const float* bada = ka->in[I_BADA];
    LAS float* mv = (LAS float*)(F.lds + RING_OFF);
#pragma unroll
    for (int v = 0; v < 4; ++v) { const int s = v >> 1, i = v & 1;
#pragma unroll
        for (int q = 0; q < 4; ++q) { const int col = F.tid + 512 * q; float a = bada[i * DM + col];
            for (int kc = 0; kc < MODP_CH; ++kc) a += P[(size_t)((kc * 2 + 0) * 2 + s) * (NMODU * DM) + i * DM + col];
            mv[v * DM + col] = a; } }
    const int gt = F.bx * 512 + F.tid;
    if (gt < DEPTH * 2 * NMODU * DM) { const int l = gt / (2 * NMODU * DM), s = (gt / (NMODU * DM)) & 1, j = gt % (NMODU * DM); float a = bada[(size_t)l * ADA_N + j];
        for (int kc = 0; kc < MODP_CH; ++kc) a += P[(size_t)((kc * 2 + l) * 2 + s) * (NMODU * DM) + j];
        ((float*)(ws + WS_MOD))[(size_t)(l * 2 + s) * (NMODU * DM) + j] = a; }
    __syncthreads();
    float* X = (float*)(ws + WS_X); bf16* H = (bf16*)(ws + WS_H);
    for (int row = F.gw; row < MTOT; row += F.NGW) {
        const float* src = row < SEQ ? ka->in[I_X] + (size_t)row * DM : ka->in[I_CTX] + (size_t)(row - SEQ) * DM;
        const LAS float* sh = mv + (row < SEQ ? 0 : 2 * DM); const LAS float* sc = sh + DM;
#pragma unroll
        for (int j = 0; j < 8; ++j) { const int col = 4 * F.lane + 256 * j; const f32x4 v = *(const GAS f32x4*)(src + col);
            *(GAS f32x4*)(X + (size_t)row * DM + col) = v;
            const f32x4 s4 = *(const LAS f32x4*)(sc + col), h4 = *(const LAS f32x4*)(sh + col); const f32x4 h = v * (s4 + 1.0f) + h4;
            v2u o; o.x = pk2(h[0], h[1]); o.y = pk2(h[2], h[3]); *(GAS v2u*)(H + (size_t)row * DM + col) = o; }
    }
    __syncthreads();
}

#ifndef DIAG_ZERO_NA
#define DIAG_ZERO_NA 0
#endif
#ifndef DIAG_ZERO_C
#define DIAG_ZERO_C 0
#endif
#ifndef DIAG_ZERO_ROW0
#define DIAG_ZERO_ROW0 0
#endif
__device__ __forceinline__ void ln_phase(const Ctx& F, const float* T, float* Xo, bf16* H, const float* g, const float* b, const float* shL, const float* scL, const float* shC, const float* scC, int nrows) {
    f32x4 gv[8], bv[8];
#pragma unroll
    for (int j = 0; j < 8; ++j) { const int col = 4 * F.lane + 256 * j; gv[j] = *(const GAS f32x4*)(g + col); bv[j] = *(const GAS f32x4*)(b + col); }
    for (int row = F.gw; row < nrows; row += F.NGW) {
        f32x4 v[8]; float s = 0.f;
#pragma unroll
        for (int j = 0; j < 8; ++j) { v[j] = *(const GAS f32x4*)(T + (size_t)row * DM + 4 * F.lane + 256 * j); s += (v[j][0] + v[j][1]) + (v[j][2] + v[j][3]); }
        const float mean = wave_sum(s) * (1.0f / DM); float q = 0.f;
#pragma unroll
        for (int j = 0; j < 8; ++j) { v[j] = v[j] - mean; q += (v[j][0] * v[j][0] + v[j][1] * v[j][1]) + (v[j][2] * v[j][2] + v[j][3] * v[j][3]); }
        const float rstd = 1.0f / sqrtf(wave_sum(q) * (1.0f / DM) + LN_EPS);
        const float* sh = row < SEQ ? shL : shC; const float* sc = row < SEQ ? scL : scC;
#pragma unroll
        for (int j = 0; j < 8; ++j) { const int col = 4 * F.lane + 256 * j; const f32x4 y = v[j] * rstd * gv[j] + bv[j];
            *(GAS f32x4*)(Xo + (size_t)row * DM + col) = (DIAG_ZERO_ROW0 && !H && row == 0) ? (f32x4){0.f, 0.f, 0.f, 0.f} : y;
            if (H) { const f32x4 s4 = *(const GAS f32x4*)(sc + col), h4 = *(const GAS f32x4*)(sh + col); const f32x4 h = y * (s4 + 1.0f) + h4;
                v2u o; o.x = pk2(h[0], h[1]); o.y = pk2(h[2], h[3]); *(GAS v2u*)(H + (size_t)row * DM + col) = o; } }
    }
}

__device__ __forceinline__ void attn_item_v1(const bf16* ZIN, bf16* YALL, const float* rpb, int tok, int head, LAS float* pb, int lane) {
    const bool isctx = tok >= SEQ;
    const int r = tok / GRID_W, c = tok % GRID_W;
    const int r0 = min(max(r - WIN_R / 2, 0), NROWS - WIN_R), c0 = min(max(c - WIN_C / 2, 0), GRID_W - WIN_C);
    const int nband = isctx ? 0 : WIN_R * WIN_C, nkeys = nband + CTX;
    const int sub = lane & 15, grp = lane >> 4;
    float q[8];
    { const v4u w = *(const GAS v4u*)(ZIN + (size_t)tok * DIN + ZQ + head * HD + 8 * sub);
      q[0] = pg8::bf_lo(w.x); q[1] = pg8::bf_hi(w.x); q[2] = pg8::bf_lo(w.y); q[3] = pg8::bf_hi(w.y); q[4] = pg8::bf_lo(w.z); q[5] = pg8::bf_hi(w.z); q[6] = pg8::bf_lo(w.w); q[7] = pg8::bf_hi(w.w); }
    const float scale = 0.08838834764831845f;
    for (int kk0 = 0; kk0 < nkeys; kk0 += 4) {
        const int kk = kk0 + grp; int ktok; float bias = 0.f;
        if (kk < nband) { const int i = kk >> 4, j = kk & 15; ktok = (r0 + i) * GRID_W + c0 + j; bias = rpb[(head * (2 * WIN_R - 1) + (r0 + i - r + WIN_R - 1)) * (2 * WIN_C - 1) + (c0 + j - c + WIN_C - 1)]; }
        else ktok = SEQ + (kk - nband);
        const v4u w = *(const GAS v4u*)(ZIN + (size_t)ktok * DIN + ZK + head * HD + 8 * sub);
        float d = q[0] * pg8::bf_lo(w.x) + q[1] * pg8::bf_hi(w.x) + q[2] * pg8::bf_lo(w.y) + q[3] * pg8::bf_hi(w.y) + q[4] * pg8::bf_lo(w.z) + q[5] * pg8::bf_hi(w.z) + q[6] * pg8::bf_lo(w.w) + q[7] * pg8::bf_hi(w.w);
        d += __shfl_xor(d, 1); d += __shfl_xor(d, 2); d += __shfl_xor(d, 4); d += __shfl_xor(d, 8);
        if (sub == 0) pb[kk] = d * scale + bias;
    }
    LDS_WAIT(); asm volatile("" ::: "memory");
    float mx = -3.0e38f;
    for (int kk = lane; kk < nkeys; kk += 64) mx = fmaxf(mx, pb[kk]);
    mx = wave_max(mx);
    float sum = 0.f;
    for (int kk = lane; kk < nkeys; kk += 64) { const float e = __expf(pb[kk] - mx); pb[kk] = e; sum += e; }
    sum = wave_sum(sum);
    LDS_WAIT(); asm volatile("" ::: "memory");
    float o0 = 0.f, o1 = 0.f;
#pragma unroll 8
    for (int kk = 0; kk < nkeys; ++kk) {
        int ktok; if (kk < nband) { const int i = kk >> 4, j = kk & 15; ktok = (r0 + i) * GRID_W + c0 + j; } else ktok = SEQ + (kk - nband);
        const unsigned vw = *(const GAS unsigned*)(ZIN + (size_t)ktok * DIN + ZV + head * HD + 2 * lane); const float p = pb[kk];
        o0 += p * pg8::bf_lo(vw); o1 += p * pg8::bf_hi(vw); }
    const float inv = 1.0f / sum;
    *(GAS unsigned*)(YALL + (size_t)tok * DM + YNA + head * HD + 2 * lane) = DIAG_ZERO_NA ? 0u : pk2(o0 * inv, o1 * inv);
    LDS_WAIT(); asm volatile("" ::: "memory");
}

__device__ __forceinline__ void conv_item_v1(const Ctx& F, const bf16* ZIN, bf16* YALL, const float* wdw, const float* bdw, const float* lg, const float* lb, int base, int len, int t0) {
    LAS float* ut = (LAS float*)(F.lds + RING_OFF);
    const int ch = F.tid;
    for (int rr = 0; rr < 32 + CONVW - 1; ++rr) { const int t = t0 - CONVW / 2 + rr; float u = 0.f;
        if (t >= 0 && t < len) { const float a = bf2f(ZIN[(size_t)(base + t) * DIN + ZA + ch]), g = bf2f(ZIN[(size_t)(base + t) * DIN + ZG + ch]); u = a * sigm(g); }
        ut[rr * DCONV + ch] = u; }
    float w[CONVW];
#pragma unroll
    for (int j = 0; j < CONVW; ++j) w[j] = wdw[j * DCONV + ch];
    const float bias = bdw[ch];
    __syncthreads();
    float y[32];
#pragma unroll
    for (int n = 0; n < 32; ++n) { float a = bias;
#pragma unroll
        for (int j = 0; j < CONVW; ++j) a += ut[(n + j) * DCONV + ch] * w[j];
        y[n] = a; }
    __syncthreads();
#pragma unroll
    for (int n = 0; n < 32; ++n) ut[n * DCONV + ch] = y[n];
    __syncthreads();
#pragma unroll
    for (int qn = 0; qn < 4; ++qn) { const int n = F.wave * 4 + qn; float v[8], s = 0.f;
#pragma unroll
        for (int i = 0; i < 8; ++i) { v[i] = ut[n * DCONV + F.lane + 64 * i]; s += v[i]; }
        const float mean = wave_sum(s) * (1.0f / DCONV); float q = 0.f;
#pragma unroll
        for (int i = 0; i < 8; ++i) { v[i] -= mean; q += v[i] * v[i]; }
        const float rstd = 1.0f / sqrtf(wave_sum(q) * (1.0f / DCONV) + LN_EPS);
#pragma unroll
        for (int i = 0; i < 8; ++i) { const int c2 = F.lane + 64 * i; const float z = v[i] * rstd * lg[c2] + lb[c2]; YALL[(size_t)(base + t0 + n) * DM + YC + c2] = DIAG_ZERO_C ? (bf16)0 : (bf16)f2bf(z * sigm(z)); } }
    __syncthreads();
}

__device__ __forceinline__ void four_cs_table(const Ctx& F, LAS f32x2* cs) { if (F.tid < 128) { float s, c; sincospif((float)F.tid * (1.0f / 64.0f), &s, &c); cs[F.tid] = (f32x2){c, s}; } }
__device__ __forceinline__ void fourAB_item_v1(const Ctx& F, const bf16* ZIN, float* FY, int base, int N1, int n2, int grp, int half) {
    LAS f32x2* cs = (LAS f32x2*)(F.lds + RING_OFF); LAS bf16* fin = (LAS bf16*)(F.lds + RING_OFF + 1024);
    LAS float* Fc = (LAS float*)(F.lds + RING_OFF + 1024 + 32768); LAS float* Fs = Fc + 128 * 64;
    four_cs_table(F, cs);
    for (int idx = F.tid; idx < N1 * 128; idx += 512) { const int n1 = idx >> 7, c = idx & 127; fin[idx] = ZIN[(size_t)(base + n1 * GRID_W + n2) * DIN + ZF + grp * FG + c]; }
    __syncthreads();
    const int cpp = F.tid & 63, cp = half * 64 + cpp, wv = F.tid >> 6;
    for (int n1 = wv; n1 < N1; n1 += 8) { float fc = 0.f, fs = 0.f;
        for (int c = 0; c < 128; ++c) { const float x = bf2f(fin[n1 * 128 + c]); const f32x2 t = cs[(c * cp) & 127]; fc += x * t.x; fs += x * t.y; }
        Fc[n1 * 64 + cpp] = fc; Fs[n1 * 64 + cpp] = fs; }
    __syncthreads();
    const int tstep = 128 / N1;
    for (int k1 = wv; k1 < N1; k1 += 8) { float yr = 0.f, yi = 0.f;
        for (int n1 = 0; n1 < N1; ++n1) { const f32x2 t = cs[((k1 * n1) & (N1 - 1)) * tstep]; const float a = Fc[n1 * 64 + cpp], b = Fs[n1 * 64 + cpp]; yr += t.x * a - t.y * b; yi -= t.x * b + t.y * a; }
        float st, ct; sincospif(2.0f * (float)(n2 * k1) / (float)(N1 * GRID_W), &st, &ct);
        const f32x2 o = {yr * ct + yi * st, yi * ct - yr * st};
        *(GAS f32x2*)(FY + ((size_t)(base + k1 * GRID_W + n2) * DFOUR + grp * FG + cp) * 2) = o; }
    __syncthreads();
}
__device__ __forceinline__ void fourC_item_v1(const Ctx& F, const float* FY, bf16* YALL, int base, int N1, int k1, int grp) {
    LAS f32x2* cs = (LAS f32x2*)(F.lds + RING_OFF); LAS f32x2* Yt = (LAS f32x2*)(F.lds + RING_OFF + 1024);
    four_cs_table(F, cs);
    for (int idx = F.tid; idx < 64 * 128; idx += 512) { const int n2 = idx >> 7, cp = idx & 127; Yt[idx] = *(const GAS f32x2*)(FY + ((size_t)(base + k1 * GRID_W + n2) * DFOUR + grp * FG + cp) * 2); }
    __syncthreads();
    const int cp = F.tid & 127, kg = F.tid >> 7; const float norm = 1.0f / sqrtf((float)(N1 * GRID_W * FG));
    for (int k2 = kg; k2 < 64; k2 += 4) { float a = 0.f;
        for (int n2 = 0; n2 < 64; ++n2) { const f32x2 t = cs[((n2 * k2) & 63) * 2]; const f32x2 y = Yt[n2 * 128 + cp]; a += t.x * y.x + t.y * y.y; }
        YALL[(size_t)(base + k1 + N1 * k2) * DM + YF + grp * FG + cp] = (bf16)f2bf(a * norm); }
    __syncthreads();
}

#if MK_DIAG
constexpr int CW_DIAG = 64;
__device__ __forceinline__ unsigned dg_hash(unsigned x) { x ^= x >> 16; x *= 0x7feb352du; x ^= x >> 15; x *= 0x846ca68bu; x ^= x >> 16; return x; }
__device__ __forceinline__ void dg_fail(unsigned char* ws, int id) { atomicMax((unsigned*)(ws + WS_CTL) + CW_DIAG, (unsigned)(200 - id)); }
__device__ __forceinline__ bool dg_bad(float got, float exp, float rel, float ab) { return !(fabsf(got - exp) <= ab + rel * fabsf(exp)); }
__device__ __forceinline__ float dg_dot(const bf16* a, const bf16* b, int K, int lane) { float s = 0.f; for (int k = lane; k < K; k += 64) s += bf2f(a[k]) * bf2f(b[k]); return wave_sum(s); }

__global__ void __launch_bounds__(256) dg_gemm(Args a, int mode, int l, int f, int nrows, int id, float gmul, int gi) {
    unsigned char* ws = a.ws; unsigned char* wl = ws + WS_W + (size_t)l * WL_SIZE; const int lane = threadIdx.x & 63;
    const int smp = blockIdx.x * 4 + (threadIdx.x >> 6);
    const unsigned h1 = dg_hash(smp * 2 + 1 + 7919u * id), h2 = dg_hash(smp * 2 + 2 + 104729u * id);
    const int row = h1 % nrows;
    const bf16* H = (const bf16*)(ws + WS_H); const bf16* G = (const bf16*)(ws + WS_G); const bf16* YALL = (const bf16*)(ws + WS_YALL); const bf16* MB = (const bf16*)(ws + WS_MB); const bf16* GATES = (const bf16*)(ws + WS_GATES);
    if (mode == 0) { const int c = h2 % DFF; const bf16* W = (const bf16*)(wl + (f == 0 ? WL_W13A : WL_W13B));
        const float av = dg_dot(H + (size_t)row * DM, W + (size_t)((c / 128) * 256 + c % 128) * DM, DM, lane), bv = dg_dot(H + (size_t)row * DM, W + (size_t)((c / 128) * 256 + 128 + c % 128) * DM, DM, lane);
        const float exp = av * sigm(av) * bv, got = bf2f(G[(size_t)row * DFF + c]);
        if (lane == 0 && dg_bad(got, exp, 1e-2f, 2e-3f)) dg_fail(ws, id); }
    else if (mode == 1) { const int c = h2 % DM; float d;
        if (gi == 5 && gmul == 1.0f) d = dg_dot(MB + (size_t)row * DM, (const bf16*)(wl + WL_WO) + (size_t)c * DM, DM, lane);
        else d = dg_dot(G + (size_t)row * DFF, (const bf16*)(wl + (f == 0 ? WL_W2A : WL_W2B)) + (size_t)c * DFF, DFF, lane);
        const float gate = mod_vec(ws, l, row >= SEQ ? 1 : 0, gi)[c];
        const float exp = ALPHA * ((const float*)(ws + WS_X))[(size_t)row * DM + c] + gmul * gate * d, got = ((const float*)(ws + WS_T))[(size_t)row * DM + c];
        if (lane == 0 && dg_bad(got, exp, 1e-3f, 1e-3f)) dg_fail(ws, id); }
    else if (mode == 2) { const int c = h2 % DIN;
        const float exp = dg_dot(H + (size_t)row * DM, (const bf16*)(wl + WL_WIN) + (size_t)c * DM, DM, lane), got = bf2f(((const bf16*)(ws + WS_ZIN))[(size_t)row * DIN + c]);
        if (lane == 0 && dg_bad(got, exp, 1e-2f, 2e-3f)) dg_fail(ws, id); }
    else if (mode == 3) { const int c = h2 % (3 * DM);
        const float pre = dg_dot(H + (size_t)row * DM, (const bf16*)(wl + WL_WG) + (size_t)c * DM, DM, lane) + a.in[I_BGATE][(size_t)l * 3 * DM + c];
        const float exp = sigm(pre), got = bf2f(GATES[(size_t)row * 3 * DM + c]);
        if (lane == 0 && dg_bad(got, exp, 1e-2f, 2e-3f)) { dg_fail(ws, id); unsigned* D = (unsigned*)(ws + WS_CTL) + CW_DIAG; atomicAdd(D + 2, 1u);
            const float bias = a.in[I_BGATE][(size_t)l * 3 * DM + c]; int hyp = 4;
            if (!dg_bad(got, sigm(pre - bias), 1e-2f, 2e-3f)) hyp = 1; else if (!dg_bad(got, pre, 1e-2f, 2e-3f)) hyp = 2; else if (got == 0.5f || got < 1e-6f) hyp = 3;
            atomicAdd(D + 4 + hyp, 1u); atomicMax(D + 10, (unsigned)(100 - row / 256)); } }
    else { const int c = h2 % DM; const bf16* W = (const bf16*)(wl + WL_WB) + (size_t)c * DM; const bf16* y = YALL + (size_t)row * DM;
        const float p0 = dg_dot(y, W, DNA, lane), p1 = dg_dot(y + DNA, W + DNA, DFOUR, lane), p2 = dg_dot(y + DNA + DFOUR, W + DNA + DFOUR, DCONV, lane);
        const float g0 = bf2f(GATES[(size_t)row * 3 * DM + c]), g1 = bf2f(GATES[(size_t)row * 3 * DM + DM + c]), g2 = bf2f(GATES[(size_t)row * 3 * DM + 2 * DM + c]);
        const float exp = g0 * p0 + g1 * p1 + g2 * p2, got = bf2f(MB[(size_t)row * DM + c]);
        if (lane == 0 && dg_bad(got, exp, 1.5e-2f, 3e-3f)) dg_fail(ws, id); }
}
__global__ void __launch_bounds__(256) dg_trans(Args a, int id) {
    unsigned char* ws = a.ws; const int t = blockIdx.x * 256 + threadIdx.x; const int l = t & 1, which = (t >> 1) % 12; const unsigned h1 = dg_hash(t * 3 + 1), h2 = dg_hash(t * 3 + 2);
    unsigned char* wl = ws + WS_W + (size_t)l * WL_SIZE; float src; bf16 got;
    if (which < 6) { const int ff = which / 3, w = which % 3;
        if (w < 2) { const int k = h1 % DM, n = h2 % DFF; src = a.in[(ff ? I_F2W1 : I_F1W1) + w][(size_t)l * DM * DFF + (size_t)k * DFF + n]; got = ((const bf16*)(wl + (ff ? WL_W13B : WL_W13A)))[(size_t)((n / 128) * 256 + w * 128 + n % 128) * DM + k]; }
        else { const int k = h1 % DFF, n = h2 % DM; src = a.in[ff ? I_F2W2 : I_F1W2][(size_t)l * DFF * DM + (size_t)k * DM + n]; got = ((const bf16*)(wl + (ff ? WL_W2B : WL_W2A)))[(size_t)n * DFF + k]; } }
    else if (which == 6) { const int k = h1 % DM, n = h2 % DIN; src = a.in[I_WIN][(size_t)l * DM * DIN + (size_t)k * DIN + n]; got = ((const bf16*)(wl + WL_WIN))[(size_t)n * DM + k]; }
    else if (which == 7) { const int k = h1 % DM, n = h2 % (3 * DM); src = a.in[I_WGATE][(size_t)l * DM * 3 * DM + (size_t)k * 3 * DM + n]; got = ((const bf16*)(wl + WL_WG))[(size_t)n * DM + k]; }
    else if (which == 8) { const int k = h1 % DNA, n = h2 % DM; src = a.in[I_WBNA][(size_t)l * DNA * DM + (size_t)k * DM + n]; got = ((const bf16*)(wl + WL_WB))[(size_t)n * DM + k]; }
    else if (which == 9) { const int k = h1 % DFOUR, n = h2 % DM; src = a.in[I_WBF][(size_t)l * DFOUR * DM + (size_t)k * DM + n]; got = ((const bf16*)(wl + WL_WB))[(size_t)n * DM + DNA + k]; }
    else if (which == 10) { const int k = h1 % DCONV, n = h2 % DM; src = a.in[I_WBC][(size_t)l * DCONV * DM + (size_t)k * DM + n]; got = ((const bf16*)(wl + WL_WB))[(size_t)n * DM + DNA + DFOUR + k]; }
    else { const int k = h1 % DM, n = h2 % DM; src = a.in[I_WO][(size_t)l * DM * DM + (size_t)k * DM + n]; got = ((const bf16*)(wl + WL_WO))[(size_t)n * DM + k]; }
    if (got != (bf16)f2bf(src)) dg_fail(ws, id);
}
__global__ void __launch_bounds__(256) dg_mod(Args a, int id) {
    unsigned char* ws = a.ws; const int lane = threadIdx.x & 63; const int smp = blockIdx.x * 4 + (threadIdx.x >> 6);
    const int l = smp & 1, s = (smp >> 1) & 1, j = dg_hash(smp) % (NMODU * DM);
    const float* cv = s ? a.in[I_CCTX] : a.in[I_C]; float acc = 0.f;
    for (int k = lane; k < DM; k += 64) { const float c = cv[k]; acc += c * sigm(c) * a.in[I_WADA][(size_t)l * DM * ADA_N + (size_t)k * ADA_N + j]; }
    acc = wave_sum(acc) + a.in[I_BADA][(size_t)l * ADA_N + j];
    const float got = ((const float*)(ws + WS_MOD))[(size_t)(l * 2 + s) * (NMODU * DM) + j];
    if (lane == 0 && dg_bad(got, acc, 1e-4f, 1e-4f)) dg_fail(ws, id);
    const int row = dg_hash(smp + 77777u) % MTOT, col = dg_hash(smp + 99991u) % DM; const int sx = row >= SEQ;
    const float xv = sx ? a.in[I_CTX][(size_t)(row - SEQ) * DM + col] : a.in[I_X][(size_t)row * DM + col];
    const float sh = mod_vec(ws, 0, sx, 0)[col], sc = mod_vec(ws, 0, sx, 1)[col];
    if (lane == 0 && (((const float*)(ws + WS_X))[(size_t)row * DM + col] != xv || dg_bad(bf2f(((const bf16*)(ws + WS_H))[(size_t)row * DM + col]), xv * (1.f + sc) + sh, 1e-2f, 1e-3f))) dg_fail(ws, id + 1);
}
__global__ void __launch_bounds__(256) dg_ln(Args a, int l, int which, int nrows, int final_out, int id) {
    unsigned char* ws = a.ws; const int lane = threadIdx.x & 63; const int smp = blockIdx.x * 4 + (threadIdx.x >> 6); const int row = dg_hash(smp + 31u * id) % nrows;
    const float* T = (const float*)(ws + WS_T) + (size_t)row * DM; float s = 0.f;
    for (int k = lane; k < DM; k += 64) s += T[k];
    const float mean = wave_sum(s) / DM; float q = 0.f;
    for (int k = lane; k < DM; k += 64) { const float d = T[k] - mean; q += d * d; }
    const float rstd = 1.0f / sqrtf(wave_sum(q) / DM + LN_EPS);
    const float* lg = a.in[I_LNG] + (size_t)(l * 3 + which) * DM; const float* lb = a.in[I_LNB] + (size_t)(l * 3 + which) * DM;
    const int ml = which == 2 ? l + 1 : l, mi = which == 2 ? 0 : 3, sx = row >= SEQ; bool bad = false;
    for (int k = lane; k < DM; k += 64) { const float y = (T[k] - mean) * rstd * lg[k] + lb[k];
        if (final_out) bad |= dg_bad(a.out[(size_t)row * DM + k], y, 1e-4f, 1e-4f);
        else { bad |= dg_bad(((const float*)(ws + WS_X))[(size_t)row * DM + k], y, 1e-4f, 1e-4f);
            const float h = y * (1.f + mod_vec(ws, ml, sx, mi + 1)[k]) + mod_vec(ws, ml, sx, mi)[k]; bad |= dg_bad(bf2f(((const bf16*)(ws + WS_H))[(size_t)row * DM + k]), h, 1e-2f, 2e-3f); } }
    if (bad) dg_fail(ws, id);
}
__global__ void __launch_bounds__(256) dg_attn(Args a, int l, int ntok, int id) {
    __shared__ float P[4][384];
    unsigned char* ws = a.ws; const int lane = threadIdx.x & 63, wv = threadIdx.x >> 6; const int smp = blockIdx.x * 4 + wv;
    const int tok = dg_hash(smp * 2 + 5u) % ntok, head = dg_hash(smp * 2 + 6u) % NH; const bf16* Z = (const bf16*)(ws + WS_ZIN);
    const float* rpb = a.in[I_RPB] + (size_t)l * NH * 15 * 31;
    const int r = tok / 64, c = tok % 64, r0 = min(max(r - 4, 0), 120), c0 = min(max(c - 8, 0), 48); const bool cx = tok >= SEQ; const int nk = cx ? 256 : 384;
    float mx = -1e30f;
    for (int kk = lane; kk < nk; kk += 64) { int kt; float bias = 0.f;
        if (!cx && kk < 128) { const int kr = r0 + kk / 16, kc = c0 + kk % 16; kt = kr * 64 + kc; bias = rpb[(head * 15 + (kr - r + 7)) * 31 + (kc - c + 15)]; } else kt = SEQ + (cx ? kk : kk - 128);
        float d = 0.f; for (int e = 0; e < 128; ++e) d += bf2f(Z[(size_t)tok * DIN + head * 128 + e]) * bf2f(Z[(size_t)kt * DIN + 1024 + head * 128 + e]);
        d = d * 0.08838834764831845f + bias; P[wv][kk] = d; mx = fmaxf(mx, d); }
    mx = wave_max(mx); float sum = 0.f;
    for (int kk = lane; kk < nk; kk += 64) { const float e = expf(P[wv][kk] - mx); P[wv][kk] = e; sum += e; }
    sum = wave_sum(sum); __syncthreads(); bool bad = false;
    for (int d = lane; d < 128; d += 64) { float o = 0.f;
        for (int kk = 0; kk < nk; ++kk) { int kt; if (!cx && kk < 128) kt = (r0 + kk / 16) * 64 + c0 + kk % 16; else kt = SEQ + (cx ? kk : kk - 128); o += P[wv][kk] * bf2f(Z[(size_t)kt * DIN + 2048 + head * 128 + d]); }
        o /= sum; bad |= dg_bad(bf2f(((const bf16*)(ws + WS_YALL))[(size_t)tok * DM + head * 128 + d]), o, 1e-2f, 2e-3f); }
    if (bad) dg_fail(ws, id);
}
__global__ void __launch_bounds__(256) dg_conv(Args a, int l, int ntok, int id) {
    unsigned char* ws = a.ws; const int lane = threadIdx.x & 63; const int smp = blockIdx.x * 4 + (threadIdx.x >> 6); const int tok = dg_hash(smp + 1234567u) % ntok;
    const bf16* Z = (const bf16*)(ws + WS_ZIN); const int base = tok >= SEQ ? SEQ : 0, len = tok >= SEQ ? CTX : SEQ, t = tok - base;
    float y[8]; float s = 0.f;
#pragma unroll
    for (int i = 0; i < 8; ++i) { const int ch = lane + 64 * i; float acc = a.in[I_BDW][l * DCONV + ch];
        for (int j = 0; j < CONVW; ++j) { const int tt = t + j - 15; if (tt >= 0 && tt < len) { const float av = bf2f(Z[(size_t)(base + tt) * DIN + 3584 + ch]), gv = bf2f(Z[(size_t)(base + tt) * DIN + 4096 + ch]); acc += av * sigm(gv) * a.in[I_WDW][(size_t)l * CONVW * DCONV + j * DCONV + ch]; } }
        y[i] = acc; s += acc; }
    const float mean = wave_sum(s) / DCONV; float q = 0.f;
#pragma unroll
    for (int i = 0; i < 8; ++i) { const float d = y[i] - mean; q += d * d; }
    const float rstd = 1.0f / sqrtf(wave_sum(q) / DCONV + LN_EPS); bool bad = false;
#pragma unroll
    for (int i = 0; i < 8; ++i) { const int ch = lane + 64 * i; const float z = (y[i] - mean) * rstd * a.in[I_CLNG][l * DCONV + ch] + a.in[I_CLNB][l * DCONV + ch];
        bad |= dg_bad(bf2f(((const bf16*)(ws + WS_YALL))[(size_t)tok * DM + 1536 + ch]), z * sigm(z), 1e-2f, 3e-3f); }
    if (bad) dg_fail(ws, id);
}
__global__ void __launch_bounds__(256) dg_four(Args a, int ntok, int id) {
    unsigned char* ws = a.ws; const int lane = threadIdx.x & 63; const int smp = blockIdx.x * 4 + (threadIdx.x >> 6);
    const int tok = smp == 0 ? 0 : (int)(dg_hash(smp + 424242u) % ntok), col = dg_hash(smp + 31337u) % DFOUR; const int grp = col / 128, cp = col % 128;
    const int base = tok >= SEQ ? SEQ : 0, N = tok >= SEQ ? CTX : SEQ, k = tok - base; const bf16* Z = (const bf16*)(ws + WS_ZIN);
    float acc = 0.f;
    for (int n = lane; n < N; n += 64) { const int pn = (int)(((long)n * k) % N);
        for (int c = 0; c < 128; ++c) { const float ang = 2.0f * (float)pn / (float)N + 2.0f * (float)((c * cp) & 127) / 128.0f; acc += bf2f(Z[(size_t)(base + n) * DIN + 3072 + grp * 128 + c]) * cospif(ang); } }
    acc = wave_sum(acc) / sqrtf((float)N * 128.f);
    if (lane == 0 && dg_bad(bf2f(((const bf16*)(ws + WS_YALL))[(size_t)tok * DM + 1024 + col]), acc, 2e-2f, 1e-2f)) dg_fail(ws, id);
}
__global__ void dg_final(Args a) { const unsigned* D = (const unsigned*)(a.ws + WS_CTL) + CW_DIAG; const unsigned d = D[0];
    if (d) { float code = (float)(200 - (int)d);
        a.out[0] = 1000.0f * code; } }
#endif

#ifndef DIAG_SKIP_FC
#define DIAG_SKIP_FC 0
#endif
#ifndef PH_MASK
#define PH_MASK 0xFFFFFFFFu
#endif
#define PH_ON(id) (((PH_MASK) >> (id)) & 1u)
constexpr int N_PHASES = 26;
__device__ __forceinline__ Ctx ctx_local(const Ctx& F) { Ctx L = F; asm volatile("" : "+v"(L.tid)); L.lane = L.tid & 63; return L; }

__device__ __forceinline__ void site_up(const Ctx& F, int l, int f, int nM) {
    const KAp ka = ka_opaque(); unsigned char* const ws = ka->ws; unsigned char* wl = ws + WS_W + (size_t)l * WL_SIZE;
    pg8::Gemm g{(const bf16*)(ws + WS_H), (const bf16*)(wl + (f == 0 ? WL_W13A : WL_W13B)), DM, DM, DM}; pg8::StaticOrder S; S.init(nM, 2 * DFF / 256, F.G, F.bx);
    pg8::EpiSwiGLU E{(bf16*)(ws + WS_G), DFF};
    pg8::gemm_phase<pg8::EpiSwiGLU, pg8::StaticOrder, true, true>(F.lds + RING_OFF, g, S, E);
}
__device__ __forceinline__ void site_down(const Ctx& F, int l, int f, int nM) {
    const KAp ka = ka_opaque(); unsigned char* const ws = ka->ws; unsigned char* wl = ws + WS_W + (size_t)l * WL_SIZE;
    const int gi = f == 0 ? 2 : 5;
    pg8::Gemm g{(const bf16*)(ws + WS_G), (const bf16*)(wl + (f == 0 ? WL_W2A : WL_W2B)), DFF, DFF, DFF}; pg8::StaticOrder S; S.init(nM, DM / 256, F.G, F.bx);
    pg8::EpiResid E{(const float*)(ws + WS_X), (float*)(ws + WS_T), DM, mod_vec(ws, l, 0, gi), mod_vec(ws, l, 1, gi), 0.5f, ALPHA};
    pg8::gemm_phase<pg8::EpiResid, pg8::StaticOrder, true, true>(F.lds + RING_OFF, g, S, E);
}
__device__ __forceinline__ void site_ln(const Ctx& F0, int l, int which, int nrows, bool final_out) {
    const Ctx F = ctx_local(F0);
    const KAp ka = ka_opaque(); unsigned char* const ws = ka->ws;
    const float* lg = ka->in[I_LNG] + (size_t)(l * 3 + which) * DM; const float* lb = ka->in[I_LNB] + (size_t)(l * 3 + which) * DM;
    const int ml = which == 2 ? l + 1 : l, mi = which == 2 ? 0 : 3;
    if (final_out) ln_phase(F, (const float*)(ws + WS_T), ka->out, nullptr, lg, lb, nullptr, nullptr, nullptr, nullptr, nrows);
    else ln_phase(F, (const float*)(ws + WS_T), (float*)(ws + WS_X), (bf16*)(ws + WS_H), lg, lb, mod_vec(ws, ml, 0, mi), mod_vec(ws, ml, 0, mi + 1), mod_vec(ws, ml, 1, mi), mod_vec(ws, ml, 1, mi + 1), nrows);
}
__device__ __forceinline__ void site_in(const Ctx& F, int l) {
    const KAp ka = ka_opaque(); unsigned char* const ws = ka->ws; unsigned char* wl = ws + WS_W + (size_t)l * WL_SIZE;
    pg8::Gemm g{(const bf16*)(ws + WS_H), (const bf16*)(wl + WL_WIN), DM, DM, DM}; pg8::StaticOrder S; S.init(33, DIN / 256, F.G, F.bx);
    pg8::EpiBf16<0> E{(bf16*)(ws + WS_ZIN), DIN, nullptr};
    pg8::gemm_phase<pg8::EpiBf16<0>, pg8::StaticOrder, true, true>(F.lds + RING_OFF, g, S, E);
}
__device__ __forceinline__ void site_mix(const Ctx& F0, int l, bool last) {
    const Ctx F = ctx_local(F0);
    const KAp ka = ka_opaque(); unsigned char* const ws = ka->ws;
    const bf16* ZIN = (const bf16*)(ws + WS_ZIN); bf16* YALL = (bf16*)(ws + WS_YALL); float* FY = (float*)(ws + WS_FY);
    const int nFAB = last ? 512 : 1024, nConv = last ? 256 : 264, nAtt = last ? SEQ : MTOT;
    const float* rpb = ka->in[I_RPB] + (size_t)l * NH * (2 * WIN_R - 1) * (2 * WIN_C - 1);
    const float* wdw = ka->in[I_WDW] + (size_t)l * CONVW * DCONV; const float* bdw = ka->in[I_BDW] + (size_t)l * DCONV;
    const float* clg = ka->in[I_CLNG] + (size_t)l * DCONV; const float* clb = ka->in[I_CLNB] + (size_t)l * DCONV;
    for (int it = F.bx; it < nFAB + nConv + nAtt; it += F.G) {
        int r = it;
        if (r < nFAB) { const bool cx = r >= 512; const int rr = r & 511; fourAB_item_v1(F, ZIN, FY, cx ? SEQ : 0, cx ? CTX / GRID_W : NROWS, rr & 63, (rr >> 6) & 3, rr >> 8); continue; }
        r -= nFAB;
        if (r < nConv) { const bool cx = r >= 256; conv_item_v1(F, ZIN, YALL, wdw, bdw, clg, clb, cx ? SEQ : 0, cx ? CTX : SEQ, (cx ? r - 256 : r) * 32); continue; }
        r -= nConv;
        attn_item_v1(ZIN, YALL, rpb, r, F.wave, (LAS float*)(F.lds + RING_OFF + F.wave * 2048), F.lane);
    }
}
__device__ __forceinline__ void site_gate(const Ctx& F, int l, bool last) {
    const KAp ka = ka_opaque(); unsigned char* const ws = ka->ws; unsigned char* wl = ws + WS_W + (size_t)l * WL_SIZE;
    pg8::Gemm g{(const bf16*)(ws + WS_H), (const bf16*)(wl + WL_WG), DM, DM, DM}; pg8::StaticOrder S; S.init(last ? 32 : 33, 3 * DM / 256, F.G, F.bx);
    pg8::EpiBf16<1> E{(bf16*)(ws + WS_GATES), 3 * DM, ka->in[I_BGATE] + (size_t)l * 3 * DM};
    pg8::gemm_phase<pg8::EpiBf16<1>, pg8::StaticOrder, true, true>(F.lds + RING_OFF, g, S, E);
    const int nFC = last ? 512 : 528;
    for (int it = F.bx; it < (DIAG_SKIP_FC ? 0 : nFC); it += F.G) { const bool cx = it >= 512; const int rr = cx ? it - 512 : it;
        fourC_item_v1(F, (const float*)(ws + WS_FY), (bf16*)(ws + WS_YALL), cx ? SEQ : 0, cx ? CTX / GRID_W : NROWS, cx ? (rr & 3) : (rr & 127), cx ? (rr >> 2) : (rr >> 7)); }
}
__device__ __forceinline__ void site_branch(const Ctx& F, int l, bool last) {
    const KAp ka = ka_opaque(); unsigned char* const ws = ka->ws; unsigned char* wl = ws + WS_W + (size_t)l * WL_SIZE;
    pg8::Gemm g{(const bf16*)(ws + WS_YALL), (const bf16*)(wl + WL_WB), DM, DM, DM}; pg8::StaticOrder S; S.init(last ? 32 : 33, DM / 256, F.G, F.bx);
    pg8::EpiBranch E{(bf16*)(ws + WS_MB), DM, (const bf16*)(ws + WS_GATES), 3 * DM};
    pg8::gemm_phase<pg8::EpiBranch, pg8::StaticOrder, true, true>(F.lds + RING_OFF, g, S, E);
}
__device__ __forceinline__ void site_o(const Ctx& F, int l, bool last) {
    const KAp ka = ka_opaque(); unsigned char* const ws = ka->ws; unsigned char* wl = ws + WS_W + (size_t)l * WL_SIZE;
    pg8::Gemm g{(const bf16*)(ws + WS_MB), (const bf16*)(wl + WL_WO), DM, DM, DM}; pg8::StaticOrder S; S.init(last ? 32 : 33, DM / 256, F.G, F.bx);
    pg8::EpiResid E{(const float*)(ws + WS_X), (float*)(ws + WS_T), DM, mod_vec(ws, l, 0, 5), mod_vec(ws, l, 1, 5), 1.0f, ALPHA};
    pg8::gemm_phase<pg8::EpiResid, pg8::StaticOrder, true, true>(F.lds + RING_OFF, g, S, E);
}

__global__ void __launch_bounds__(NWAVES * 64, 2) mk_fwd(Args args) {
    extern __shared__ __attribute__((aligned(16))) unsigned char lds[];
    Ctx F;
    F.lds = (LAS unsigned char*)lds; F.tid = threadIdx.x; F.lane = F.tid & 63; F.wave = __builtin_amdgcn_readfirstlane(F.tid >> 6);
    F.bx = blockIdx.x; F.G = gridDim.x; F.gw = F.bx * NWAVES + F.wave; F.NGW = F.G * NWAVES;
    volatile LAS unsigned* MISC = (volatile LAS unsigned*)(F.lds + MISC_OFF);
    for (int u = F.tid; u < (LDS_BYTES - LDSCTL_OFF) / 4; u += NWAVES * 64) ((LAS unsigned*)(F.lds + LDSCTL_OFF))[u] = 0u;
    __syncthreads();
    unsigned* barw = (unsigned*)(args.ws + WS_CTL) + CW_BAR;
    XcdBarrier bar; bar.bar = barw; bar.x = 0; bar.st = nullptr;
    if (args.use_bar) bar = xcd_barrier_post(barw, MISC + 8);
    const int lo = args.ph_lo, hi = args.ph_hi;
#define IN(k) (lo <= (k) && (k) < hi)
#define SEAM(k) do { if (IN(k) && IN((k) + 1)) xcd_barrier(bar); } while (0)

    if (PH_ON(0)) { if (IN(0)) p0_prologue(ctx_local(F)); }
    SEAM(0);
    if (PH_ON(1)) { if (IN(1)) p1_prologue(ctx_local(F)); }
    SEAM(1);

    for (int hl = 0; hl < 2 * DEPTH; ++hl) {
        const int l = hl >> 1, f = hl & 1; const bool last = (l == DEPTH - 1);
        const int pb = 2 + 3 * hl + 6 * ((hl + 1) >> 1);
        const int nMf = (last && f == 1) ? 32 : 33;
        if (PH_ON(2)) { if (IN(pb + 0)) site_up(F, l, f, nMf); }
        SEAM(pb + 0);
        if (PH_ON(3)) { if (IN(pb + 1)) site_down(F, l, f, nMf); }
        SEAM(pb + 1);
        if (PH_ON(4)) { if (IN(pb + 2)) site_ln(F, l, f == 0 ? 0 : 2, (last && f == 1) ? SEQ : MTOT, last && f == 1); }
        if (!(last && f == 1)) SEAM(pb + 2);
        if (f == 1) continue;
        const int mb = pb + 3;
        if (PH_ON(5)) { if (IN(mb + 0)) site_in(F, l); }
        SEAM(mb + 0);
        if (PH_ON(6)) { if (IN(mb + 1)) site_mix(F, l, last); }
        SEAM(mb + 1);
        if (PH_ON(7)) { if (IN(mb + 2)) site_gate(F, l, last); }
        SEAM(mb + 2);
        if (PH_ON(8)) { if (IN(mb + 3)) site_branch(F, l, last); }
        SEAM(mb + 3);
        if (PH_ON(9)) { if (IN(mb + 4)) site_o(F, l, last); }
        SEAM(mb + 4);
        if (PH_ON(10)) { if (IN(mb + 5)) site_ln(F, l, 1, last ? SEQ : MTOT, false); }
        SEAM(mb + 5);
    }
#undef IN
#undef SEAM
}

extern "C" void kernel_launch(void* const* d_in, const int* in_sizes, int n_in, void* d_out, int out_size, void* d_ws, size_t ws_size, hipStream_t stream) {
    static int grid = 0;
    if (grid == 0) {
        if (n_in != N_IN || in_sizes[0] != SEQ * DM || out_size != SEQ * DM || ws_size < WS_END) { fprintf(stderr, "kernel_launch: unexpected shapes (n_in %d, in0 %d, out %d, ws %zu); nothing launched\n", n_in, n_in > 0 ? in_sizes[0] : -1, out_size, ws_size); grid = -1; return; }
        int dev = 0, cus = 0, per_cu = 0;
        if (hipGetDevice(&dev) != hipSuccess || hipDeviceGetAttribute(&cus, hipDeviceAttributeMultiprocessorCount, dev) != hipSuccess) { grid = -1; return; }
        if (hipFuncSetAttribute((const void*)mk_fwd, hipFuncAttributeMaxDynamicSharedMemorySize, LDS_BYTES) != hipSuccess) { fprintf(stderr, "kernel_launch: hipFuncSetAttribute failed\n"); grid = -1; return; }
        if (hipOccupancyMaxActiveBlocksPerMultiprocessor(&per_cu, (const void*)mk_fwd, NWAVES * 64, LDS_BYTES) != hipSuccess || per_cu < 1) fprintf(stderr, "kernel_launch: note: occupancy query reports %d\n", per_cu);
        (void)hipGetLastError();
        grid = cus;
    }
    if (grid < 0) return;
    if (hipMemsetAsync((char*)d_ws + WS_CTL, 0, CTL_ZERO_BYTES, stream) != hipSuccess) return;
    Args a{};
    for (int i = 0; i < N_IN; ++i) a.in[i] = (const float*)d_in[i];
    a.out = (float*)d_out; a.ws = (unsigned char*)d_ws; a.pad = 0;
#if MK_PER_PHASE
    for (int k = 0; k < N_PHASES; ++k) { a.ph_lo = k; a.ph_hi = k + 1; a.use_bar = 0; hipLaunchKernelGGL(mk_fwd, dim3(grid), dim3(NWAVES * 64), LDS_BYTES, stream, a);
#if MK_DIAG
        const int id = 2 * k + 4;
        if (k == 0) hipLaunchKernelGGL(dg_trans, dim3(4096), dim3(256), 0, stream, a, id);
        else if (k == 1) hipLaunchKernelGGL(dg_mod, dim3(1024), dim3(256), 0, stream, a, id);
        else for (int hl = 0; hl < 2 * DEPTH; ++hl) { const int pb = 2 + 3 * hl + 6 * ((hl + 1) >> 1), l = hl >> 1, f = hl & 1; const bool last = l == DEPTH - 1;
            const int nMf = (last && f == 1) ? 32 : 33, nMm = last ? 32 : 33; int type = -1;
            if (k >= pb && k <= pb + 2) type = k - pb; else if (f == 0 && k >= pb + 3 && k <= pb + 8) type = k - pb;
            if (type == 0) hipLaunchKernelGGL(dg_gemm, dim3(2048), dim3(256), 0, stream, a, 0, l, f, nMf * 256, id, 0.f, 0);
            if (type == 1) hipLaunchKernelGGL(dg_gemm, dim3(2048), dim3(256), 0, stream, a, 1, l, f, nMf * 256, id, 0.5f, f == 0 ? 2 : 5);
            if (type == 2) hipLaunchKernelGGL(dg_ln, dim3(512), dim3(256), 0, stream, a, l, f == 0 ? 0 : 2, (last && f == 1) ? SEQ : MTOT, (last && f == 1) ? 1 : 0, id);
            if (type == 3) hipLaunchKernelGGL(dg_gemm, dim3(2048), dim3(256), 0, stream, a, 2, l, 0, MTOT, id, 0.f, 0);
            if (type == 4) { hipLaunchKernelGGL(dg_attn, dim3(1024), dim3(256), 0, stream, a, l, last ? SEQ : MTOT, id); hipLaunchKernelGGL(dg_conv, dim3(1024), dim3(256), 0, stream, a, l, last ? SEQ : MTOT, id + 1); }
            if (type == 5) { hipLaunchKernelGGL(dg_gemm, dim3(2048), dim3(256), 0, stream, a, 3, l, 0, nMm * 256, id, 0.f, 0); hipLaunchKernelGGL(dg_four, dim3(64), dim3(256), 0, stream, a, last ? SEQ : MTOT, id + 1); }
            if (type == 6) hipLaunchKernelGGL(dg_gemm, dim3(2048), dim3(256), 0, stream, a, 4, l, 0, nMm * 256, id, 0.f, 0);
            if (type == 7) hipLaunchKernelGGL(dg_gemm, dim3(2048), dim3(256), 0, stream, a, 1, l, 0, nMm * 256, id, 1.0f, 5);
            if (type == 8) hipLaunchKernelGGL(dg_ln, dim3(512), dim3(256), 0, stream, a, l, 1, nMm * 256, 0, id);
        }
#endif
    }
#if MK_DIAG
    hipLaunchKernelGGL(dg_final, dim3(1), dim3(1), 0, stream, a);
#endif
#else
    a.ph_lo = 0; a.ph_hi = N_PHASES; a.use_bar = 1;
    hipLaunchKernelGGL(mk_fwd, dim3(grid), dim3(NWAVES * 64), LDS_BYTES, stream, a);
#endif
    const hipError_t le = hipPeekAtLastError();
    if (le != hipSuccess) fprintf(stderr, "kernel_launch: launch failed: %s\n", hipGetErrorName(le));
}
```

```cpp
#include <hip/hip_runtime.h>
#include <cstdio>
#include <cstdint>

#ifndef MK_DIAG
#define MK_DIAG 0
#endif
#ifndef DIAG_PREC
#define DIAG_PREC 0
#endif
#ifndef MK_STAMP
#define MK_STAMP 0
#endif
#ifndef MK_PER_PHASE
#define MK_PER_PHASE 0
#endif

__device__ __forceinline__ int hw_lane() { int l; asm volatile("v_mbcnt_lo_u32_b32 %0, -1, 0\n\tv_mbcnt_hi_u32_b32 %0, -1, %0" : "=v"(l)); return l; }
namespace pg8 {
#define PG8_LAS __attribute__((address_space(3)))
typedef unsigned short bf16_t;
typedef short bf16x8 __attribute__((ext_vector_type(8)));
typedef float f32x4 __attribute__((ext_vector_type(4)));
typedef unsigned u32x4 __attribute__((ext_vector_type(4)));
constexpr int BM = 256, BK = 64, HALF = 128, HTB = HALF * BK * 2  , STAGE_BYTES = 8 * HTB, NXCD = 8, WGM = 8;

__host__ __device__ __forceinline__ int lds_byte(int r, int c) { const int st = (r >> 4) * 2 + (c >> 5), rr = r & 15, cc = c & 31, ob = rr * 64 + cc * 2; return st * 1024 + (ob ^ (((ob >> 9) & 1) << 5)); }
__host__ __device__ __forceinline__ void stage_rc(int b, int& R, int& C) { const int st = b / 1024, sb = b % 1024, swz = sb ^ (((sb >> 9) & 1) << 5); R = (st >> 1) * 16 + swz / 64; C = (st & 1) * 32 + (swz % 64) / 2; }
__host__ __device__ __forceinline__ int perm32(int rho) { const int n = rho >> 4, i = rho & 15; return 8 * (i >> 2) + 4 * n + (i & 3); }

struct Unit { int pm, pn, kt0, nt, job; };
struct Gemm { const bf16_t* A; const bf16_t* Bt; long dA1, dB1; int lda, ldb; };

struct StaticOrder {
    int nM, nN, nwg, G, c, ntK;
    __host__ __device__ void init(int nM_, int nN_, int G_, int c_, int ntK_) { nM = nM_; nN = nN_; nwg = nM * nN; G = G_; c = c_; ntK = ntK_; }
    __host__ __device__ __forceinline__ void map(int L, int& pm, int& pn) const {
        int wgid = L; { const int q = nwg / NXCD, r = nwg % NXCD, xcd = wgid % NXCD, off = wgid / NXCD; wgid = (xcd < r ? xcd * (q + 1) : r * (q + 1) + (xcd - r) * q) + off; }
        const int nig = WGM * nN, gid = wgid / nig, fm = gid * WGM, gsz = (nM - fm) < WGM ? (nM - fm) : WGM;
        pm = fm + ((wgid % nig) % gsz); pn = (wgid % nig) / gsz;
    }
    __host__ __device__ __forceinline__ bool next(int i, Unit& u) const {
        const long L = (long)i * G + c; const bool ok = L < nwg; int pm = 0, pn = 0; if (ok) map((int)L, pm, pn);
        u.pm = pm; u.pn = pn; u.kt0 = 0; u.nt = ntK; u.job = 0; return ok;
    }
    __device__ __forceinline__ void a_ready(const Unit&) const {}
    __device__ __forceinline__ void done(const Unit&) const {}
};
struct OrderPlus {
    StaticOrder base, ext; int chunks, ntc, pmx;
    __host__ __device__ __forceinline__ bool next(int i, Unit& u) const {
        const long L = (long)i * base.G + base.c; int pm = 0, pn = 0, kt0 = 0, nt = base.ntK, job = 0; bool ok = true;
        if (L < base.nwg) base.map((int)L, pm, pn);
        else { const int q = (int)(L - base.nwg); ok = q < ext.nwg * chunks; if (ok) ext.map(q / chunks, pm, pn); pm += pmx; kt0 = (q % chunks) * ntc; nt = ntc; job = 1; }
        u.pm = pm; u.pn = pn; u.kt0 = kt0; u.nt = nt; u.job = job; return ok;
    }
    __device__ __forceinline__ void a_ready(const Unit&) const {}
    __device__ __forceinline__ void done(const Unit&) const {}
};

typedef float f32x2_t __attribute__((ext_vector_type(2))); typedef __bf16 bf16x2_t __attribute__((ext_vector_type(2)));
__device__ __forceinline__ unsigned cvt_pk_bf16(float lo, float hi) { const f32x2_t v = {lo, hi}; const bf16x2_t b = __builtin_convertvector(v, bf16x2_t); return __builtin_bit_cast(unsigned, b); }
__device__ __forceinline__ float sigmoid_f(float x) { return __builtin_amdgcn_rcpf(1.0f + __builtin_amdgcn_exp2f(-1.4426950408889634f * x)); }
__device__ __forceinline__ float bf_lo(unsigned w) { return __builtin_bit_cast(float, w << 16); }
__device__ __forceinline__ float bf_hi(unsigned w) { return __builtin_bit_cast(float, w & 0xffff0000u); }
constexpr int CTX_PM = 32;

struct EpiSwiGLU {
    static constexpr bool PERM = true, AFTER_DRAIN = false, MIDK = false; static constexpr int T1 = 0, T2 = 0, NST = 8;
    bf16_t* O; int ldc;
    __device__ __forceinline__ void mid(f32x4 (&)[2][2][4][2], const Unit&, int, int, int, int, int) const {}
    __device__ __forceinline__ void operator()(const f32x4 (&acc)[2][2][4][2], const Unit& u, int wr, int wc, int fr, int fq) const {
        const int row0 = u.pm * BM + wr * 64 + fr, col0 = u.pn * HALF + wc * 32 + 8 * fq;
#pragma unroll
        for (int ai = 0; ai < 2; ++ai)
#pragma unroll
            for (int m = 0; m < 4; ++m) {
                bf16_t* rowp = O + (size_t)(row0 + ai * HALF + m * 16) * ldc + col0;
                float g[8];
#pragma unroll
                for (int n = 0; n < 2; ++n)
#pragma unroll
                    for (int j = 0; j < 4; ++j) { const float a = acc[ai][0][m][n][j], b = acc[ai][1][m][n][j]; g[n * 4 + j] = a * sigmoid_f(a) * b; }
                u32x4 w; w.x = cvt_pk_bf16(g[0], g[1]); w.y = cvt_pk_bf16(g[2], g[3]); w.z = cvt_pk_bf16(g[4], g[5]); w.w = cvt_pk_bf16(g[6], g[7]);
                *(u32x4*)rowp = w; }
    }
};
struct EpiDelta {
    static constexpr bool PERM = true, AFTER_DRAIN = false, MIDK = false; static constexpr int T1 = 0, T2 = 0, NST = 16;
    bf16_t* D; int ldc; const float* gate_lat; const float* gate_ctx; float gmul; long part_off;
    __device__ __forceinline__ void mid(f32x4 (&)[2][2][4][2], const Unit&, int, int, int, int, int) const {}
    __device__ __forceinline__ void operator()(const f32x4 (&acc)[2][2][4][2], const Unit& u, int wr, int wc, int fr, int fq) const {
        const int row0 = u.pm * BM + wr * 64 + fr, col0 = u.pn * BM + wc * 32 + 8 * fq;
        const long joff = (long)u.job * (part_off + ((long)(u.kt0 / u.nt) - u.pm) * BM * ldc);
        const float gm = u.job ? 0.f : gmul, g1 = u.job ? 1.f : 0.f;
        const float* gv = (u.pm >= CTX_PM) ? gate_ctx : gate_lat;
        f32x4 gg[2][2];
#pragma unroll
        for (int bj = 0; bj < 2; ++bj)
#pragma unroll
            for (int n = 0; n < 2; ++n) gg[bj][n] = *(const f32x4*)(gv + col0 + bj * HALF + 4 * n) * gm + g1;
#pragma unroll
        for (int ai = 0; ai < 2; ++ai)
#pragma unroll
            for (int m = 0; m < 4; ++m) { bf16_t* rowp = D + joff + (size_t)(row0 + ai * HALF + m * 16) * ldc + col0;
#pragma unroll
                for (int bj = 0; bj < 2; ++bj) { const f32x4 v0 = acc[ai][bj][m][0] * gg[bj][0], v1 = acc[ai][bj][m][1] * gg[bj][1];
                    u32x4 w; w.x = cvt_pk_bf16(v0[0], v0[1]); w.y = cvt_pk_bf16(v0[2], v0[3]); w.z = cvt_pk_bf16(v1[0], v1[1]); w.w = cvt_pk_bf16(v1[2], v1[3]);
                    *(u32x4*)(rowp + bj * HALF) = w; } }
    }
};
template <int ACT> struct EpiBf16 {
    static constexpr bool PERM = true, AFTER_DRAIN = false, MIDK = false; static constexpr int T1 = 0, T2 = 0, NST = 16;
    bf16_t* O; int ldc; const float* bias; bf16_t* O1; int ldc1;
    __device__ __forceinline__ void mid(f32x4 (&)[2][2][4][2], const Unit&, int, int, int, int, int) const {}
    __device__ __forceinline__ void operator()(const f32x4 (&acc)[2][2][4][2], const Unit& u, int wr, int wc, int fr, int fq) const {
        if constexpr (ACT == 2) { if (u.job) { EpiBf16<1> e{O1, ldc1, bias, nullptr, 0}; e(acc, u, wr, wc, fr, fq); } else { EpiBf16<0> e{O, ldc, nullptr, nullptr, 0}; e(acc, u, wr, wc, fr, fq); } return; } else {
        const int row0 = u.pm * BM + wr * 64 + fr, col0 = u.pn * BM + wc * 32 + 8 * fq;
        f32x4 bv[2][2];
#pragma unroll
        for (int bj = 0; bj < 2; ++bj)
#pragma unroll
            for (int n = 0; n < 2; ++n) bv[bj][n] = bias ? *(const f32x4*)(bias + col0 + bj * HALF + 4 * n) : (f32x4){0.f, 0.f, 0.f, 0.f};
#pragma unroll
        for (int ai = 0; ai < 2; ++ai)
#pragma unroll
            for (int m = 0; m < 4; ++m) { bf16_t* rowp = O + (size_t)(row0 + ai * HALF + m * 16) * ldc + col0;
#pragma unroll
                for (int bj = 0; bj < 2; ++bj) { f32x4 v0 = acc[ai][bj][m][0] + bv[bj][0], v1 = acc[ai][bj][m][1] + bv[bj][1];
                    if (ACT == 1) {
#pragma unroll
                        for (int j = 0; j < 4; ++j) { v0[j] = sigmoid_f(v0[j]); v1[j] = sigmoid_f(v1[j]); } }
                    u32x4 w; w.x = cvt_pk_bf16(v0[0], v0[1]); w.y = cvt_pk_bf16(v0[2], v0[3]); w.z = cvt_pk_bf16(v1[0], v1[1]); w.w = cvt_pk_bf16(v1[2], v1[3]);
                    *(u32x4*)(rowp + bj * HALF) = w; } }
        }
    }
};
struct EpiBranch {
    static constexpr bool PERM = true, AFTER_DRAIN = false, MIDK = true; static constexpr int T1 = 16, T2 = 24, NST = 16;
    bf16_t* O; int ldc; const bf16_t* gates; int ldg;
    __device__ __forceinline__ static void ld8(const bf16_t* p, float (&g)[8]) { const u32x4 w = *(const u32x4*)p;
        g[0] = bf_lo(w.x); g[1] = bf_hi(w.x); g[2] = bf_lo(w.y); g[3] = bf_hi(w.y); g[4] = bf_lo(w.z); g[5] = bf_hi(w.z); g[6] = bf_lo(w.w); g[7] = bf_hi(w.w);
#pragma unroll
        for (int j = 0; j < 8; ++j) g[j] = fmaxf(g[j], 1e-20f); }
    __device__ __forceinline__ void mid(f32x4 (&acc)[2][2][4][2], const Unit& u, int t, int wr, int wc, int fr, int fq) const {
        int row0 = u.pm * BM + wr * 64 + fr; asm volatile("" : "+v"(row0));
        const int col0 = u.pn * BM + wc * 32 + 8 * fq;
        const int bnum = (t == T1) ? 0 : 1;
#pragma unroll
        for (int ai = 0; ai < 2; ++ai)
#pragma unroll
            for (int m = 0; m < 4; ++m) { const bf16_t* gp = gates + (size_t)(row0 + ai * HALF + m * 16) * ldg + col0 + bnum * 2048;
#pragma unroll
                for (int bj = 0; bj < 2; ++bj) { float gn[8], gd[8]; ld8(gp + bj * HALF, gn); ld8(gp + bj * HALF + 2048, gd);
#pragma unroll
                    for (int n = 0; n < 2; ++n)
#pragma unroll
                        for (int j = 0; j < 4; ++j) acc[ai][bj][m][n][j] *= gn[n * 4 + j] * __builtin_amdgcn_rcpf(gd[n * 4 + j]); }
                if (m == 3) asm volatile("" ::: "memory"); }
    }
    __device__ __forceinline__ void operator()(const f32x4 (&acc)[2][2][4][2], const Unit& u, int wr, int wc, int fr, int fq) const {
        const int row0 = u.pm * BM + wr * 64 + fr, col0 = u.pn * BM + wc * 32 + 8 * fq;
#pragma unroll
        for (int ai = 0; ai < 2; ++ai)
#pragma unroll
            for (int m = 0; m < 4; ++m) { const size_t r = (size_t)(row0 + ai * HALF + m * 16); const bf16_t* gp = gates + r * ldg + col0 + 2 * 2048; bf16_t* rowp = O + r * ldc + col0;
#pragma unroll
                for (int bj = 0; bj < 2; ++bj) { float g2[8]; ld8(gp + bj * HALF, g2);
                    const f32x4 v0 = acc[ai][bj][m][0], v1 = acc[ai][bj][m][1];
                    u32x4 w; w.x = cvt_pk_bf16(v0[0] * g2[0], v0[1] * g2[1]); w.y = cvt_pk_bf16(v0[2] * g2[2], v0[3] * g2[3]); w.z = cvt_pk_bf16(v1[0] * g2[4], v1[1] * g2[5]); w.w = cvt_pk_bf16(v1[2] * g2[6], v1[3] * g2[7]);
                    *(u32x4*)(rowp + bj * HALF) = w; }
                }
    }
};
template <class Epi, class Sched, bool ALIGN_EPI = false, bool SP2 = false>
__device__ __forceinline__ void gemm_phase(PG8_LAS unsigned char* lds, const Gemm g, const Sched& S, const Epi& E, int wave_id) {
    int tid_ = (wave_id << 6) | hw_lane();
    const int tid = tid_, wid = __builtin_amdgcn_readfirstlane(tid >> 6), lane = tid & 63, wr = wid >> 2, wc = wid & 3, fr = lane & 15, fq = lane >> 4;
    unsigned voffA[2], voffB[2];
#pragma unroll
    for (int i = 0; i < 2; ++i) { int R, C; stage_rc(tid * 16 + i * 8192, R, C); const int Rb = Epi::PERM ? ((R & ~31) + perm32(R & 31)) : R;
        voffA[i] = (unsigned)(R * g.lda + C) * 2u; voffB[i] = (unsigned)(Rb * g.ldb + C) * 2u; }
    const size_t kstep = (size_t)(BK * 2);
    const size_t hstepA = (size_t)HALF * g.lda * 2, hstepB = (size_t)HALF * g.ldb * 2;
    const size_t tstepA = 2 * hstepA, tstepB = 2 * hstepB;
    const unsigned ldsw = (unsigned)wid * 1024u;
    const int aoff = lds_byte(wr * 64 + fr, fq * 8), boff = lds_byte(wc * 32 + fr, fq * 8);
#define PG8_SA(b, h) (((b) * 2 + (h)) * HTB)
#define PG8_SB(b, h) ((4 + (b) * 2 + (h)) * HTB)
#define PG8_STAGE(bufoff, gbase, voff) do { _Pragma("unroll") for (int _i = 0; _i < 2; ++_i) \
        __builtin_amdgcn_global_load_lds((const unsigned*)((const char*)(gbase) + (voff)[_i]), (PG8_LAS unsigned*)(lds + (bufoff) + ldsw + _i * 8192), 16, 0, 0); } while (0)
#define PG8_LDA(dst, b, h) do { _Pragma("unroll") for (int m = 0; m < 4; ++m) _Pragma("unroll") for (int k = 0; k < 2; ++k) dst[m][k] = *(const PG8_LAS bf16x8*)(lds + PG8_SA(b, h) + aoff + m * 2048 + k * 1024); } while (0)
#define PG8_LDB(dst, b, h) do { _Pragma("unroll") for (int n = 0; n < 2; ++n) _Pragma("unroll") for (int k = 0; k < 2; ++k) dst[n][k] = *(const PG8_LAS bf16x8*)(lds + PG8_SB(b, h) + boff + n * 2048 + k * 1024); } while (0)
#define PG8_MMA(ai, bj, At, Bt) do { __builtin_amdgcn_s_setprio(1); _Pragma("unroll") for (int m = 0; m < 4; ++m) _Pragma("unroll") for (int n = 0; n < 2; ++n) _Pragma("unroll") for (int k = 0; k < 2; ++k) \
        acc[ai][bj][m][n] = __builtin_amdgcn_mfma_f32_16x16x32_bf16(Bt[n][k], At[m][k], acc[ai][bj][m][n], 0, 0, 0); __builtin_amdgcn_s_setprio(0); } while (0)
#define PG8_WAIT_V(n) asm volatile("s_waitcnt vmcnt(" #n ")" ::: "memory")
#define PG8_WAIT_L(n) asm volatile("s_waitcnt lgkmcnt(" #n ")" ::: "memory")
#define PG8_BAR __builtin_amdgcn_s_barrier()
#define PG8_SCHED __builtin_amdgcn_sched_barrier(0)
    Unit cur, nxt; int ui = 0;
    if (!S.next(0, cur)) return;
    f32x4 acc[2][2][4][2];
#pragma unroll
    for (int a = 0; a < 2; ++a)
#pragma unroll
        for (int b = 0; b < 2; ++b)
#pragma unroll
            for (int m = 0; m < 4; ++m)
#pragma unroll
                for (int n = 0; n < 2; ++n) acc[a][b][m][n] = (f32x4){0.f, 0.f, 0.f, 0.f};
    bf16x8 At[4][2], B0[2][2], B1[2][2];
#define PG8_UA(u) ((const char*)g.A + (long)(u).job * g.dA1 + (size_t)(u).pm * tstepA + (size_t)(u).kt0 * kstep)
#define PG8_UB(u) ((const char*)g.Bt + (long)(u).job * g.dB1 + (size_t)(u).pn * tstepB + (size_t)(u).kt0 * kstep)
    const char* cA = PG8_UA(cur); const char* cB = PG8_UB(cur);
    S.a_ready(cur);
    if constexpr (SP2) {
        PG8_STAGE(PG8_SB(0, 0), cB, voffB); PG8_STAGE(PG8_SB(0, 1), cB + hstepB, voffB); PG8_STAGE(PG8_SA(0, 0), cA, voffA); PG8_STAGE(PG8_SA(0, 1), cA + hstepA, voffA);
        if (wr == 1) PG8_BAR;
        PG8_WAIT_V(2); PG8_BAR;
        PG8_STAGE(PG8_SB(1, 0), cB + kstep, voffB); PG8_STAGE(PG8_SA(1, 0), cA + kstep, voffA); PG8_STAGE(PG8_SB(1, 1), cB + hstepB + kstep, voffB);
        PG8_WAIT_V(6); PG8_BAR;
    } else {
        PG8_STAGE(PG8_SB(0, 0), cB, voffB); PG8_STAGE(PG8_SA(0, 0), cA, voffA); PG8_STAGE(PG8_SB(0, 1), cB + hstepB, voffB); PG8_STAGE(PG8_SA(0, 1), cA + hstepA, voffA);
        if (wr == 1) PG8_BAR;
        PG8_WAIT_V(4); PG8_BAR;
        PG8_STAGE(PG8_SB(1, 0), cB + kstep, voffB); PG8_STAGE(PG8_SA(1, 0), cA + kstep, voffA); PG8_STAGE(PG8_SB(1, 1), cB + hstepB + kstep, voffB);
        PG8_WAIT_V(6); PG8_BAR;
    }
    for (;;) {
        const bool has_next = S.next(ui + 1, nxt);
        const char* nA = has_next ? PG8_UA(nxt) : cA; const char* nB = has_next ? PG8_UB(nxt) : cB;
        const int nt = cur.nt;
        for (int t = 0; t < nt; t += 2) {
            if constexpr (Epi::MIDK) { if (t == Epi::T1 || t == Epi::T2) E.mid(acc, cur, t, wr, wc, fr, fq); }
            const bool last = (t == nt - 2);
            const char* a1 = cA + (size_t)(t + 1) * kstep;
            const char* a2 = last ? nA : cA + (size_t)(t + 2) * kstep; const char* b2 = last ? nB : cB + (size_t)(t + 2) * kstep;
            const char* a3 = a2 + kstep; const char* b3 = b2 + kstep;
            if (last && has_next) S.a_ready(nxt);
            if constexpr (SP2) {
            const int loose = __builtin_amdgcn_readfirstlane(((t == 0) && (ui > 0)) ? 1 : 0);
#define PG8_WAIT_V8L do { if constexpr (Epi::NST == 8) asm volatile("s_waitcnt vmcnt(16)\n\ts_cmp_lg_u32 %0, 0\n\ts_cbranch_scc1 1f\n\ts_waitcnt vmcnt(8)\n1:" :: "s"(loose) : "memory", "scc"); \
                          else asm volatile("s_waitcnt vmcnt(24)\n\ts_cmp_lg_u32 %0, 0\n\ts_cbranch_scc1 1f\n\ts_waitcnt vmcnt(8)\n1:" :: "s"(loose) : "memory", "scc"); } while (0)
            PG8_LDB(B0, 0, 0); PG8_LDB(B1, 0, 1); PG8_SCHED; PG8_LDA(At, 0, 0); PG8_STAGE(PG8_SA(1, 1), a1 + hstepA, voffA);
            PG8_WAIT_V8L; PG8_WAIT_L(0); PG8_BAR; PG8_MMA(0, 0, At, B0); PG8_MMA(0, 1, At, B1); PG8_BAR; PG8_SCHED;
            PG8_LDA(At, 0, 1); PG8_STAGE(PG8_SB(0, 0), b2, voffB); PG8_STAGE(PG8_SB(0, 1), b2 + hstepB, voffB); PG8_STAGE(PG8_SA(0, 0), a2, voffA);
            PG8_WAIT_V8L; PG8_WAIT_L(0); PG8_BAR; PG8_MMA(1, 0, At, B0); PG8_MMA(1, 1, At, B1); PG8_BAR; PG8_SCHED;
#undef PG8_WAIT_V8L
            PG8_LDB(B0, 1, 0); PG8_LDB(B1, 1, 1); PG8_SCHED; PG8_LDA(At, 1, 0); PG8_STAGE(PG8_SA(0, 1), a2 + hstepA, voffA);
            PG8_WAIT_V(8); PG8_WAIT_L(0); PG8_BAR; PG8_MMA(0, 0, At, B0); PG8_MMA(0, 1, At, B1); PG8_BAR; PG8_SCHED;
            PG8_LDA(At, 1, 1); PG8_STAGE(PG8_SB(1, 0), b3, voffB); PG8_STAGE(PG8_SB(1, 1), b3 + hstepB, voffB); PG8_STAGE(PG8_SA(1, 0), a3, voffA);
            PG8_WAIT_V(8); PG8_WAIT_L(0); PG8_BAR; PG8_MMA(1, 0, At, B0); PG8_MMA(1, 1, At, B1); PG8_BAR; PG8_SCHED;
            } else {
            PG8_LDB(B0, 0, 0); PG8_SCHED; PG8_LDA(At, 0, 0); PG8_STAGE(PG8_SA(1, 1), a1 + hstepA, voffA);
            PG8_WAIT_L(8); PG8_BAR; PG8_WAIT_L(0); PG8_MMA(0, 0, At, B0); PG8_BAR; PG8_SCHED;
            PG8_LDB(B1, 0, 1); PG8_STAGE(PG8_SB(0, 0), b2, voffB);
            PG8_BAR; PG8_WAIT_L(0); PG8_MMA(0, 1, At, B1); PG8_BAR;
            PG8_LDA(At, 0, 1); PG8_STAGE(PG8_SA(0, 0), a2, voffA);
            PG8_BAR; PG8_WAIT_L(0); PG8_MMA(1, 0, At, B0); PG8_BAR; PG8_SCHED;
            PG8_STAGE(PG8_SB(0, 1), b2 + hstepB, voffB);
            PG8_WAIT_V(6); PG8_BAR; PG8_MMA(1, 1, At, B1); PG8_BAR;
            PG8_LDB(B0, 1, 0); PG8_SCHED; PG8_LDA(At, 1, 0); PG8_STAGE(PG8_SA(0, 1), a2 + hstepA, voffA);
            PG8_WAIT_L(8); PG8_BAR; PG8_WAIT_L(0); PG8_MMA(0, 0, At, B0); PG8_BAR; PG8_SCHED;
            PG8_LDB(B1, 1, 1); PG8_STAGE(PG8_SB(1, 0), b3, voffB);
            PG8_BAR; PG8_WAIT_L(0); PG8_MMA(0, 1, At, B1); PG8_BAR;
            PG8_LDA(At, 1, 1); PG8_STAGE(PG8_SA(1, 0), a3, voffA);
            PG8_BAR; PG8_WAIT_L(0); PG8_MMA(1, 0, At, B0); PG8_BAR; PG8_SCHED;
            PG8_STAGE(PG8_SB(1, 1), b3 + hstepB, voffB);
            PG8_WAIT_V(6); PG8_BAR; PG8_MMA(1, 1, At, B1); PG8_BAR;
            }
        }
        if constexpr (ALIGN_EPI) { if (wr == 0) PG8_BAR; }
        if constexpr (!Epi::AFTER_DRAIN) { E(acc, cur, wr, wc, fr, fq); S.done(cur); }
        if (!has_next) break;
#pragma unroll
        for (int a = 0; a < 2; ++a)
#pragma unroll
            for (int b = 0; b < 2; ++b)
#pragma unroll
                for (int m = 0; m < 4; ++m)
#pragma unroll
                    for (int n = 0; n < 2; ++n) acc[a][b][m][n] = (f32x4){0.f, 0.f, 0.f, 0.f};
        cur = nxt; cA = nA; cB = nB; ++ui;
        if constexpr (ALIGN_EPI) { if (wr == 1) PG8_BAR; }
    }
    PG8_WAIT_V(0);
    if constexpr (!ALIGN_EPI) { if (wr == 0) PG8_BAR; }
    PG8_BAR;
    if constexpr (Epi::AFTER_DRAIN) { E.fused(acc, cur, wr, wc, fr, fq, lds, wid, lane); S.done(cur); }
#undef PG8_UA
#undef PG8_UB
#undef PG8_SA
#undef PG8_SB
#undef PG8_STAGE
#undef PG8_LDA
#undef PG8_LDB
#undef PG8_MMA
#undef PG8_WAIT_V
#undef PG8_WAIT_L
#undef PG8_BAR
#undef PG8_SCHED
}
}

#ifndef PG8_SP2
#define PG8_SP2 true
#endif
#ifndef PG8_ALIGN
#define PG8_ALIGN true
#endif

constexpr int NWAVES = 8;
constexpr int DM = 2048, SEQ = 8192, CTX = 256, DEPTH = 2, GRID_W = 64, NROWS = SEQ / GRID_W;
constexpr int MTOT = SEQ + CTX;
constexpr int NH = 8, HD = 128, DNA = 1024, WIN_R = 8, WIN_C = 16;
constexpr int DFOUR = 512, FG = 128, DCONV = 512, CONVW = 31;
constexpr int DFF = 5632, DIN = 4608, NMODU = 6;
constexpr int ADA_N = 9 * DM;
constexpr float LN_EPS = 1e-5f, ALPHA = 1.4142135623730951f;
constexpr int ZQ = 0, ZK = DNA, ZV = 2 * DNA, ZF = 3 * DNA, ZA = 3 * DNA + DFOUR, ZG = 3 * DNA + DFOUR + DCONV;
constexpr int YNA = 0, YF = DNA, YC = DNA + DFOUR;

enum { I_X = 0, I_C, I_CTX, I_CCTX, I_WADA, I_BADA, I_F1W1, I_F1W3, I_F1W2, I_F2W1, I_F2W3, I_F2W2, I_WIN, I_WDW, I_BDW, I_CLNG, I_CLNB, I_RPB, I_WGATE, I_BGATE, I_WBNA, I_WBF, I_WBC, I_WO, I_LNG, I_LNB, N_IN };

constexpr size_t MiB = 1u << 20;
constexpr size_t WS_CTL = 0, CTL_ZERO_BYTES = 64 * 1024;
constexpr int MODP_CH = 16;
constexpr size_t WS_MODP = 2 * MiB;
constexpr size_t WS_MOD = 6 * MiB;
constexpr size_t WS_W = 8 * MiB;
constexpr size_t WL_W13A = 0, WL_W2A = 44 * MiB, WL_W13B = 66 * MiB, WL_W2B = 110 * MiB, WL_WIN = 132 * MiB, WL_WG = 150 * MiB, WL_WB = 174 * MiB, WL_WO = 182 * MiB, WL_SIZE = 190 * MiB;
constexpr size_t WS_X = 388 * MiB;
constexpr size_t WS_T = 454 * MiB;
constexpr size_t WS_H = 520 * MiB;
constexpr size_t WS_G = 553 * MiB;
constexpr size_t WS_ZIN = 644 * MiB;
constexpr size_t WS_YALL = 719 * MiB;
constexpr size_t WS_GATES = 752 * MiB;
constexpr size_t WS_MB = 851 * MiB;
constexpr size_t WS_FY = 884 * MiB;
constexpr size_t WS_VT = 917 * MiB;
constexpr size_t WS_PART = 934 * MiB;
constexpr size_t WS_END = 978 * MiB;
static_assert(WS_W + 2 * WL_SIZE <= WS_X && WS_G + (size_t)MTOT * DFF * 2 <= WS_ZIN && WS_ZIN + (size_t)MTOT * DIN * 2 <= WS_YALL && WS_GATES + (size_t)MTOT * 3 * DM * 2 <= WS_MB && WS_FY + (size_t)MTOT * DFOUR * 8 <= WS_END, "d_ws map");
constexpr int CW_TMO = 0, CW_BAR = 4096;

constexpr int RING_OFF = 0, RING_BYTES = 131072;
constexpr int LDSCTL_OFF = RING_BYTES, MISC_OFF = LDSCTL_OFF + 320;
constexpr int LDS_BYTES = 147456;

#define GAS __attribute__((address_space(1)))
#define LAS __attribute__((address_space(3)))
typedef unsigned short bf16;
typedef unsigned v4u __attribute__((ext_vector_type(4)));
typedef unsigned v2u __attribute__((ext_vector_type(2)));
typedef float f32x4 __attribute__((ext_vector_type(4)));
typedef float f32x2 __attribute__((ext_vector_type(2)));
typedef short bf16x8 __attribute__((ext_vector_type(8)));
typedef GAS unsigned gu32;
typedef float xh;
typedef float xh4 __attribute__((ext_vector_type(4)));
__device__ __forceinline__ f32x4 xld4(const xh* p) { return __builtin_convertvector(*(const GAS xh4*)p, f32x4); }
__device__ __forceinline__ void xst4(xh* p, f32x4 v) { *(GAS xh4*)p = __builtin_convertvector(v, xh4); }
#define RLX_AGENT __ATOMIC_RELAXED, __HIP_MEMORY_SCOPE_AGENT
#define LDS_WAIT() asm volatile("s_waitcnt lgkmcnt(0)" ::: "memory")
#define VM_WAIT() asm volatile("s_waitcnt vmcnt(0)" ::: "memory")
__device__ __forceinline__ unsigned f2bf(float f) { unsigned u = __builtin_bit_cast(unsigned, f); return (u + 0x7fffu + ((u >> 16) & 1u)) >> 16; }
__device__ __forceinline__ unsigned pk2(float lo, float hi) { return f2bf(lo) | (f2bf(hi) << 16); }
typedef __bf16 bf16x2v __attribute__((ext_vector_type(2)));
__device__ __forceinline__ unsigned pkbf(float lo, float hi) { const f32x2 v = {lo, hi}; const bf16x2v b = __builtin_convertvector(v, bf16x2v); return __builtin_bit_cast(unsigned, b); }
__device__ __forceinline__ float bf2f(bf16 b) { return __builtin_bit_cast(float, (unsigned)b << 16); }
__device__ __forceinline__ float sigm(float x) { return 1.0f / (1.0f + __expf(-x)); }
template <int CTRL> __device__ __forceinline__ float dppf(float v) { return __builtin_bit_cast(float, __builtin_amdgcn_update_dpp(0, __builtin_bit_cast(int, v), CTRL, 0xF, 0xF, false)); }
template <int CTRL, int ROWMASK> __device__ __forceinline__ float dppfm(float v) { return __builtin_bit_cast(float, __builtin_amdgcn_update_dpp(0, __builtin_bit_cast(int, v), CTRL, ROWMASK, 0xF, true)); }
__device__ __forceinline__ float wave_sum(float v) {
    v += dppf<0x128>(v); v += dppf<0x124>(v); v += dppf<0x122>(v); v += dppf<0x121>(v);
    v += dppfm<0x142, 0xA>(v);
    v += dppfm<0x143, 0xC>(v);
    return __builtin_bit_cast(float, __builtin_amdgcn_readlane(__builtin_bit_cast(int, v), 63));
}
__device__ __forceinline__ float wave_max(float v) {
#pragma unroll
    for (int o = 1; o < 64; o <<= 1) v = fmaxf(v, __shfl_xor(v, o));
    return v;
}
#define XB_TMO      128
#define XB_XCNT(j)  (256  + 64 * (j))
#define XB_XSUB(j)  (1280 + 64 * (j))
#define XB_XGEN(j)  (2304 + 64 * (j))
#define XB_TOP      3328
#define XB_TOPGEN   3392
#define XCD_BAR_WORDS 3456
#define XB_SPIN_CAP (1u << 18)

__device__ __forceinline__ unsigned xb_ld(unsigned* p)              { return __hip_atomic_load(p, __ATOMIC_RELAXED, __HIP_MEMORY_SCOPE_AGENT); }
__device__ __forceinline__ unsigned xb_add(unsigned* p, unsigned v) { return __hip_atomic_fetch_add(p, v, __ATOMIC_RELAXED, __HIP_MEMORY_SCOPE_AGENT); }
__device__ __forceinline__ unsigned xb_xcc_id() { return (unsigned)__builtin_amdgcn_s_getreg((3 << 11) | 20) & 0xFu; }
#define XB_SPIN(cond, bar) do { unsigned _sp = 0; while (cond) { __builtin_amdgcn_s_sleep(1); \
    if ((++_sp & 255u) == 0u) { if (xb_ld(&(bar)[XB_TMO])) break; if (_sp > XB_SPIN_CAP) { atomicAdd(&(bar)[XB_TMO], 1u); break; } } } } while (0)

struct XcdBarrier {
    unsigned* bar; unsigned x; int wave;
    volatile LAS unsigned* st;
};

__device__ __forceinline__ XcdBarrier xcd_barrier_post(unsigned* bar, volatile LAS unsigned* st) {
    XcdBarrier b; b.bar = bar; b.x = xb_xcc_id(); b.st = st; b.wave = __builtin_amdgcn_readfirstlane(threadIdx.x >> 6);
    if (threadIdx.x == 0) (void)xb_add(&bar[XB_XCNT(b.x)], 1u);
    return b;
}
__device__ __forceinline__ void xcd_barrier_complete(unsigned* bar, unsigned x, unsigned& nloc, unsigned& nx) {
    const unsigned G = gridDim.x * gridDim.y * gridDim.z;
    unsigned sum, cnt, mine, sp = 0u;
    for (;;) {
        sum = 0u; cnt = 0u; mine = 0u;
#pragma unroll
        for (unsigned j = 0; j < 16; ++j) { const unsigned c = xb_ld(&bar[XB_XCNT(j)]); sum += c; cnt += (c > 0u) ? 1u : 0u; mine = (j == x) ? c : mine; }
        if (sum == G) break;
        __builtin_amdgcn_s_sleep(1);
        if ((++sp & 255u) == 0u) { if (xb_ld(&bar[XB_TMO])) break; if (sp > XB_SPIN_CAP) { atomicAdd(&bar[XB_TMO], 1u); break; } }
    }
    nloc = mine > 0u ? mine : 1u; nx = cnt > 0u ? cnt : 1u;
}

__device__ __forceinline__ void xcd_barrier(const XcdBarrier& b) {
    asm volatile("s_waitcnt vmcnt(0)" ::: "memory");
    __syncthreads();
    if (b.wave == 0 && hw_lane() == 0) {
        unsigned* bar = b.bar;
        __builtin_amdgcn_s_waitcnt(0);
        unsigned nloc = b.st[0], nx = b.st[1];
        if (nloc == 0u) { xcd_barrier_complete(bar, b.x, nloc, nx); b.st[0] = nloc; b.st[1] = nx; }
        const unsigned old = xb_add(&bar[XB_XSUB(b.x)], 1u);
        const unsigned gen = old / nloc;
        if (old + 1u == (gen + 1u) * nloc) {
            __builtin_amdgcn_fence(__ATOMIC_RELEASE, "agent");
            asm volatile("s_waitcnt vmcnt(0)" ::: "memory");
            const unsigned og = xb_add(&bar[XB_TOP], 1u);
            const unsigned tg = og / nx;
            if (og + 1u == (tg + 1u) * nx) xb_add(&bar[XB_TOPGEN], 1u);
            else XB_SPIN(xb_ld(&bar[XB_TOPGEN]) == tg, bar);
            __builtin_amdgcn_fence(__ATOMIC_ACQUIRE, "agent");
            xb_add(&bar[XB_XGEN(b.x)], 1u);
            asm volatile("s_waitcnt vmcnt(0)" ::: "memory");
        } else {
            XB_SPIN(xb_ld(&bar[XB_XGEN(b.x)]) == gen, bar);
            __builtin_amdgcn_fence(__ATOMIC_ACQUIRE, "agent");
            asm volatile("s_waitcnt vmcnt(0)" ::: "memory");
        }
    }
    __syncthreads();
}


struct Ctx {
    LAS unsigned char* lds; int tid, lane, wave, bx, G, gw, NGW;
};
struct Args { const float* in[26]; float* out; unsigned char* ws; int ph_lo, ph_hi, use_bar, pad; };
typedef const __attribute__((address_space(4))) Args* KAp;
typedef unsigned u32x4p __attribute__((ext_vector_type(4)));
__device__ __forceinline__ KAp ka_opaque() { KAp p = (KAp)__builtin_amdgcn_kernarg_segment_ptr(); asm volatile("" : "+s"(p)); return p; }

struct TrDesc { const float* W; int N; bf16* WT; int ldk, koff, grp, gstride, goff, item; };
#ifndef TR_MAP
#define TR_MAP 1
#endif
__device__ __forceinline__ void tr_kn(const TrDesc& d, int& kb, int& nb) {
    const int nblk = d.N / 64;
#if TR_MAP == 1
    const int pr = d.item / (2 * nblk), j = d.item % (2 * nblk); kb = 2 * pr + ((j >> 2) & 1); nb = 4 * (j >> 3) + (j & 3);
#elif TR_MAP == 2
    const int pr = d.item / (8 * nblk), j = d.item % (8 * nblk); kb = 8 * pr + (j & 7); nb = j >> 3;
#else
    kb = d.item / nblk; nb = d.item % nblk;
#endif
}
__device__ __forceinline__ void tr_load(const TrDesc& d, f32x4 (&a)[8], f32x4 (&b)[8], int lane) {
    int kb, nb; tr_kn(d, kb, nb); const int k0 = 64 * kb, n0 = 64 * nb, nq = lane & 15, kr = lane >> 4;
#pragma unroll
    for (int i = 0; i < 8; ++i) { const float* wp = d.W + (size_t)(k0 + 8 * i + 2 * kr) * d.N + n0 + 4 * nq; a[i] = *(const GAS f32x4*)wp; b[i] = *(const GAS f32x4*)(wp + d.N); }
}
__device__ __forceinline__ void tr_finish(const TrDesc& d, const f32x4 (&a)[8], const f32x4 (&b)[8], LAS unsigned* scr, int lane) {
    int kb, nb; tr_kn(d, kb, nb); const int k0 = 64 * kb, n0 = 64 * nb, nq = lane & 15, kr = lane >> 4;
#pragma unroll
    for (int i = 0; i < 8; ++i) { const int kd = 4 * i + kr;
#pragma unroll
        for (int e = 0; e < 4; ++e) scr[(4 * nq + e) * 33 + kd] = pkbf(a[i][e], b[i][e]); }
    LDS_WAIT(); asm volatile("" ::: "memory");
#pragma unroll
    for (int j = 0; j < 8; ++j) { const int n = (lane >> 3) + 8 * j, ch = lane & 7; const LAS unsigned* s = scr + n * 33 + 4 * ch;
        v4u o; o.x = s[0]; o.y = s[1]; o.z = s[2]; o.w = s[3];
        const int nn = n0 + n, drow = (nn / d.grp) * d.gstride + d.goff + (nn % d.grp);
        *(GAS v4u*)(d.WT + (size_t)drow * d.ldk + d.koff + k0 + 8 * ch) = o; }
    LDS_WAIT(); asm volatile("" ::: "memory");
}
constexpr int TI_FF = (DM / 64) * (DFF / 64);
constexpr int TI_IN = (DM / 64) * (DIN / 64), TI_G = (DM / 64) * (3 * DM / 64), TI_BNA = (DNA / 64) * (DM / 64), TI_BF = (DFOUR / 64) * (DM / 64), TI_BC = (DCONV / 64) * (DM / 64), TI_O = (DM / 64) * (DM / 64);
constexpr int TI_LAYER = 6 * TI_FF + TI_IN + TI_G + TI_BNA + TI_BF + TI_BC + TI_O;
constexpr int MOD_CB = NMODU * DM / 256;
constexpr int MODI = DEPTH * MOD_CB * MODP_CH;

__device__ __forceinline__ TrDesc weight_desc(const KAp ka, unsigned char* ws, int l, int r) {
    unsigned char* wl = ws + WS_W + (size_t)l * WL_SIZE;
    const float* W; int N; bf16* WT; int ldk, koff = 0, grp, gstride = 0, goff = 0;
    if (r < TI_FF) { W = ka->in[I_F1W1] + (size_t)l * DM * DFF; N = DFF; WT = (bf16*)(wl + WL_W13A); ldk = DM; grp = 128; gstride = 256; goff = 0; }
    else if ((r -= TI_FF) < TI_FF) { W = ka->in[I_F1W3] + (size_t)l * DM * DFF; N = DFF; WT = (bf16*)(wl + WL_W13A); ldk = DM; grp = 128; gstride = 256; goff = 128; }
    else if ((r -= TI_FF) < TI_FF) { W = ka->in[I_F1W2] + (size_t)l * DFF * DM; N = DM; WT = (bf16*)(wl + WL_W2A); ldk = DFF; grp = DM; }
    else if ((r -= TI_FF) < TI_FF) { W = ka->in[I_F2W1] + (size_t)l * DM * DFF; N = DFF; WT = (bf16*)(wl + WL_W13B); ldk = DM; grp = 128; gstride = 256; goff = 0; }
    else if ((r -= TI_FF) < TI_FF) { W = ka->in[I_F2W3] + (size_t)l * DM * DFF; N = DFF; WT = (bf16*)(wl + WL_W13B); ldk = DM; grp = 128; gstride = 256; goff = 128; }
    else if ((r -= TI_FF) < TI_FF) { W = ka->in[I_F2W2] + (size_t)l * DFF * DM; N = DM; WT = (bf16*)(wl + WL_W2B); ldk = DFF; grp = DM; }
    else if ((r -= TI_FF) < TI_IN) { W = ka->in[I_WIN] + (size_t)l * DM * DIN; N = DIN; WT = (bf16*)(wl + WL_WIN); ldk = DM; grp = DIN; }
    else if ((r -= TI_IN) < TI_G) { W = ka->in[I_WGATE] + (size_t)l * DM * 3 * DM; N = 3 * DM; WT = (bf16*)(wl + WL_WG); ldk = DM; grp = 3 * DM; }
    else if ((r -= TI_G) < TI_BNA) { W = ka->in[I_WBNA] + (size_t)l * DNA * DM; N = DM; WT = (bf16*)(wl + WL_WB); ldk = DM; grp = DM; koff = 0; }
    else if ((r -= TI_BNA) < TI_BF) { W = ka->in[I_WBF] + (size_t)l * DFOUR * DM; N = DM; WT = (bf16*)(wl + WL_WB); ldk = DM; grp = DM; koff = DNA; }
    else if ((r -= TI_BF) < TI_BC) { W = ka->in[I_WBC] + (size_t)l * DCONV * DM; N = DM; WT = (bf16*)(wl + WL_WB); ldk = DM; grp = DM; koff = DNA + DFOUR; }
    else { r -= TI_BC; W = ka->in[I_WO] + (size_t)l * DM * DM; N = DM; WT = (bf16*)(wl + WL_WO); ldk = DM; grp = DM; }
    TrDesc d; d.W = W; d.N = N; d.WT = WT; d.ldk = ldk; d.koff = koff; d.grp = grp; d.gstride = gstride; d.goff = goff; d.item = r; return d;
}
__device__ __forceinline__ void weight_item(const KAp ka, unsigned char* ws, int l, int r, LAS unsigned* scr, int lane) {
    const TrDesc d = weight_desc(ka, ws, l, r); f32x4 a[8], b[8]; tr_load(d, a, b, lane); tr_finish(d, a, b, scr, lane);
}
__device__ __forceinline__ int w2_lo(int f) { return f == 0 ? 2 * TI_FF : 5 * TI_FF; }
constexpr int L1_OTHER = TI_LAYER - 2 * TI_FF;
constexpr int TI_MIX = TI_LAYER - 6 * TI_FF;
__device__ __forceinline__ int l1_other_item(int q) { return q < 2 * TI_FF ? q : (q < 4 * TI_FF ? q + TI_FF : q + 2 * TI_FF); }
__device__ __forceinline__ void helper_convert(const Ctx& F, int first_idle_block, int la, int qa0, int nA, int lb = 0, int qb0 = 0, int nB = 0) {
    if (F.bx < first_idle_block) return;
    const KAp ka = ka_opaque(); unsigned char* const ws = ka->ws;
    LAS unsigned* scr = (LAS unsigned*)(F.lds + RING_OFF + F.wave * 16384);
    const int hw = (F.bx - first_idle_block) * NWAVES + F.wave, nhw = (F.G - first_idle_block) * NWAVES;
    const int lane = hw_lane();
    for (int q = hw; q < nA + nB; q += nhw) { const bool inA = q < nA; weight_item(ka, ws, inA ? la : lb, inA ? qa0 + q : qb0 + (q - nA), scr, lane); }
}
__device__ __forceinline__ TrDesc p0_desc(const KAp ka, unsigned char* ws, int r) {
    return weight_desc(ka, ws, 0, r < 2 * TI_FF ? r : r + 4 * TI_FF);
}
__device__ __forceinline__ void p0_prologue(const Ctx& F) {
    const KAp ka = ka_opaque(); unsigned char* const ws = ka->ws;
    LAS unsigned* scr = (LAS unsigned*)(F.lds + RING_OFF + F.wave * 16384);
    for (int it = F.gw; it < MODI; it += F.NGW) {
        const int l = it / (MOD_CB * MODP_CH), r = it % (MOD_CB * MODP_CH), cb = r / MODP_CH, kc = r % MODP_CH;
        const float* cv = ka->in[I_C]; const float* cc = ka->in[I_CCTX];
        const float a0 = cv[kc * 128 + F.lane], a1 = cv[kc * 128 + 64 + F.lane], b0 = cc[kc * 128 + F.lane], b1 = cc[kc * 128 + 64 + F.lane];
        const float sl0 = a0 * sigm(a0), sl1 = a1 * sigm(a1), sc0 = b0 * sigm(b0), sc1 = b1 * sigm(b1);
        const float* W = ka->in[I_WADA] + (size_t)l * DM * ADA_N + (size_t)(kc * 128) * ADA_N + cb * 256 + 4 * F.lane;
        f32x4 aL = {0.f, 0.f, 0.f, 0.f}, aC = {0.f, 0.f, 0.f, 0.f};
#pragma unroll 16
        for (int k = 0; k < 64; ++k) { const f32x4 w = *(const GAS f32x4*)(W + (size_t)k * ADA_N); aL += w * __shfl(sl0, k); aC += w * __shfl(sc0, k); }
#pragma unroll 16
        for (int k = 0; k < 64; ++k) { const f32x4 w = *(const GAS f32x4*)(W + (size_t)(64 + k) * ADA_N); aL += w * __shfl(sl1, k); aC += w * __shfl(sc1, k); }
        float* P = (float*)(ws + WS_MODP);
        *(GAS f32x4*)(P + (size_t)((kc * 2 + l) * 2 + 0) * (NMODU * DM) + cb * 256 + 4 * F.lane) = aL;
        *(GAS f32x4*)(P + (size_t)((kc * 2 + l) * 2 + 1) * (NMODU * DM) + cb * 256 + 4 * F.lane) = aC;
    }
    const int NT = 2 * TI_FF + (TI_LAYER - 6 * TI_FF);
    int r = (F.gw + MODI) % F.NGW;
    f32x4 a0[8], b0[8], a1[8], b1[8];
    if (r < NT) { TrDesc d0 = p0_desc(ka, ws, r); tr_load(d0, a0, b0, F.lane);
        for (;;) {
            const int r1 = r + F.NGW; const bool v1 = r1 < NT; TrDesc d1 = d0;
            if (v1) { d1 = p0_desc(ka, ws, r1); tr_load(d1, a1, b1, F.lane); }
            tr_finish(d0, a0, b0, scr, F.lane);
            if (!v1) break;
            const int r2 = r1 + F.NGW; const bool v2 = r2 < NT;
            if (v2) { d0 = p0_desc(ka, ws, r2); tr_load(d0, a0, b0, F.lane); }
            tr_finish(d1, a1, b1, scr, F.lane);
            if (!v2) break;
            r = r2;
        } }
}

__device__ __forceinline__ const float* mod_vec(unsigned char* ws, int l, int s, int i) { return (const float*)(ws + WS_MOD) + (size_t)((l * 2 + s) * NMODU + i) * DM; }
__device__ __forceinline__ void p1_prologue(const Ctx& F) {
    const KAp ka = ka_opaque(); unsigned char* const ws = ka->ws;
    const float* P = (const float*)(ws + WS_MODP); const float* bada = ka->in[I_BADA];
    LAS float* mv = (LAS float*)(F.lds + RING_OFF);
#pragma unroll 1
    for (int v = 0; v < 4; ++v) { const int s = v >> 1, i = v & 1;
        float pa[4][MODP_CH], a0[4];
#pragma unroll
        for (int q = 0; q < 4; ++q) { const int col = F.tid + 512 * q; a0[q] = bada[i * DM + col];
#pragma unroll
            for (int kc = 0; kc < MODP_CH; ++kc) pa[q][kc] = P[(size_t)((kc * 2 + 0) * 2 + s) * (NMODU * DM) + i * DM + col]; }
#pragma unroll
        for (int q = 0; q < 4; ++q) { float a = a0[q];
#pragma unroll
            for (int kc = 0; kc < MODP_CH; ++kc) a += pa[q][kc];
            mv[v * DM + F.tid + 512 * q] = a; } }
    const int gt = F.bx * 512 + F.tid;
    if (gt < DEPTH * 2 * NMODU * DM) { const int l = gt / (2 * NMODU * DM), s = (gt / (NMODU * DM)) & 1, j = gt % (NMODU * DM); float a = bada[(size_t)l * ADA_N + j];
        for (int kc = 0; kc < MODP_CH; ++kc) a += P[(size_t)((kc * 2 + l) * 2 + s) * (NMODU * DM) + j];
        ((float*)(ws + WS_MOD))[(size_t)(l * 2 + s) * (NMODU * DM) + j] = a; }
    __syncthreads();
    xh* X = (xh*)(ws + WS_X); bf16* H = (bf16*)(ws + WS_H);
    for (int row0 = F.gw; row0 < MTOT; row0 += 2 * F.NGW) {
        const int row1 = row0 + F.NGW; const bool two = row1 < MTOT;
        f32x4 va[8], vb[8];
        { const float* src = row0 < SEQ ? ka->in[I_X] + (size_t)row0 * DM : ka->in[I_CTX] + (size_t)(row0 - SEQ) * DM;
#pragma unroll
          for (int j = 0; j < 8; ++j) va[j] = *(const GAS f32x4*)(src + 4 * F.lane + 256 * j); }
        if (two) { const float* src = row1 < SEQ ? ka->in[I_X] + (size_t)row1 * DM : ka->in[I_CTX] + (size_t)(row1 - SEQ) * DM;
#pragma unroll
          for (int j = 0; j < 8; ++j) vb[j] = *(const GAS f32x4*)(src + 4 * F.lane + 256 * j); }
#pragma unroll
        for (int h2 = 0; h2 < 2; ++h2) { if (h2 == 1 && !two) break;
            const int row = h2 ? row1 : row0;
            const LAS float* sh = mv + (row < SEQ ? 0 : 2 * DM); const LAS float* sc = sh + DM;
#pragma unroll
            for (int j = 0; j < 8; ++j) { const int col = 4 * F.lane + 256 * j; const f32x4 v = h2 ? vb[j] : va[j];
                xst4(X + (size_t)row * DM + col, v);
                const f32x4 s4 = *(const LAS f32x4*)(sc + col), h4 = *(const LAS f32x4*)(sh + col); const f32x4 h = v * (s4 + 1.0f) + h4;
                v2u o; o.x = pk2(h[0], h[1]); o.y = pk2(h[2], h[3]); *(GAS v2u*)(H + (size_t)row * DM + col) = o; } }
    }
    __syncthreads();
}

#ifndef DIAG_ZERO_NA
#define DIAG_ZERO_NA 0
#endif
#ifndef DIAG_ZERO_C
#define DIAG_ZERO_C 0
#endif
#ifndef DIAG_ZERO_ROW0
#define DIAG_ZERO_ROW0 0
#endif
__device__ __forceinline__ f32x4 bf4(v2u w) { return (f32x4){pg8::bf_lo(w.x), pg8::bf_hi(w.x), pg8::bf_lo(w.y), pg8::bf_hi(w.y)}; }
__device__ __forceinline__ void ln_load_row(const Ctx& F, f32x4 (&v)[8], int row, const bf16* Dl, const xh* Xin, const bf16* parts, int nparts, const float* gate_ctx, float gmul) {
    if (parts && row >= SEQ) {
        f32x4 a[8];
#pragma unroll
        for (int j = 0; j < 8; ++j) a[j] = (f32x4){0.f, 0.f, 0.f, 0.f};
#pragma unroll 2
        for (int ch = 0; ch < nparts; ++ch) { const bf16* pp = parts + ((size_t)ch * 256 + (row - SEQ)) * DM + 4 * F.lane;
#pragma unroll
            for (int j = 0; j < 8; ++j) a[j] += bf4(*(const GAS v2u*)(pp + 256 * j)); }
#pragma unroll
        for (int j = 0; j < 8; ++j) { const int col = 4 * F.lane + 256 * j; v[j] = xld4(Xin + (size_t)row * DM + col) * ALPHA + a[j] * (*(const GAS f32x4*)(gate_ctx + col) * gmul); }
    } else {
#pragma unroll
        for (int j = 0; j < 8; ++j) { const int col = 4 * F.lane + 256 * j; v[j] = xld4(Xin + (size_t)row * DM + col) * ALPHA + bf4(*(const GAS v2u*)(Dl + (size_t)row * DM + col)); }
    }
}
__device__ __forceinline__ void ln_stats2(f32x4 (&v0)[8], f32x4 (&v1)[8], bool two, float& r0, float& r1) {
    float s0 = 0.f, s1 = 0.f;
#pragma unroll
    for (int j = 0; j < 8; ++j) { s0 += (v0[j][0] + v0[j][1]) + (v0[j][2] + v0[j][3]); if (two) s1 += (v1[j][0] + v1[j][1]) + (v1[j][2] + v1[j][3]); }
    s0 = wave_sum(s0); s1 = wave_sum(s1);
    const float m0 = s0 * (1.0f / DM), m1 = s1 * (1.0f / DM); float q0 = 0.f, q1 = 0.f;
#pragma unroll
    for (int j = 0; j < 8; ++j) { v0[j] = v0[j] - m0; q0 += (v0[j][0] * v0[j][0] + v0[j][1] * v0[j][1]) + (v0[j][2] * v0[j][2] + v0[j][3] * v0[j][3]);
        if (two) { v1[j] = v1[j] - m1; q1 += (v1[j][0] * v1[j][0] + v1[j][1] * v1[j][1]) + (v1[j][2] * v1[j][2] + v1[j][3] * v1[j][3]); } }
    q0 = wave_sum(q0); q1 = wave_sum(q1);
    r0 = 1.0f / sqrtf(q0 * (1.0f / DM) + LN_EPS); r1 = 1.0f / sqrtf(q1 * (1.0f / DM) + LN_EPS);
}
__device__ __forceinline__ void ln_finish_row(const Ctx& F, f32x4 (&v)[8], float rstd, int row, float* Xo32, xh* Xo, bf16* H, const f32x4 (&gv)[8], const f32x4 (&bv)[8], const float* shL, const float* scL, const float* shC, const float* scC) {
    const float* sh = row < SEQ ? shL : shC; const float* sc = row < SEQ ? scL : scC;
#pragma unroll
    for (int j = 0; j < 8; ++j) { const int col = 4 * F.lane + 256 * j; const f32x4 y = v[j] * rstd * gv[j] + bv[j];
        if (Xo32) *(GAS f32x4*)(Xo32 + (size_t)row * DM + col) = y; else xst4(Xo + (size_t)row * DM + col, y);
        if (H) { const f32x4 s4 = *(const GAS f32x4*)(sc + col), h4 = *(const GAS f32x4*)(sh + col); const f32x4 h = y * (s4 + 1.0f) + h4;
            v2u o; o.x = pk2(h[0], h[1]); o.y = pk2(h[2], h[3]); *(GAS v2u*)(H + (size_t)row * DM + col) = o; } }
}
template <int NP>
__device__ __forceinline__ void ln_ctx_row_wg(const Ctx& F, int row, xh* Xo, bf16* H, const float* g, const float* b, const float* shC, const float* scC, const xh* Xin, const bf16* parts, const float* gate_ctx, float gmul) {
    LAS float* red = (LAS float*)(F.lds + RING_OFF);
    const int col = 256 * F.wave + 4 * F.lane;
    const bf16* pp0 = parts + (size_t)(row - SEQ) * DM + col;
    v2u t[NP];
#pragma unroll
    for (int ch = 0; ch < NP; ++ch) t[ch] = *(const GAS v2u*)(pp0 + (size_t)ch * 256 * DM);
    const f32x4 x = xld4(Xin + (size_t)row * DM + col), gt = *(const GAS f32x4*)(gate_ctx + col);
    f32x4 a = {0.f, 0.f, 0.f, 0.f};
#pragma unroll
    for (int ch = 0; ch < NP; ++ch) a += bf4(t[ch]);
    f32x4 v = x * ALPHA + a * (gt * gmul);
    const float s = wave_sum((v[0] + v[1]) + (v[2] + v[3]));
    if (F.lane == 0) red[F.wave] = s;
    __syncthreads();
    const float mean = (((red[0] + red[1]) + (red[2] + red[3])) + ((red[4] + red[5]) + (red[6] + red[7]))) * (1.0f / DM);
    v = v - mean;
    const float q = wave_sum((v[0] * v[0] + v[1] * v[1]) + (v[2] * v[2] + v[3] * v[3]));
    if (F.lane == 0) red[8 + F.wave] = q;
    __syncthreads();
    const float rstd = 1.0f / sqrtf((((red[8] + red[9]) + (red[10] + red[11])) + ((red[12] + red[13]) + (red[14] + red[15]))) * (1.0f / DM) + LN_EPS);
    const f32x4 y = v * rstd * *(const GAS f32x4*)(g + col) + *(const GAS f32x4*)(b + col);
    xst4(Xo + (size_t)row * DM + col, y);
    if (H) { const f32x4 s4 = *(const GAS f32x4*)(scC + col), h4 = *(const GAS f32x4*)(shC + col); const f32x4 h = y * (s4 + 1.0f) + h4;
        v2u o; o.x = pk2(h[0], h[1]); o.y = pk2(h[2], h[3]); *(GAS v2u*)(H + (size_t)row * DM + col) = o; }
    __syncthreads();
}
__device__ __forceinline__ void ln_raw_load(const Ctx& F, f32x4 (&xr)[8], v2u (&dr)[8], int row, const bf16* Dl, const xh* Xin) {
#pragma unroll
    for (int j = 0; j < 8; ++j) { const int col = 4 * F.lane + 256 * j; xr[j] = xld4(Xin + (size_t)row * DM + col); dr[j] = *(const GAS v2u*)(Dl + (size_t)row * DM + col); }
}
__device__ __forceinline__ void ln_phase(const Ctx& F, const bf16* Dl, float* Xo32, xh* Xo, bf16* H, const float* g, const float* b, const float* shL, const float* scL, const float* shC, const float* scC, int nrows,
                                         const xh* Xin, const bf16* parts, int nparts, const float* gate_ctx, float gmul) {
    const int nlat = parts ? SEQ : nrows;
    int row = F.gw; int row1 = row + F.NGW; bool two = row1 < nlat;
    f32x4 v0[8], v1[8]; v2u d0[8], d1[8];
    if (row < nlat) { ln_raw_load(F, v0, d0, row, Dl, Xin); if (two) ln_raw_load(F, v1, d1, row1, Dl, Xin); }
    if (parts) {
        for (int crow = SEQ + F.bx; crow < nrows; crow += F.G) { if (nparts == 22) ln_ctx_row_wg<22>(F, crow, Xo, H, g, b, shC, scC, Xin, parts, gate_ctx, gmul); else ln_ctx_row_wg<8>(F, crow, Xo, H, g, b, shC, scC, Xin, parts, gate_ctx, gmul); } }
    f32x4 gv[8], bv[8];
#pragma unroll
    for (int j = 0; j < 8; ++j) { const int col = 4 * F.lane + 256 * j; gv[j] = *(const GAS f32x4*)(g + col); bv[j] = *(const GAS f32x4*)(b + col); }
    while (row < nlat) {
#pragma unroll
        for (int j = 0; j < 8; ++j) { v0[j] = v0[j] * ALPHA + bf4(d0[j]); if (two) v1[j] = v1[j] * ALPHA + bf4(d1[j]); }
        float r0, r1; ln_stats2(v0, v1, two, r0, r1);
        ln_finish_row(F, v0, r0, row, Xo32, Xo, H, gv, bv, shL, scL, shC, scC);
        if (two) ln_finish_row(F, v1, r1, row1, Xo32, Xo, H, gv, bv, shL, scL, shC, scC);
        row += 2 * F.NGW; row1 = row + F.NGW; two = row1 < nlat;
        if (row < nlat) { ln_raw_load(F, v0, d0, row, Dl, Xin); if (two) ln_raw_load(F, v1, d1, row1, Dl, Xin); }
    }
}

__device__ __forceinline__ void attn_item_v1(const bf16* ZIN, bf16* YALL, const float* rpb, int tok, int head, LAS float* pb, int lane) {
    const bool isctx = tok >= SEQ;
    const int r = tok / GRID_W, c = tok % GRID_W;
    const int r0 = min(max(r - WIN_R / 2, 0), NROWS - WIN_R), c0 = min(max(c - WIN_C / 2, 0), GRID_W - WIN_C);
    const int nband = isctx ? 0 : WIN_R * WIN_C, nkeys = nband + CTX;
    const int sub = lane & 15, grp = lane >> 4;
    float q[8];
    { const v4u w = *(const GAS v4u*)(ZIN + (size_t)tok * DIN + ZQ + head * HD + 8 * sub);
      q[0] = pg8::bf_lo(w.x); q[1] = pg8::bf_hi(w.x); q[2] = pg8::bf_lo(w.y); q[3] = pg8::bf_hi(w.y); q[4] = pg8::bf_lo(w.z); q[5] = pg8::bf_hi(w.z); q[6] = pg8::bf_lo(w.w); q[7] = pg8::bf_hi(w.w); }
    const float scale = 0.08838834764831845f;
    for (int kk0 = 0; kk0 < nkeys; kk0 += 4) {
        const int kk = kk0 + grp; int ktok; float bias = 0.f;
        if (kk < nband) { const int i = kk >> 4, j = kk & 15; ktok = (r0 + i) * GRID_W + c0 + j; bias = rpb[(head * (2 * WIN_R - 1) + (r0 + i - r + WIN_R - 1)) * (2 * WIN_C - 1) + (c0 + j - c + WIN_C - 1)]; }
        else ktok = SEQ + (kk - nband);
        const v4u w = *(const GAS v4u*)(ZIN + (size_t)ktok * DIN + ZK + head * HD + 8 * sub);
        float d = q[0] * pg8::bf_lo(w.x) + q[1] * pg8::bf_hi(w.x) + q[2] * pg8::bf_lo(w.y) + q[3] * pg8::bf_hi(w.y) + q[4] * pg8::bf_lo(w.z) + q[5] * pg8::bf_hi(w.z) + q[6] * pg8::bf_lo(w.w) + q[7] * pg8::bf_hi(w.w);
        d += __shfl_xor(d, 1); d += __shfl_xor(d, 2); d += __shfl_xor(d, 4); d += __shfl_xor(d, 8);
        if (sub == 0) pb[kk] = d * scale + bias;
    }
    LDS_WAIT(); asm volatile("" ::: "memory");
    float mx = -3.0e38f;
    for (int kk = lane; kk < nkeys; kk += 64) mx = fmaxf(mx, pb[kk]);
    mx = wave_max(mx);
    float sum = 0.f;
    for (int kk = lane; kk < nkeys; kk += 64) { const float e = __expf(pb[kk] - mx); pb[kk] = e; sum += e; }
    sum = wave_sum(sum);
    LDS_WAIT(); asm volatile("" ::: "memory");
    float o0 = 0.f, o1 = 0.f;
#pragma unroll 8
    for (int kk = 0; kk < nkeys; ++kk) {
        int ktok; if (kk < nband) { const int i = kk >> 4, j = kk & 15; ktok = (r0 + i) * GRID_W + c0 + j; } else ktok = SEQ + (kk - nband);
        const unsigned vw = *(const GAS unsigned*)(ZIN + (size_t)ktok * DIN + ZV + head * HD + 2 * lane); const float p = pb[kk];
        o0 += p * pg8::bf_lo(vw); o1 += p * pg8::bf_hi(vw); }
    const float inv = 1.0f / sum;
    *(GAS unsigned*)(YALL + (size_t)tok * DM + YNA + head * HD + 2 * lane) = DIAG_ZERO_NA ? 0u : pk2(o0 * inv, o1 * inv);
    LDS_WAIT(); asm volatile("" ::: "memory");
}


__device__ __forceinline__ void vt_item(const bf16* ZIN, bf16* VT, int item, LAS bf16* scr, int lane) {
    const int t0 = (item >> 4) * 64, c0 = (item & 15) * 64;
#pragma unroll
    for (int i = 0; i < 8; ++i) { const int row = 8 * i + (lane >> 3); const v4u w = *(const GAS v4u*)(ZIN + (size_t)(t0 + row) * DIN + ZV + c0 + 8 * (lane & 7)); *(LAS v4u*)(scr + row * 72 + 8 * (lane & 7)) = w; }
    LDS_WAIT(); asm volatile("" ::: "memory");
#pragma unroll
    for (int i = 0; i < 8; ++i) { const int dd = 8 * i + (lane >> 3), ch = lane & 7; unsigned short e[8];
#pragma unroll
        for (int k = 0; k < 8; ++k) e[k] = scr[(8 * ch + k) * 72 + dd];
        v4u o; o.x = e[0] | ((unsigned)e[1] << 16); o.y = e[2] | ((unsigned)e[3] << 16); o.z = e[4] | ((unsigned)e[5] << 16); o.w = e[6] | ((unsigned)e[7] << 16);
        *(GAS v4u*)(VT + (size_t)(c0 + dd) * MTOT + t0 + 8 * ch) = o; }
    LDS_WAIT(); asm volatile("" ::: "memory");
}

__device__ __forceinline__ void attn_task_v2(const bf16* ZIN, const bf16* VT, bf16* YALL, const float* rpb, int tok0, int head, int lane) {
    const bool isctx = tok0 >= SEQ;
    const int qn = lane & 15, g = lane >> 4;
    const int r = tok0 >> 6, cq0 = tok0 & 63, c = cq0 + qn;
    const int r0 = min(max(r - WIN_R / 2, 0), NROWS - WIN_R), cb = min(max(cq0 - WIN_C / 2, 0), GRID_W - 32), c0 = min(max(c - WIN_C / 2, 0), GRID_W - WIN_C);
    const float C1 = 0.08838834764831845f * 1.4426950408889634f, LOG2E = 1.4426950408889634f;
    bf16x8 qf[4];
#pragma unroll
    for (int s = 0; s < 4; ++s) qf[s] = *(const GAS bf16x8*)(ZIN + (size_t)(tok0 + qn) * DIN + ZQ + head * HD + 32 * s + 8 * g);
    f32x4 o[8];
#pragma unroll
    for (int db = 0; db < 8; ++db) o[db] = (f32x4){0.f, 0.f, 0.f, 0.f};
    float m_run = -1.0e30f, l_run = 0.f;
    const float* rpbh = rpb + head * (2 * WIN_R - 1) * (2 * WIN_C - 1) + (r0 - r + WIN_R - 1) * (2 * WIN_C - 1);
    int bo[8]; unsigned okm = 0u;
#pragma unroll
    for (int i = 0; i < 8; ++i) { const int kc = cb + 8 * g + i; okm |= ((kc >= c0) && (kc < c0 + WIN_C)) ? (1u << i) : 0u; bo[i] = min(max(kc - c + WIN_C - 1, 0), 2 * WIN_C - 2); }
    const int km = lane & 15, kmo = 8 * (km >> 2) + (km & 3);
    bf16x8 kc0[4], kc1[4];
    { const int ksf = isctx ? 8 : 0; const int kb0 = ksf < 8 ? (r0 + ksf) * GRID_W + cb : SEQ + (ksf - 8) * 32;
      const bf16* kp0 = ZIN + (size_t)(kb0 + kmo) * DIN + ZK + head * HD + 8 * g;
#pragma unroll
      for (int s = 0; s < 4; ++s) { kc0[s] = *(const GAS bf16x8*)(kp0 + 32 * s); kc1[s] = *(const GAS bf16x8*)(kp0 + 4 * DIN + 32 * s); } }
    for (int ks = isctx ? 8 : 0; ks < 16; ++ks) {
        const bool band = ks < 8;
        const int kbase = band ? (r0 + ks) * GRID_W + cb : SEQ + (ks - 8) * 32;
        bf16x8 vf[8];
        { const bf16* vp = VT + (size_t)(head * HD + (lane & 15)) * MTOT + kbase + 8 * g;
#pragma unroll
          for (int db = 0; db < 8; ++db) vf[db] = *(const GAS bf16x8*)(vp + (size_t)(16 * db) * MTOT); }
        f32x4 s0 = {0.f, 0.f, 0.f, 0.f}, s1 = {0.f, 0.f, 0.f, 0.f};
#pragma unroll
        for (int s = 0; s < 4; ++s) { s0 = __builtin_amdgcn_mfma_f32_16x16x32_bf16(kc0[s], qf[s], s0, 0, 0, 0); s1 = __builtin_amdgcn_mfma_f32_16x16x32_bf16(kc1[s], qf[s], s1, 0, 0, 0); }
        if (ks + 1 < 16) { const int kn = ks + 1; const int kb1 = kn < 8 ? (r0 + kn) * GRID_W + cb : SEQ + (kn - 8) * 32;
            const bf16* kp0 = ZIN + (size_t)(kb1 + kmo) * DIN + ZK + head * HD + 8 * g;
#pragma unroll
            for (int s = 0; s < 4; ++s) { kc0[s] = *(const GAS bf16x8*)(kp0 + 32 * s); kc1[s] = *(const GAS bf16x8*)(kp0 + 4 * DIN + 32 * s); } }
        float sc[8];
        if (band) { const float* brow = rpbh + ks * (2 * WIN_C - 1);
#pragma unroll
            for (int i = 0; i < 8; ++i) { const float sv = (i < 4 ? s0[i & 3] : s1[i & 3]); sc[i] = ((okm >> i) & 1u) ? sv * C1 + brow[bo[i]] * LOG2E : -1.0e30f; } }
        else {
#pragma unroll
            for (int i = 0; i < 8; ++i) sc[i] = (i < 4 ? s0[i & 3] : s1[i & 3]) * C1; }
        float mx = fmaxf(fmaxf(fmaxf(sc[0], sc[1]), fmaxf(sc[2], sc[3])), fmaxf(fmaxf(sc[4], sc[5]), fmaxf(sc[6], sc[7])));
        mx = fmaxf(mx, __shfl_xor(mx, 16)); mx = fmaxf(mx, __shfl_xor(mx, 32));
        const bool resc = __any(mx > m_run + 6.0f);
        float alpha = 1.0f;
        if (resc) { const float m_new = fmaxf(m_run, mx); alpha = __builtin_amdgcn_exp2f(m_run - m_new); m_run = m_new; l_run *= alpha;
#pragma unroll
            for (int db = 0; db < 8; ++db) o[db] = o[db] * alpha; }
        float p[8], ps = 0.f;
#pragma unroll
        for (int i = 0; i < 8; ++i) { p[i] = __builtin_amdgcn_exp2f(sc[i] - m_run); ps += p[i]; }
        l_run += ps;
        u32x4p pfw; pfw.x = pkbf(p[0], p[1]); pfw.y = pkbf(p[2], p[3]); pfw.z = pkbf(p[4], p[5]); pfw.w = pkbf(p[6], p[7]);
        const bf16x8 pf = __builtin_bit_cast(bf16x8, pfw);
#pragma unroll
        for (int db = 0; db < 8; ++db) o[db] = __builtin_amdgcn_mfma_f32_16x16x32_bf16(vf[db], pf, o[db], 0, 0, 0);
    }
    float lt = l_run; lt += __shfl_xor(lt, 16); lt += __shfl_xor(lt, 32);
    const float inv = 1.0f / lt;
#pragma unroll
    for (int db = 0; db < 8; ++db) { v2u w; w.x = pkbf(o[db][0] * inv, o[db][1] * inv); w.y = pkbf(o[db][2] * inv, o[db][3] * inv);
        *(GAS v2u*)(YALL + (size_t)(tok0 + qn) * DM + YNA + head * HD + 16 * db + 4 * g) = w; }
}


__device__ __forceinline__ size_t fy2_idx(int k1, int grp, int cp, int n2) { return (size_t)((((k1 * 4 + grp) * (GRID_W / 4) + (n2 >> 2)) * FG + cp) * 4 + (n2 & 3)); }
__device__ __forceinline__ v4u pk8(const float (&v)[8]) { v4u o; o.x = pkbf(v[0], v[1]); o.y = pkbf(v[2], v[3]); o.z = pkbf(v[4], v[5]); o.w = pkbf(v[6], v[7]); return o; }
__device__ __forceinline__ void fourAB_item_v3(const Ctx& F0, const bf16* ZIN, unsigned* FY2, int nq, int grp, int cblk) {
    Ctx F = F0; asm volatile("" : "+v"(F.tid)); F.lane = F.tid & 63;
    LAS f32x2* tab = (LAS f32x2*)(F.lds + RING_OFF); LAS v4u* CwP = (LAS v4u*)(F.lds + RING_OFF + 1024); LAS v4u* SwP = CwP + 2048;
    LAS f32x2* twt = (LAS f32x2*)(F.lds + RING_OFF + 1024 + 65536);
    LAS unsigned* XB = (LAS unsigned*)(F.lds + RING_OFF + 1024);
    if (F.tid < 128) { float s, c; sincospif((float)F.tid * (1.0f / 64.0f), &s, &c); tab[F.tid] = (f32x2){c, s}; }
    { const int k1 = F.tid & 127, jj = F.tid >> 7; float s, c; sincospif((float)((4 * nq + jj) * k1) * (2.0f / (float)(NROWS * GRID_W)), &s, &c); twt[jj * 128 + k1] = (f32x2){c, s}; }
    __syncthreads();
#pragma unroll
    for (int q = 0; q < 4; ++q) { const int e = F.tid + 512 * q, ln = e & 63, ks = (e >> 6) & 3, kt = e >> 8; const int k1 = 16 * kt + (ln & 15), gg = ln >> 4; float cv[8], sv[8];
#pragma unroll
        for (int j = 0; j < 8; ++j) { const int n1 = 32 * ks + 16 * (j >> 2) + 4 * gg + (j & 3); const f32x2 t = tab[(k1 * n1) & 127]; cv[j] = t.x; sv[j] = t.y; }
        CwP[e] = pk8(cv); SwP[e] = pk8(sv); }
    const int lane = F.lane, g = lane >> 4, jw = F.wave & 3, n2 = 4 * nq + jw, cpl = 16 * (F.wave >> 2) + (lane & 15), cp = 32 * cblk + cpl;
    bf16x8 Bc[4], Bs[4];
#pragma unroll
    for (int s = 0; s < 4; ++s) { float cv[8], sv[8];
#pragma unroll
        for (int j = 0; j < 8; ++j) { const f32x2 t = tab[((32 * s + 8 * g + j) * cp) & 127]; cv[j] = t.x; sv[j] = t.y; }
        Bc[s] = __builtin_bit_cast(bf16x8, pk8(cv)); Bs[s] = __builtin_bit_cast(bf16x8, pk8(sv)); }
    __syncthreads();
    f32x4 Zc[8], Zs[8];
#pragma unroll
    for (int rt = 0; rt < 8; ++rt) { Zc[rt] = (f32x4){0.f, 0.f, 0.f, 0.f}; Zs[rt] = (f32x4){0.f, 0.f, 0.f, 0.f};
        const bf16* fp = ZIN + (size_t)((16 * rt + (lane & 15)) * GRID_W + n2) * DIN + ZF + grp * FG + 8 * g;
#pragma unroll
        for (int s = 0; s < 4; ++s) { const bf16x8 a = *(const GAS bf16x8*)(fp + 32 * s);
            Zc[rt] = __builtin_amdgcn_mfma_f32_16x16x32_bf16(a, Bc[s], Zc[rt], 0, 0, 0); Zs[rt] = __builtin_amdgcn_mfma_f32_16x16x32_bf16(a, Bs[s], Zs[rt], 0, 0, 0); }
        if (rt & 1) asm volatile("" ::: "memory"); }
    bf16x8 zc[4], zs[4], zn[4];
#pragma unroll
    for (int ks = 0; ks < 4; ++ks) { v4u a, b; a.x = pkbf(Zc[2 * ks][0], Zc[2 * ks][1]); a.y = pkbf(Zc[2 * ks][2], Zc[2 * ks][3]); a.z = pkbf(Zc[2 * ks + 1][0], Zc[2 * ks + 1][1]); a.w = pkbf(Zc[2 * ks + 1][2], Zc[2 * ks + 1][3]);
        b.x = pkbf(Zs[2 * ks][0], Zs[2 * ks][1]); b.y = pkbf(Zs[2 * ks][2], Zs[2 * ks][3]); b.z = pkbf(Zs[2 * ks + 1][0], Zs[2 * ks + 1][1]); b.w = pkbf(Zs[2 * ks + 1][2], Zs[2 * ks + 1][3]);
        zc[ks] = __builtin_bit_cast(bf16x8, a); zs[ks] = __builtin_bit_cast(bf16x8, b); v4u n = b ^ 0x80008000u; zn[ks] = __builtin_bit_cast(bf16x8, n); }
    unsigned ow[8][4];
#pragma unroll
    for (int kt = 0; kt < 8; ++kt) { f32x4 yr = {0.f, 0.f, 0.f, 0.f}, yi = {0.f, 0.f, 0.f, 0.f};
#pragma unroll
        for (int ks = 0; ks < 4; ++ks) { const bf16x8 aC = __builtin_bit_cast(bf16x8, CwP[(kt * 4 + ks) * 64 + lane]), aS = __builtin_bit_cast(bf16x8, SwP[(kt * 4 + ks) * 64 + lane]);
            yr = __builtin_amdgcn_mfma_f32_16x16x32_bf16(aC, zc[ks], yr, 0, 0, 0); yr = __builtin_amdgcn_mfma_f32_16x16x32_bf16(aS, zn[ks], yr, 0, 0, 0);
            yi = __builtin_amdgcn_mfma_f32_16x16x32_bf16(aC, zs[ks], yi, 0, 0, 0); yi = __builtin_amdgcn_mfma_f32_16x16x32_bf16(aS, zc[ks], yi, 0, 0, 0); }
#pragma unroll
        for (int rg = 0; rg < 4; ++rg) { const int k1 = 16 * kt + 4 * g + rg; const f32x2 tw = twt[jw * 128 + k1]; const float ct = tw.x, st = tw.y;
            const float a = yr[rg], b = -yi[rg];
            ow[kt][rg] = pkbf(a * ct + b * st, b * ct - a * st); } }
    __syncthreads();
#pragma unroll
    for (int kt = 0; kt < 8; ++kt)
#pragma unroll
        for (int rg = 0; rg < 4; ++rg) XB[((16 * kt + 4 * g + rg) * 32 + cpl) * 4 + jw] = ow[kt][rg];
    __syncthreads();
#pragma unroll
    for (int i = 0; i < 8; ++i) { const int s = F.tid + 512 * i, k1 = s >> 5, c2 = s & 31;
        *(GAS v4u*)(FY2 + fy2_idx(k1, grp, 32 * cblk + c2, 4 * nq)) = *(const LAS v4u*)(XB + 4 * s); }
    __syncthreads();
}
__device__ __forceinline__ void fourC_table_v2(const Ctx& F, LAS v4u* CS) {
    LAS f32x2* t64 = (LAS f32x2*)(CS + 1024);
    if (F.tid < 64) { float s, c; sincospif((float)F.tid * (1.0f / 32.0f), &s, &c); t64[F.tid] = (f32x2){c, s}; }
    __syncthreads();
#pragma unroll
    for (int q = 0; q < 2; ++q) { const int e = F.tid + 512 * q, ln = e & 63, nt = (e >> 6) & 3, ks = e >> 8; const int k2 = 16 * nt + (ln & 15), gg = ln >> 4; float v[8];
#pragma unroll
        for (int j = 0; j < 8; ++j) { const int k = 32 * ks + 8 * gg + j, n2v = k >> 1; const f32x2 t = t64[(n2v * k2) & 63]; v[j] = (k & 1) ? t.y : t.x; }
        CS[e] = pk8(v); }
}
__device__ __forceinline__ void fourC_item_v2(const unsigned* FY2, bf16* YALL, const LAS v4u* CS, int base, int N1, int k1, int grp, int cq, int lane) {
    const int g = lane >> 4; const float norm = 1.0f / sqrtf((float)(N1 * GRID_W * FG));
    f32x4 acc[2][4];
#pragma unroll
    for (int mt = 0; mt < 2; ++mt)
#pragma unroll
        for (int nt = 0; nt < 4; ++nt) acc[mt][nt] = (f32x4){0.f, 0.f, 0.f, 0.f};
#pragma unroll
    for (int ks = 0; ks < 4; ++ks) { bf16x8 bfr[4];
#pragma unroll
        for (int nt = 0; nt < 4; ++nt) bfr[nt] = __builtin_bit_cast(bf16x8, CS[(ks * 4 + nt) * 64 + lane]);
#pragma unroll
        for (int mt = 0; mt < 2; ++mt) { const int cp = 32 * cq + 16 * mt + (lane & 15);
            const bf16x8 a = *(const GAS bf16x8*)(FY2 + fy2_idx(k1, grp, cp, 16 * ks + 4 * g));
#pragma unroll
            for (int nt = 0; nt < 4; ++nt) acc[mt][nt] = __builtin_amdgcn_mfma_f32_16x16x32_bf16(a, bfr[nt], acc[mt][nt], 0, 0, 0); } }
#pragma unroll
    for (int mt = 0; mt < 2; ++mt)
#pragma unroll
        for (int nt = 0; nt < 4; ++nt) { const int k2 = 16 * nt + (lane & 15), cp0 = 32 * cq + 16 * mt + 4 * g; v2u w; w.x = pkbf(acc[mt][nt][0] * norm, acc[mt][nt][1] * norm); w.y = pkbf(acc[mt][nt][2] * norm, acc[mt][nt][3] * norm);
            *(GAS v2u*)(YALL + (size_t)(base + k1 + N1 * k2) * DM + YF + grp * FG + cp0) = w; }
}


constexpr int A3_KROW = 272, A3_VROW = 144, A3_KB = 64 * A3_KROW, A3_BUF = A3_KB + 128 * A3_VROW;
typedef short s16x4 __attribute__((ext_vector_type(4)));
__device__ __forceinline__ void attn_item_v3(const Ctx& F, const bf16* ZIN, bf16* YALL, const float* rpb, int qtok0, int head) {
    const bool isctx = qtok0 >= SEQ;
    const int lane = F.lane, qn = lane & 15, g = lane >> 4, tid = F.tid;
    const int tok0 = qtok0 + 16 * F.wave;
    const int r = tok0 >> 6, cq0 = tok0 & 63, c = cq0 + qn;
    const int r0w = min(max(r - WIN_R / 2, 0), NROWS - WIN_R), cb = min(max(cq0 - WIN_C / 2, 0), GRID_W - 32), c0 = min(max(c - WIN_C / 2, 0), GRID_W - WIN_C);
    const int rA = qtok0 >> 6, r0A = min(max(rA - WIN_R / 2, 0), NROWS - WIN_R), r0B = min(max(rA + 1 - WIN_R / 2, 0), NROWS - WIN_R);
    const int nband = isctx ? 0 : WIN_R + (r0B - r0A), nsteps = nband + CTX / 64;
    const float C1 = 0.08838834764831845f * 1.4426950408889634f, LOG2E = 1.4426950408889634f;
    LAS unsigned char* const lb = F.lds + RING_OFF;
    bf16x8 qf[4];
#pragma unroll
    for (int s = 0; s < 4; ++s) qf[s] = *(const GAS bf16x8*)(ZIN + (size_t)(tok0 + qn) * DIN + ZQ + head * HD + 32 * s + 8 * g);
    f32x4 o[8];
#pragma unroll
    for (int db = 0; db < 8; ++db) o[db] = (f32x4){0.f, 0.f, 0.f, 0.f};
    float m_run = -1.0e30f, l_run = 0.f;
    const float* rpbh = rpb + head * (2 * WIN_R - 1) * (2 * WIN_C - 1);
    LAS float* bl = (LAS float*)(lb + 2 * A3_BUF);
    if (tid < (2 * WIN_R - 1) * (2 * WIN_C - 1)) bl[tid] = rpbh[tid] * LOG2E;
    int bo[8]; unsigned okm = 0u;
#pragma unroll
    for (int i = 0; i < 8; ++i) { const int kc = cb + 8 * g + i; okm |= ((kc >= c0) && (kc < c0 + WIN_C)) ? (1u << i) : 0u; bo[i] = min(max(kc - c + WIN_C - 1, 0), 2 * WIN_C - 2); }
    v4u st[4];
    const bf16* kp0[2];
#pragma unroll
    for (int i = 0; i < 2; ++i) { const int ch = tid + 512 * i; kp0[i] = ZIN + (size_t)(ch >> 4) * DIN + ZK + head * HD + 8 * (ch & 15); }
#define A3_LOAD(s_) do { const int s__ = (s_); const int tb = s__ < nband ? (r0A + s__) * GRID_W : SEQ + 64 * (s__ - nband); const size_t toff = (size_t)tb * DIN; \
        _Pragma("unroll") for (int i = 0; i < 2; ++i) { st[i] = *(const GAS v4u*)(kp0[i] + toff); st[2 + i] = *(const GAS v4u*)(kp0[i] + toff + (ZV - ZK)); } } while (0)
#define A3_STORE(b_) do { LAS unsigned char* bb = lb + (b_) * A3_BUF; \
        _Pragma("unroll") for (int i = 0; i < 2; ++i) { const int ch = tid + 512 * i; *(LAS v4u*)(bb + (ch >> 4) * A3_KROW + 16 * (ch & 15)) = st[i]; { const int r_ = ch >> 4, c_ = ch & 15, sv_ = (r_ & 3) | (((r_ >> 3) & 1) << 2); *(LAS v4u*)(bb + A3_KB + r_ * 256 + ((((c_ >> 1) ^ sv_) << 5) | ((c_ & 1) << 4))) = st[2 + i]; } } } while (0)
    A3_LOAD(0); A3_STORE(0);
    __builtin_amdgcn_s_waitcnt(0x0F70);
    __syncthreads();
    if (nsteps > 1) A3_LOAD(1);
    const int km = lane & 15, kmo = 8 * (km >> 2) + (km & 3);
    for (int s = 0; s < nsteps; ++s) {
        if (s + 1 < nsteps) A3_STORE((s + 1) & 1);
        if (s + 2 < nsteps) A3_LOAD(s + 2);
        const LAS unsigned char* bb = lb + (s & 1) * A3_BUF;
        const bool band = s < nband; const int rb = r0A + s;
        const int nk = band ? ((rb >= r0w && rb < r0w + WIN_R) ? 1 : 0) : 2;
        for (int kq = 0; kq < nk; ++kq) {
            const int koff = band ? cb : 32 * kq;
            const LAS unsigned char* kp = bb + (koff + kmo) * A3_KROW + 16 * g;
            f32x4 s0 = {0.f, 0.f, 0.f, 0.f}, s1 = {0.f, 0.f, 0.f, 0.f};
#pragma unroll
            for (int sk = 0; sk < 4; ++sk) { const bf16x8 k0 = *(const LAS bf16x8*)(kp + 64 * sk), k1 = *(const LAS bf16x8*)(kp + 4 * A3_KROW + 64 * sk);
                s0 = __builtin_amdgcn_mfma_f32_16x16x32_bf16(k0, qf[sk], s0, 0, 0, 0); s1 = __builtin_amdgcn_mfma_f32_16x16x32_bf16(k1, qf[sk], s1, 0, 0, 0); }
            const int tq = (lane & 15) >> 2, tp = lane & 3, vsw = tq | ((((koff >> 3) + g) & 1) << 2);
            const LAS unsigned char* vb0 = bb + A3_KB + (koff + 8 * g + tq) * 256 + 8 * tp;
            bf16x8 vf[8];
#pragma unroll
            for (int db = 0; db < 8; ++db) { const int blk = (db ^ vsw) << 5;
                const s16x4 lo = __builtin_amdgcn_ds_read_tr16_b64_v4i16((LAS s16x4*)(vb0 + blk)), hi = __builtin_amdgcn_ds_read_tr16_b64_v4i16((LAS s16x4*)(vb0 + 4 * 256 + blk));
                vf[db] = (bf16x8){lo[0], lo[1], lo[2], lo[3], hi[0], hi[1], hi[2], hi[3]}; }
            float sc[8];
            if (band) { const LAS float* brow = bl + (rb - r + WIN_R - 1) * (2 * WIN_C - 1); float bv[8];
#pragma unroll
                for (int i = 0; i < 8; ++i) bv[i] = brow[bo[i]];
                asm volatile("" : "+v"(bv[0]), "+v"(bv[1]), "+v"(bv[2]), "+v"(bv[3]), "+v"(bv[4]), "+v"(bv[5]), "+v"(bv[6]), "+v"(bv[7]));
#pragma unroll
                for (int i = 0; i < 8; ++i) { const float sv = (i < 4 ? s0[i & 3] : s1[i & 3]); sc[i] = ((okm >> i) & 1u) ? sv * C1 + bv[i] : -1.0e30f; } }
            else {
#pragma unroll
                for (int i = 0; i < 8; ++i) sc[i] = (i < 4 ? s0[i & 3] : s1[i & 3]) * C1; }
            float mx = fmaxf(fmaxf(fmaxf(sc[0], sc[1]), fmaxf(sc[2], sc[3])), fmaxf(fmaxf(sc[4], sc[5]), fmaxf(sc[6], sc[7])));
            const bool resc = __any(mx > m_run + 6.0f);
            if (resc) { mx = fmaxf(mx, __shfl_xor(mx, 16)); mx = fmaxf(mx, __shfl_xor(mx, 32));
                const float m_new = fmaxf(m_run, mx); const float alpha = __builtin_amdgcn_exp2f(m_run - m_new); m_run = m_new; l_run *= alpha;
#pragma unroll
                for (int db = 0; db < 8; ++db) o[db] = o[db] * alpha; }
            float p[8], ps = 0.f;
#pragma unroll
            for (int i = 0; i < 8; ++i) { p[i] = __builtin_amdgcn_exp2f(sc[i] - m_run); ps += p[i]; }
            l_run += ps;
            u32x4p pfw; pfw.x = pkbf(p[0], p[1]); pfw.y = pkbf(p[2], p[3]); pfw.z = pkbf(p[4], p[5]); pfw.w = pkbf(p[6], p[7]);
            const bf16x8 pf = __builtin_bit_cast(bf16x8, pfw);
#pragma unroll
            for (int db = 0; db < 8; ++db) o[db] = __builtin_amdgcn_mfma_f32_16x16x32_bf16(vf[db], pf, o[db], 0, 0, 0);
        }
        __syncthreads();
    }
#undef A3_LOAD
#undef A3_STORE
    float lt = l_run; lt += __shfl_xor(lt, 16); lt += __shfl_xor(lt, 32);
    const float inv = 1.0f / lt;
#pragma unroll
    for (int db = 0; db < 8; ++db) { v2u w; w.x = pkbf(o[db][0] * inv, o[db][1] * inv); w.y = pkbf(o[db][2] * inv, o[db][3] * inv);
        *(GAS v2u*)(YALL + (size_t)(tok0 + qn) * DM + YNA + head * HD + 16 * db + 4 * g) = w; }
}

__device__ __forceinline__ void conv_item_v1(const Ctx& F, const bf16* ZIN, bf16* YALL, const float* wdw, const float* bdw, const float* lg, const float* lb, int base, int len, int t0) {
    LAS float* ut = (LAS float*)(F.lds + RING_OFF);
    const int ch = F.tid;
    { const int chunk = F.tid & 63, rsub = F.tid >> 6;
        v4u aw[4], gw[4];
#define CV_LOAD(slot_, ps_) do { const int rr_ = 8 * (ps_) + rsub, t_ = t0 - CONVW / 2 + rr_; aw[slot_] = (v4u){0u, 0u, 0u, 0u}; gw[slot_] = aw[slot_]; \
            if (rr_ < 32 + CONVW - 1 && t_ >= 0 && t_ < len) { const bf16* zp = ZIN + (size_t)(base + t_) * DIN + 8 * chunk; aw[slot_] = *(const GAS v4u*)(zp + ZA); gw[slot_] = *(const GAS v4u*)(zp + ZG); } } while (0)
#define CV_COMP(slot_, ps_) do { const int rr_ = 8 * (ps_) + rsub; \
            if (rr_ < 32 + CONVW - 1) { f32x4 u0, u1; const v4u A_ = aw[slot_], G_ = gw[slot_]; \
                u0[0] = pg8::bf_lo(A_.x) * sigm(pg8::bf_lo(G_.x)); u0[1] = pg8::bf_hi(A_.x) * sigm(pg8::bf_hi(G_.x)); u0[2] = pg8::bf_lo(A_.y) * sigm(pg8::bf_lo(G_.y)); u0[3] = pg8::bf_hi(A_.y) * sigm(pg8::bf_hi(G_.y)); \
                u1[0] = pg8::bf_lo(A_.z) * sigm(pg8::bf_lo(G_.z)); u1[1] = pg8::bf_hi(A_.z) * sigm(pg8::bf_hi(G_.z)); u1[2] = pg8::bf_lo(A_.w) * sigm(pg8::bf_lo(G_.w)); u1[3] = pg8::bf_hi(A_.w) * sigm(pg8::bf_hi(G_.w)); \
                *(LAS f32x4*)(ut + rr_ * DCONV + 8 * chunk) = u0; *(LAS f32x4*)(ut + rr_ * DCONV + 8 * chunk + 4) = u1; } } while (0)
        CV_LOAD(0, 0); CV_LOAD(1, 1); CV_LOAD(2, 2); CV_LOAD(3, 3);
#pragma unroll
        for (int s = 0; s < 8; ++s) { CV_COMP(s & 3, s); if (s + 4 < 8) CV_LOAD(s & 3, s + 4); asm volatile("" ::: "memory"); }
#undef CV_LOAD
#undef CV_COMP
    }
    float w[CONVW];
#pragma unroll
    for (int j = 0; j < CONVW; ++j) w[j] = wdw[j * DCONV + ch];
    const float bias = bdw[ch];
    __syncthreads();
    float y[32];
#pragma unroll
    for (int n = 0; n < 32; ++n) { float a = bias;
#pragma unroll
        for (int j = 0; j < CONVW; ++j) a += ut[(n + j) * DCONV + ch] * w[j];
        y[n] = a; }
    __syncthreads();
#pragma unroll
    for (int n = 0; n < 32; ++n) ut[n * DCONV + ch] = y[n];
    __syncthreads();
    { float v[4][8], s[4], q[4];
#pragma unroll
      for (int qn = 0; qn < 4; ++qn) { const int n = F.wave * 4 + qn; s[qn] = 0.f;
#pragma unroll
        for (int i = 0; i < 8; ++i) { v[qn][i] = ut[n * DCONV + F.lane + 64 * i]; s[qn] += v[qn][i]; } }
#pragma unroll
      for (int qn = 0; qn < 4; ++qn) s[qn] = wave_sum(s[qn]);
#pragma unroll
      for (int qn = 0; qn < 4; ++qn) { const float mean = s[qn] * (1.0f / DCONV); q[qn] = 0.f;
#pragma unroll
        for (int i = 0; i < 8; ++i) { v[qn][i] -= mean; q[qn] += v[qn][i] * v[qn][i]; } }
#pragma unroll
      for (int qn = 0; qn < 4; ++qn) q[qn] = wave_sum(q[qn]);
#pragma unroll
      for (int qn = 0; qn < 4; ++qn) { const int n = F.wave * 4 + qn; const float rstd = 1.0f / sqrtf(q[qn] * (1.0f / DCONV) + LN_EPS);
#pragma unroll
        for (int i = 0; i < 8; ++i) { const int c2 = F.lane + 64 * i; const float z = v[qn][i] * rstd * lg[c2] + lb[c2]; YALL[(size_t)(base + t0 + n) * DM + YC + c2] = DIAG_ZERO_C ? (bf16)0 : (bf16)f2bf(z * sigm(z)); } } }
    __syncthreads();
}

__device__ __forceinline__ void four_cs_table(const Ctx& F, LAS f32x2* cs) { if (F.tid < 128) { float s, c; sincospif((float)F.tid * (1.0f / 64.0f), &s, &c); cs[F.tid] = (f32x2){c, s}; } }
__device__ __forceinline__ void fourAB_ctx_v3(const Ctx& F, const bf16* ZIN, unsigned* FY2s, int nq, int grp) {
    constexpr int N1 = CTX / GRID_W;
    LAS f32x2* tab = (LAS f32x2*)(F.lds + RING_OFF);
    LAS f32x2* tw = (LAS f32x2*)(F.lds + RING_OFF + 1024);
    LAS unsigned char* fin = F.lds + RING_OFF + 2048;
    LAS unsigned* XO = (LAS unsigned*)(F.lds + RING_OFF + 8192);
    if (F.tid < 128) { float s, c; sincospif((float)F.tid * (1.0f / 64.0f), &s, &c); tab[F.tid] = (f32x2){c, s}; }
    else if (F.tid < 144) { const int e = F.tid - 128, jj = e >> 2, k1 = e & 3; float s, c; sincospif(2.0f * (float)((4 * nq + jj) * k1) / (float)(N1 * GRID_W), &s, &c); tw[e] = (f32x2){c, s}; }
    else if (F.tid >= 256) { const int e = F.tid - 256, r = e >> 4, chn = e & 15, jj = r >> 2, n1 = r & 3;
        *(LAS v4u*)(fin + r * 272 + 16 * chn) = *(const GAS v4u*)(ZIN + (size_t)(SEQ + n1 * GRID_W + 4 * nq + jj) * DIN + ZF + grp * FG + 8 * chn); }
    __syncthreads();
    const int lane = F.lane, g = lane >> 4, cp = 16 * F.wave + (lane & 15);
    f32x4 Zc = {0.f, 0.f, 0.f, 0.f}, Zs = {0.f, 0.f, 0.f, 0.f};
#pragma unroll
    for (int s = 0; s < 4; ++s) { float cv[8], sv[8];
#pragma unroll
        for (int j = 0; j < 8; ++j) { const f32x2 t = tab[((32 * s + 8 * g + j) * cp) & 127]; cv[j] = t.x; sv[j] = t.y; }
        const bf16x8 bc = __builtin_bit_cast(bf16x8, pk8(cv)), bs = __builtin_bit_cast(bf16x8, pk8(sv));
        const bf16x8 a = *(const LAS bf16x8*)(fin + (lane & 15) * 272 + 64 * s + 16 * g);
        Zc = __builtin_amdgcn_mfma_f32_16x16x32_bf16(a, bc, Zc, 0, 0, 0); Zs = __builtin_amdgcn_mfma_f32_16x16x32_bf16(a, bs, Zs, 0, 0, 0); }
#pragma unroll
    for (int k1 = 0; k1 < N1; ++k1) { float yr = 0.f, yi = 0.f;
#pragma unroll
        for (int n1 = 0; n1 < N1; ++n1) { const int m = (k1 * n1) & 3; const float c4 = (m == 0) ? 1.f : (m == 2 ? -1.f : 0.f), s4 = (m == 1) ? 1.f : (m == 3 ? -1.f : 0.f);
            const float a = Zc[n1], b = Zs[n1]; yr += c4 * a - s4 * b; yi -= c4 * b + s4 * a; }
        const f32x2 t = tw[g * 4 + k1]; const float ct = t.x, st = t.y;
        XO[(k1 * 128 + cp) * 4 + g] = pkbf(yr * ct + yi * st, yi * ct - yr * st); }
    __syncthreads();
    { const int k1 = F.tid >> 7, c2 = F.tid & 127; *(GAS v4u*)(FY2s + fy2_idx(k1, grp, c2, 4 * nq)) = *(const LAS v4u*)(XO + 4 * F.tid); }
    __syncthreads();
}
__device__ __forceinline__ void fourAB_ctx_v2(const Ctx& F, const bf16* ZIN, unsigned* FY2s, int nq, int grp, int half) {
    constexpr int N1 = CTX / GRID_W;
    LAS f32x2* cs = (LAS f32x2*)(F.lds + RING_OFF); LAS bf16* fin = (LAS bf16*)(F.lds + RING_OFF + 1024);
    LAS float* Fc = (LAS float*)(F.lds + RING_OFF + 1024 + 4096); LAS float* Fs = Fc + 1024;
    LAS unsigned* XO = (LAS unsigned*)(F.lds + RING_OFF + 1024 + 3 * 4096);
    four_cs_table(F, cs);
#pragma unroll
    for (int i = 0; i < 4; ++i) { const int idx = F.tid + 512 * i, jj = idx >> 9, n1 = (idx >> 7) & 3, c = idx & 127; fin[idx] = ZIN[(size_t)(SEQ + n1 * GRID_W + 4 * nq + jj) * DIN + ZF + grp * FG + c]; }
    __syncthreads();
    const int cpp = F.tid & 63, h2 = (F.tid >> 6) & 1, j = F.tid >> 7, cp = half * 64 + cpp, n2 = 4 * nq + j;
#pragma unroll
    for (int u = 0; u < 2; ++u) { const int n1 = 2 * h2 + u; float fc = 0.f, fs = 0.f;
        for (int c = 0; c < 128; ++c) { const float x = bf2f(fin[(j * 4 + n1) * 128 + c]); const f32x2 t = cs[(c * cp) & 127]; fc += x * t.x; fs += x * t.y; }
        Fc[(j * 4 + n1) * 64 + cpp] = fc; Fs[(j * 4 + n1) * 64 + cpp] = fs; }
    __syncthreads();
    const int tstep = 128 / N1;
#pragma unroll
    for (int u = 0; u < 2; ++u) { const int k1 = 2 * h2 + u; float yr = 0.f, yi = 0.f;
#pragma unroll
        for (int n1 = 0; n1 < N1; ++n1) { const f32x2 t = cs[((k1 * n1) & (N1 - 1)) * tstep]; const float a = Fc[(j * 4 + n1) * 64 + cpp], b = Fs[(j * 4 + n1) * 64 + cpp]; yr += t.x * a - t.y * b; yi -= t.x * b + t.y * a; }
        float st, ct; sincospif(2.0f * (float)(n2 * k1) / (float)(N1 * GRID_W), &st, &ct);
        XO[(k1 * 64 + cpp) * 4 + j] = pkbf(yr * ct + yi * st, yi * ct - yr * st); }
    __syncthreads();
    if (F.tid < 256) { const int k1 = F.tid >> 6, c2 = F.tid & 63; *(GAS v4u*)(FY2s + fy2_idx(k1, grp, half * 64 + c2, 4 * nq)) = *(const LAS v4u*)(XO + 4 * F.tid); }
    __syncthreads();
}
__device__ __forceinline__ void fourC_item_v1(const Ctx& F, const float* FY, bf16* YALL, int base, int N1, int k1, int grp) {
    LAS f32x2* cs = (LAS f32x2*)(F.lds + RING_OFF); LAS f32x2* Yt = (LAS f32x2*)(F.lds + RING_OFF + 1024);
    four_cs_table(F, cs);
    for (int idx = F.tid; idx < 64 * 128; idx += 512) { const int n2 = idx >> 7, cp = idx & 127; Yt[idx] = *(const GAS f32x2*)(FY + ((size_t)(base + k1 * GRID_W + n2) * DFOUR + grp * FG + cp) * 2); }
    __syncthreads();
    const int cp = F.tid & 127, kg = F.tid >> 7; const float norm = 1.0f / sqrtf((float)(N1 * GRID_W * FG));
    for (int k2 = kg; k2 < 64; k2 += 4) { float a = 0.f;
        for (int n2 = 0; n2 < 64; ++n2) { const f32x2 t = cs[((n2 * k2) & 63) * 2]; const f32x2 y = Yt[n2 * 128 + cp]; a += t.x * y.x + t.y * y.y; }
        YALL[(size_t)(base + k1 + N1 * k2) * DM + YF + grp * FG + cp] = (bf16)f2bf(a * norm); }
    __syncthreads();
}

#if MK_DIAG
constexpr int CW_DIAG = 64;
__device__ __forceinline__ unsigned dg_hash(unsigned x) { x ^= x >> 16; x *= 0x7feb352du; x ^= x >> 15; x *= 0x846ca68bu; x ^= x >> 16; return x; }
__device__ __forceinline__ void dg_fail(unsigned char* ws, int id) { atomicMax((unsigned*)(ws + WS_CTL) + CW_DIAG, (unsigned)(200 - id)); }
__device__ __forceinline__ bool dg_bad(float got, float exp, float rel, float ab) { return !(fabsf(got - exp) <= ab + rel * fabsf(exp)); }
__device__ __forceinline__ float dg_dot(const bf16* a, const bf16* b, int K, int lane) { float s = 0.f; for (int k = lane; k < K; k += 64) s += bf2f(a[k]) * bf2f(b[k]); return wave_sum(s); }

__global__ void __launch_bounds__(256) dg_gemm(Args a, int mode, int l, int f, int nrows, int id, float gmul, int gi) {
    unsigned char* ws = a.ws; unsigned char* wl = ws + WS_W + (size_t)l * WL_SIZE; const int lane = threadIdx.x & 63;
    const int smp = blockIdx.x * 4 + (threadIdx.x >> 6);
    const unsigned h1 = dg_hash(smp * 2 + 1 + 7919u * id), h2 = dg_hash(smp * 2 + 2 + 104729u * id);
    const int row = h1 % nrows;
    const bf16* H = (const bf16*)(ws + WS_H); const bf16* G = (const bf16*)(ws + WS_G); const bf16* YALL = (const bf16*)(ws + WS_YALL); const bf16* MB = (const bf16*)(ws + WS_MB); const bf16* GATES = (const bf16*)(ws + WS_GATES);
    if (mode == 0) { const int c = h2 % DFF; const bf16* W = (const bf16*)(wl + (f == 0 ? WL_W13A : WL_W13B));
        const float av = dg_dot(H + (size_t)row * DM, W + (size_t)((c / 128) * 256 + c % 128) * DM, DM, lane), bv = dg_dot(H + (size_t)row * DM, W + (size_t)((c / 128) * 256 + 128 + c % 128) * DM, DM, lane);
        const float exp = av * sigm(av) * bv, got = bf2f(G[(size_t)row * DFF + c]);
        if (lane == 0 && dg_bad(got, exp, 1e-2f, 2e-3f)) dg_fail(ws, id); }
    else if (mode == 1) { const int c = h2 % DM; float d;
        if (gi == 5 && gmul == 1.0f) d = dg_dot(MB + (size_t)row * DM, (const bf16*)(wl + WL_WO) + (size_t)c * DM, DM, lane);
        else d = dg_dot(G + (size_t)row * DFF, (const bf16*)(wl + (f == 0 ? WL_W2A : WL_W2B)) + (size_t)c * DFF, DFF, lane);
        const float gate = mod_vec(ws, l, row >= SEQ ? 1 : 0, gi)[c];
        const float exp = gmul * gate * d, got = bf2f(((const bf16*)(ws + WS_T))[(size_t)row * DM + c]);
        if (lane == 0 && dg_bad(got, exp, 1e-2f, 1e-3f)) dg_fail(ws, id); }
    else if (mode == 2) { const int c = h2 % DIN;
        const float exp = dg_dot(H + (size_t)row * DM, (const bf16*)(wl + WL_WIN) + (size_t)c * DM, DM, lane), got = bf2f(((const bf16*)(ws + WS_ZIN))[(size_t)row * DIN + c]);
        if (lane == 0 && dg_bad(got, exp, 1e-2f, 2e-3f)) dg_fail(ws, id); }
    else if (mode == 3) { const int c = h2 % (3 * DM);
        const float pre = dg_dot(H + (size_t)row * DM, (const bf16*)(wl + WL_WG) + (size_t)c * DM, DM, lane) + a.in[I_BGATE][(size_t)l * 3 * DM + c];
        const float exp = sigm(pre), got = bf2f(GATES[(size_t)row * 3 * DM + c]);
        if (lane == 0 && dg_bad(got, exp, 1e-2f, 2e-3f)) { dg_fail(ws, id); unsigned* D = (unsigned*)(ws + WS_CTL) + CW_DIAG; atomicAdd(D + 2, 1u);
            const float bias = a.in[I_BGATE][(size_t)l * 3 * DM + c]; int hyp = 4;
            if (!dg_bad(got, sigm(pre - bias), 1e-2f, 2e-3f)) hyp = 1; else if (!dg_bad(got, pre, 1e-2f, 2e-3f)) hyp = 2; else if (got == 0.5f || got < 1e-6f) hyp = 3;
            atomicAdd(D + 4 + hyp, 1u); atomicMax(D + 10, (unsigned)(100 - row / 256)); } }
    else { const int c = h2 % DM; const bf16* W = (const bf16*)(wl + WL_WB) + (size_t)c * DM; const bf16* y = YALL + (size_t)row * DM;
        const float p0 = dg_dot(y, W, DNA, lane), p1 = dg_dot(y + DNA, W + DNA, DFOUR, lane), p2 = dg_dot(y + DNA + DFOUR, W + DNA + DFOUR, DCONV, lane);
        const float g0 = bf2f(GATES[(size_t)row * 3 * DM + c]), g1 = bf2f(GATES[(size_t)row * 3 * DM + DM + c]), g2 = bf2f(GATES[(size_t)row * 3 * DM + 2 * DM + c]);
        const float exp = g0 * p0 + g1 * p1 + g2 * p2, got = bf2f(MB[(size_t)row * DM + c]);
        if (lane == 0 && dg_bad(got, exp, 1.5e-2f, 3e-3f)) dg_fail(ws, id); }
}
__global__ void __launch_bounds__(256) dg_trans(Args a, int id, int l, unsigned wmask) {
    unsigned char* ws = a.ws; const int t = blockIdx.x * 256 + threadIdx.x; const int which = (t >> 1) % 12; if (!((wmask >> which) & 1u)) return; const unsigned h1 = dg_hash(t * 3 + 1), h2 = dg_hash(t * 3 + 2);
    unsigned char* wl = ws + WS_W + (size_t)l * WL_SIZE; float src; bf16 got;
    if (which < 6) { const int ff = which / 3, w = which % 3;
        if (w < 2) { const int k = h1 % DM, n = h2 % DFF; src = a.in[(ff ? I_F2W1 : I_F1W1) + w][(size_t)l * DM * DFF + (size_t)k * DFF + n]; got = ((const bf16*)(wl + (ff ? WL_W13B : WL_W13A)))[(size_t)((n / 128) * 256 + w * 128 + n % 128) * DM + k]; }
        else { const int k = h1 % DFF, n = h2 % DM; src = a.in[ff ? I_F2W2 : I_F1W2][(size_t)l * DFF * DM + (size_t)k * DM + n]; got = ((const bf16*)(wl + (ff ? WL_W2B : WL_W2A)))[(size_t)n * DFF + k]; } }
    else if (which == 6) { const int k = h1 % DM, n = h2 % DIN; src = a.in[I_WIN][(size_t)l * DM * DIN + (size_t)k * DIN + n]; got = ((const bf16*)(wl + WL_WIN))[(size_t)n * DM + k]; }
    else if (which == 7) { const int k = h1 % DM, n = h2 % (3 * DM); src = a.in[I_WGATE][(size_t)l * DM * 3 * DM + (size_t)k * 3 * DM + n]; got = ((const bf16*)(wl + WL_WG))[(size_t)n * DM + k]; }
    else if (which == 8) { const int k = h1 % DNA, n = h2 % DM; src = a.in[I_WBNA][(size_t)l * DNA * DM + (size_t)k * DM + n]; got = ((const bf16*)(wl + WL_WB))[(size_t)n * DM + k]; }
    else if (which == 9) { const int k = h1 % DFOUR, n = h2 % DM; src = a.in[I_WBF][(size_t)l * DFOUR * DM + (size_t)k * DM + n]; got = ((const bf16*)(wl + WL_WB))[(size_t)n * DM + DNA + k]; }
    else if (which == 10) { const int k = h1 % DCONV, n = h2 % DM; src = a.in[I_WBC][(size_t)l * DCONV * DM + (size_t)k * DM + n]; got = ((const bf16*)(wl + WL_WB))[(size_t)n * DM + DNA + DFOUR + k]; }
    else { const int k = h1 % DM, n = h2 % DM; src = a.in[I_WO][(size_t)l * DM * DM + (size_t)k * DM + n]; got = ((const bf16*)(wl + WL_WO))[(size_t)n * DM + k]; }
    if (got != (bf16)f2bf(src)) dg_fail(ws, id);
}
__global__ void __launch_bounds__(256) dg_mod(Args a, int id) {
    unsigned char* ws = a.ws; const int lane = threadIdx.x & 63; const int smp = blockIdx.x * 4 + (threadIdx.x >> 6);
    const int l = smp & 1, s = (smp >> 1) & 1, j = dg_hash(smp) % (NMODU * DM);
    const float* cv = s ? a.in[I_CCTX] : a.in[I_C]; float acc = 0.f;
    for (int k = lane; k < DM; k += 64) { const float c = cv[k]; acc += c * sigm(c) * a.in[I_WADA][(size_t)l * DM * ADA_N + (size_t)k * ADA_N + j]; }
    acc = wave_sum(acc) + a.in[I_BADA][(size_t)l * ADA_N + j];
    const float got = ((const float*)(ws + WS_MOD))[(size_t)(l * 2 + s) * (NMODU * DM) + j];
    if (lane == 0 && dg_bad(got, acc, 1e-4f, 1e-4f)) dg_fail(ws, id);
    const int row = dg_hash(smp + 77777u) % MTOT, col = dg_hash(smp + 99991u) % DM; const int sx = row >= SEQ;
    const float xv = sx ? a.in[I_CTX][(size_t)(row - SEQ) * DM + col] : a.in[I_X][(size_t)row * DM + col];
    const float sh = mod_vec(ws, 0, sx, 0)[col], sc = mod_vec(ws, 0, sx, 1)[col];
    if (lane == 0 && (dg_bad((float)((const xh*)(ws + WS_X))[(size_t)row * DM + col], xv, 1e-3f, 1e-4f) || dg_bad(bf2f(((const bf16*)(ws + WS_H))[(size_t)row * DM + col]), xv * (1.f + sc) + sh, 1e-2f, 1e-3f))) dg_fail(ws, id + 1);
}
__global__ void __launch_bounds__(256) dg_ln(Args a, int l, int which, int nrows, int final_out, int id) {
    unsigned char* ws = a.ws; const int lane = threadIdx.x & 63; const int smp = blockIdx.x * 4 + (threadIdx.x >> 6); const int row = dg_hash(smp + 31u * id) % nrows;
    const float* Xo32 = a.out + (size_t)row * DM; const xh* Xo16 = (const xh*)(ws + WS_X) + (size_t)row * DM;
#define Xo(k_) (final_out ? Xo32[k_] : (float)Xo16[k_])
    const float* lg = a.in[I_LNG] + (size_t)(l * 3 + which) * DM; const float* lb = a.in[I_LNB] + (size_t)(l * 3 + which) * DM;
    float s = 0.f, q = 0.f;
    for (int k = lane; k < DM; k += 64) { const float z = (Xo(k) - lb[k]) / lg[k]; s += z; q += z * z; }
    s = wave_sum(s) / DM; q = wave_sum(q) / DM; bool bad = fabsf(s) > 1e-3f || fabsf(q - 1.0f) > 1e-2f;
    const int ml = which == 2 ? l + 1 : l, mi = which == 2 ? 0 : 3, sx = row >= SEQ;
    if (!final_out) for (int k = lane; k < DM; k += 64) { const float h = Xo(k) * (1.f + mod_vec(ws, ml, sx, mi + 1)[k]) + mod_vec(ws, ml, sx, mi)[k]; bad |= dg_bad(bf2f(((const bf16*)(ws + WS_H))[(size_t)row * DM + k]), h, 1e-2f, 2e-3f); }
    if (bad) dg_fail(ws, id);
#undef Xo
}
__global__ void __launch_bounds__(256) dg_attn(Args a, int l, int ntok, int id) {
    __shared__ float P[4][384];
    unsigned char* ws = a.ws; const int lane = threadIdx.x & 63, wv = threadIdx.x >> 6; const int smp = blockIdx.x * 4 + wv;
    const int tok = dg_hash(smp * 2 + 5u) % ntok, head = dg_hash(smp * 2 + 6u) % NH; const bf16* Z = (const bf16*)(ws + WS_ZIN);
    const float* rpb = a.in[I_RPB] + (size_t)l * NH * 15 * 31;
    const int r = tok / 64, c = tok % 64, r0 = min(max(r - 4, 0), 120), c0 = min(max(c - 8, 0), 48); const bool cx = tok >= SEQ; const int nk = cx ? 256 : 384;
    float mx = -1e30f;
    for (int kk = lane; kk < nk; kk += 64) { int kt; float bias = 0.f;
        if (!cx && kk < 128) { const int kr = r0 + kk / 16, kc = c0 + kk % 16; kt = kr * 64 + kc; bias = rpb[(head * 15 + (kr - r + 7)) * 31 + (kc - c + 15)]; } else kt = SEQ + (cx ? kk : kk - 128);
        float d = 0.f; for (int e = 0; e < 128; ++e) d += bf2f(Z[(size_t)tok * DIN + head * 128 + e]) * bf2f(Z[(size_t)kt * DIN + 1024 + head * 128 + e]);
        d = d * 0.08838834764831845f + bias; P[wv][kk] = d; mx = fmaxf(mx, d); }
    mx = wave_max(mx); float sum = 0.f;
    for (int kk = lane; kk < nk; kk += 64) { const float e = expf(P[wv][kk] - mx); P[wv][kk] = e; sum += e; }
    sum = wave_sum(sum); __syncthreads(); bool bad = false;
    for (int d = lane; d < 128; d += 64) { float o = 0.f;
        for (int kk = 0; kk < nk; ++kk) { int kt; if (!cx && kk < 128) kt = (r0 + kk / 16) * 64 + c0 + kk % 16; else kt = SEQ + (cx ? kk : kk - 128); o += P[wv][kk] * bf2f(Z[(size_t)kt * DIN + 2048 + head * 128 + d]); }
        o /= sum; bad |= dg_bad(bf2f(((const bf16*)(ws + WS_YALL))[(size_t)tok * DM + head * 128 + d]), o, 1e-2f, 2e-3f); }
    if (bad) dg_fail(ws, id);
}
__global__ void __launch_bounds__(256) dg_conv(Args a, int l, int ntok, int id) {
    unsigned char* ws = a.ws; const int lane = threadIdx.x & 63; const int smp = blockIdx.x * 4 + (threadIdx.x >> 6); const int tok = dg_hash(smp + 1234567u) % ntok;
    const bf16* Z = (const bf16*)(ws + WS_ZIN); const int base = tok >= SEQ ? SEQ : 0, len = tok >= SEQ ? CTX : SEQ, t = tok - base;
    float y[8]; float s = 0.f;
#pragma unroll
    for (int i = 0; i < 8; ++i) { const int ch = lane + 64 * i; float acc = a.in[I_BDW][l * DCONV + ch];
        for (int j = 0; j < CONVW; ++j) { const int tt = t + j - 15; if (tt >= 0 && tt < len) { const float av = bf2f(Z[(size_t)(base + tt) * DIN + 3584 + ch]), gv = bf2f(Z[(size_t)(base + tt) * DIN + 4096 + ch]); acc += av * sigm(gv) * a.in[I_WDW][(size_t)l * CONVW * DCONV + j * DCONV + ch]; } }
        y[i] = acc; s += acc; }
    const float mean = wave_sum(s) / DCONV; float q = 0.f;
#pragma unroll
    for (int i = 0; i < 8; ++i) { const float d = y[i] - mean; q += d * d; }
    const float rstd = 1.0f / sqrtf(wave_sum(q) / DCONV + LN_EPS); bool bad = false;
#pragma unroll
    for (int i = 0; i < 8; ++i) { const int ch = lane + 64 * i; const float z = (y[i] - mean) * rstd * a.in[I_CLNG][l * DCONV + ch] + a.in[I_CLNB][l * DCONV + ch];
        bad |= dg_bad(bf2f(((const bf16*)(ws + WS_YALL))[(size_t)tok * DM + 1536 + ch]), z * sigm(z), 1e-2f, 3e-3f); }
    if (bad) dg_fail(ws, id);
}
__global__ void __launch_bounds__(256) dg_four(Args a, int ntok, int id) {
    unsigned char* ws = a.ws; const int lane = threadIdx.x & 63; const int smp = blockIdx.x * 4 + (threadIdx.x >> 6);
    const int tok = smp == 0 ? 0 : (int)(dg_hash(smp + 424242u) % ntok), col = dg_hash(smp + 31337u) % DFOUR; const int grp = col / 128, cp = col % 128;
    const int base = tok >= SEQ ? SEQ : 0, N = tok >= SEQ ? CTX : SEQ, k = tok - base; const bf16* Z = (const bf16*)(ws + WS_ZIN);
    float acc = 0.f;
    for (int n = lane; n < N; n += 64) { const int pn = (int)(((long)n * k) % N);
        for (int c = 0; c < 128; ++c) { const float ang = 2.0f * (float)pn / (float)N + 2.0f * (float)((c * cp) & 127) / 128.0f; acc += bf2f(Z[(size_t)(base + n) * DIN + 3072 + grp * 128 + c]) * cospif(ang); } }
    acc = wave_sum(acc) / sqrtf((float)N * 128.f);
    const float gotf = bf2f(((const bf16*)(ws + WS_YALL))[(size_t)tok * DM + 1024 + col]);
    if (lane == 0 && dg_bad(gotf, acc, 2e-2f, 1e-2f)) dg_fail(ws, id);
    if (lane == 0 && DIAG_PREC == 3 && tok != 0 && tok != SEQ) { float* D = (float*)((unsigned*)(ws + WS_CTL) + CW_DIAG + 8); atomicAdd(D, (gotf - acc) * (gotf - acc)); atomicAdd(D + 1, acc * acc); }
}

__global__ void __launch_bounds__(256) dg_prec_up(Args a) {
    unsigned char* ws = a.ws; const int lane = threadIdx.x & 63; const int smp = blockIdx.x * 4 + (threadIdx.x >> 6);
    const int row = dg_hash(smp * 2 + 11u) % SEQ, c = dg_hash(smp * 2 + 12u) % DFF;
    const float* x = a.in[I_X] + (size_t)row * DM; const float* sh = mod_vec(ws, 0, 0, 0); const float* sc = mod_vec(ws, 0, 0, 1);
    float av = 0.f, bv = 0.f;
    for (int k = lane; k < DM; k += 64) { const float h = x[k] * (1.f + sc[k]) + sh[k]; av += h * a.in[I_F1W1][(size_t)k * DFF + c]; bv += h * a.in[I_F1W3][(size_t)k * DFF + c]; }
    av = wave_sum(av); bv = wave_sum(bv);
    const float exp = av * sigm(av) * bv, got = bf2f(((const bf16*)(ws + WS_G))[(size_t)row * DFF + c]);
    if (lane == 0) { float* D = (float*)((unsigned*)(ws + WS_CTL) + CW_DIAG + 8); atomicAdd(D, (got - exp) * (got - exp)); atomicAdd(D + 1, exp * exp); }
}

__global__ void __launch_bounds__(256) dg_prec_dn(Args a) {
    __shared__ float red[256]; __shared__ float hs[DM];
    unsigned char* ws = a.ws; const int tid = threadIdx.x; const int smp = blockIdx.x;
    const int row = dg_hash(smp * 2 + 21u) % SEQ, c = dg_hash(smp * 2 + 22u) % DM;
    const float* x = a.in[I_X] + (size_t)row * DM; const float* sh = mod_vec(ws, 0, 0, 0); const float* sc = mod_vec(ws, 0, 0, 1);
    for (int k = tid; k < DM; k += 256) hs[k] = x[k] * (1.f + sc[k]) + sh[k];
    __syncthreads();
    float y = 0.f;
    for (int j = tid; j < DFF; j += 256) { float av = 0.f, bv = 0.f;
        for (int k = 0; k < DM; ++k) { const float h = hs[k]; av += h * a.in[I_F1W1][(size_t)k * DFF + j]; bv += h * a.in[I_F1W3][(size_t)k * DFF + j]; }
        y += av * sigm(av) * bv * a.in[I_F1W2][(size_t)j * DM + c]; }
    red[tid] = y; __syncthreads();
    for (int s = 128; s > 0; s >>= 1) { if (tid < s) red[tid] += red[tid + s]; __syncthreads(); }
    if (tid == 0) { const float exp = 0.5f * mod_vec(ws, 0, 0, 2)[c] * red[0], got = bf2f(((const bf16*)(ws + WS_T))[(size_t)row * DM + c]);
        float* D = (float*)((unsigned*)(ws + WS_CTL) + CW_DIAG + 8); atomicAdd(D, (got - exp) * (got - exp)); atomicAdd(D + 1, exp * exp); }
}

__global__ void __launch_bounds__(256) dg_prec_mix(Args a) {
    __shared__ float red[256]; __shared__ float hs[DM]; __shared__ float ms[DM];
    unsigned char* ws = a.ws; const int tid = threadIdx.x; const int smp = blockIdx.x;
    const int row = dg_hash(smp * 2 + 31u) % SEQ, c = dg_hash(smp * 2 + 32u) % DM;
    const xh* x = (const xh*)(ws + WS_X) + (size_t)row * DM; const float* sh = mod_vec(ws, 0, 0, 3); const float* sc = mod_vec(ws, 0, 0, 4);
    const bf16* y = (const bf16*)(ws + WS_YALL) + (size_t)row * DM;
    for (int k = tid; k < DM; k += 256) hs[k] = (float)x[k] * (1.f + sc[k]) + sh[k];
    __syncthreads();
    for (int i = tid; i < DM; i += 256) { float g[3];
        for (int b = 0; b < 3; ++b) { float pre = a.in[I_BGATE][b * DM + i]; for (int k = 0; k < DM; ++k) pre += hs[k] * a.in[I_WGATE][(size_t)k * 3 * DM + b * DM + i]; g[b] = sigm(pre); }
        float p0 = 0.f, p1 = 0.f, p2 = 0.f;
        for (int k = 0; k < DNA; ++k) p0 += bf2f(y[k]) * a.in[I_WBNA][(size_t)k * DM + i];
        for (int k = 0; k < DFOUR; ++k) p1 += bf2f(y[DNA + k]) * a.in[I_WBF][(size_t)k * DM + i];
        for (int k = 0; k < DCONV; ++k) p2 += bf2f(y[DNA + DFOUR + k]) * a.in[I_WBC][(size_t)k * DM + i];
        ms[i] = g[0] * p0 + g[1] * p1 + g[2] * p2; }
    __syncthreads();
    float o = 0.f; for (int i = tid; i < DM; i += 256) o += ms[i] * a.in[I_WO][(size_t)i * DM + c];
    red[tid] = o; __syncthreads();
    for (int s = 128; s > 0; s >>= 1) { if (tid < s) red[tid] += red[tid + s]; __syncthreads(); }
    if (tid == 0) { const float exp = mod_vec(ws, 0, 0, 5)[c] * red[0], got = bf2f(((const bf16*)(ws + WS_T))[(size_t)row * DM + c]);
        float* D = (float*)((unsigned*)(ws + WS_CTL) + CW_DIAG + 8); atomicAdd(D, (got - exp) * (got - exp)); atomicAdd(D + 1, exp * exp); }
}
__global__ void dg_final(Args a) { const unsigned* D = (const unsigned*)(a.ws + WS_CTL) + CW_DIAG; const unsigned d = D[0];
    const float* P = (const float*)(D + 8);
    if (P[1] > 0.f) { a.out[0] = 1000.0f * rintf(-10.0f * log10f(sqrtf(P[0] / P[1]))); return; }
    if (d) { float code = (float)(200 - (int)d);
        a.out[0] = 1000.0f * code; } }
#endif

#ifndef DIAG_SKIP_FC
#define DIAG_SKIP_FC 0
#endif
#ifndef PROBE_REPEAT_MASK
#define PROBE_REPEAT_MASK 0u
#endif
#define REPN(id) (1 + (int)(((PROBE_REPEAT_MASK) >> (id)) & 1u))
#ifndef PROBE_EXTRA_BARRIERS
#ifndef PROBE_MIXA
#define PROBE_MIXA 0
#endif
#define PROBE_EXTRA_BARRIERS 0
#endif
#ifndef PROBE_REPEAT_MIX
#define PROBE_REPEAT_MIX 0
#endif
#ifndef PH_MASK
#define PH_MASK 0xFFFFFFFFu
#endif
#define PH_ON(id) (((PH_MASK) >> (id)) & 1u)
constexpr int N_PHASES = 28;
constexpr int CTXK_DN = 22, CTXK_O = 8;
constexpr size_t FY2_CTX = (size_t)NROWS * 4 * FG * GRID_W;
__device__ __forceinline__ Ctx ctx_local(const Ctx& F) { Ctx L = F; L.lane = hw_lane(); L.tid = (F.wave << 6) | L.lane; return L; }

__device__ __forceinline__ void site_up(const Ctx& F, int l, int f, int nM) {
    const KAp ka = ka_opaque(); unsigned char* const ws = ka->ws; unsigned char* wl = ws + WS_W + (size_t)l * WL_SIZE;
    pg8::Gemm g{(const bf16*)(ws + WS_H), (const bf16*)(wl + (f == 0 ? WL_W13A : WL_W13B)), 0, 0, DM, DM}; pg8::StaticOrder S; S.init(nM, 2 * DFF / 256, F.G, F.bx, DM / 64);
    pg8::EpiSwiGLU E{(bf16*)(ws + WS_G), DFF};
    pg8::gemm_phase<pg8::EpiSwiGLU, pg8::StaticOrder, true, true>(F.lds + RING_OFF, g, S, E, F.wave);
    helper_convert(F, (nM * (2 * DFF / 256)) % F.G, l, w2_lo(f), TI_FF);
}
__device__ __forceinline__ void site_down(const Ctx& F, int l, int f, int nM) {
    const KAp ka = ka_opaque(); unsigned char* const ws = ka->ws; unsigned char* wl = ws + WS_W + (size_t)l * WL_SIZE;
    const int gi = f == 0 ? 2 : 5;
    const bf16* Gb = (const bf16*)(ws + WS_G); const bf16* W2 = (const bf16*)(wl + (f == 0 ? WL_W2A : WL_W2B));
    pg8::Gemm g{Gb, W2, 0, 0, DFF, DFF};
    pg8::OrderPlus S; S.base.init(32, DM / 256, F.G, F.bx, DFF / 64); S.ext.init((nM == 33) ? 1 : 0, DM / 256, F.G, F.bx, 0); S.chunks = CTXK_DN; S.ntc = DFF / 64 / CTXK_DN; S.pmx = 32;
    pg8::EpiDelta E{(bf16*)(ws + WS_T), DM, mod_vec(ws, l, 0, gi), mod_vec(ws, l, 1, gi), 0.5f, (long)((WS_PART - WS_T) / 2)};
    pg8::gemm_phase<pg8::EpiDelta, pg8::OrderPlus, true, true>(F.lds + RING_OFF, g, S, E, F.wave);
}
__device__ __forceinline__ void site_ln(const Ctx& F0, int l, int which, int nrows, bool final_out) {
    const Ctx F = ctx_local(F0);
    const KAp ka = ka_opaque(); unsigned char* const ws = ka->ws;
    const float* lg = ka->in[I_LNG] + (size_t)(l * 3 + which) * DM; const float* lb = ka->in[I_LNB] + (size_t)(l * 3 + which) * DM;
    const int ml = which == 2 ? l + 1 : l, mi = which == 2 ? 0 : 3;
    const int gi = which == 0 ? 2 : 5; const float gmul = which == 1 ? 1.0f : 0.5f; const int nparts = which == 1 ? CTXK_O : CTXK_DN;
    if (final_out) ln_phase(F, (const bf16*)(ws + WS_T), ka->out, nullptr, nullptr, lg, lb, nullptr, nullptr, nullptr, nullptr, nrows, (const xh*)(ws + WS_X), nullptr, 0, nullptr, 0.f);
    else ln_phase(F, (const bf16*)(ws + WS_T), nullptr, (xh*)(ws + WS_X), (bf16*)(ws + WS_H), lg, lb, mod_vec(ws, ml, 0, mi), mod_vec(ws, ml, 0, mi + 1), mod_vec(ws, ml, 1, mi), mod_vec(ws, ml, 1, mi + 1), nrows,
                  (const xh*)(ws + WS_X), nrows > SEQ ? (const bf16*)(ws + WS_PART) : nullptr, nparts, mod_vec(ws, l, 1, gi), gmul);
}
__device__ __forceinline__ void site_in(const Ctx& F, int l, bool last) {
    const KAp ka = ka_opaque(); unsigned char* const ws = ka->ws; unsigned char* wl = ws + WS_W + (size_t)l * WL_SIZE;
    const bf16* Hb = (const bf16*)(ws + WS_H);
    pg8::Gemm g{Hb, (const bf16*)(wl + WL_WIN), 0, (long)WL_WG - (long)WL_WIN, DM, DM};
    pg8::OrderPlus S; S.base.init(33, DIN / 256, F.G, F.bx, DM / 64); S.ext.init(last ? 0 : 1, 3 * DM / 256, F.G, F.bx, 0); S.chunks = 1; S.ntc = DM / 64; S.pmx = 32;
    pg8::EpiBf16<2> E{(bf16*)(ws + WS_ZIN), DIN, ka->in[I_BGATE] + (size_t)l * 3 * DM, (bf16*)(ws + WS_GATES), 3 * DM};
    pg8::gemm_phase<pg8::EpiBf16<2>, pg8::OrderPlus, true, true>(F.lds + RING_OFF, g, S, E, F.wave);
    { const int q0 = last ? 3 * TI_FF : 0; helper_convert(F, (33 * (DIN / 256) + (last ? 0 : 3 * DM / 256)) % F.G, 1, q0, 2 * TI_FF); }
}
__device__ __forceinline__ void site_mixA(const Ctx& F0, int l, bool last) {
    const Ctx F = ctx_local(F0);
    const KAp ka = ka_opaque(); unsigned char* const ws = ka->ws;
    const bf16* ZIN = (const bf16*)(ws + WS_ZIN); bf16* YALL = (bf16*)(ws + WS_YALL); unsigned* FY2 = (unsigned*)(ws + WS_FY);
    const int nFAB = last ? 256 : 320, nConv = last ? 256 : 264;
    const float* wdw = ka->in[I_WDW] + (size_t)l * CONVW * DCONV; const float* bdw = ka->in[I_BDW] + (size_t)l * DCONV;
    const float* clg = ka->in[I_CLNG] + (size_t)l * DCONV; const float* clb = ka->in[I_CLNB] + (size_t)l * DCONV;
    for (int it = F.bx; it < nFAB + nConv; it += F.G) {
      const int reps = 1 + ((PROBE_MIXA == 2 && it < 256) || (PROBE_MIXA == 3 && it >= 256 && it < nFAB) || (PROBE_MIXA == 4 && it >= nFAB) ? 3 : 0);
      for (int rep = 0; rep < reps; ++rep) {
        int r = it;
        if (r < nFAB) { if (r < 256) fourAB_item_v3(F, ZIN, FY2, r & 15, (r >> 4) & 3, r >> 6); else { const int rr = r - 256; fourAB_ctx_v3(F, ZIN, FY2 + FY2_CTX, rr & 15, rr >> 4); } continue; }
        r -= nFAB;
        { const bool cx = r >= 256; conv_item_v1(F, ZIN, YALL, wdw, bdw, clg, clb, cx ? SEQ : 0, cx ? CTX : SEQ, (cx ? r - 256 : r) * 32); }
      }
    }
    const float* rpb = ka->in[I_RPB] + (size_t)l * NH * (2 * WIN_R - 1) * (2 * WIN_C - 1);
    const int nA = (NROWS / 2) * NH + (last ? 0 : (CTX / 128) * NH);
    for (int k = 0; k * F.G < nA; ++k) { const int rem = nA - k * F.G; const int it = k * F.G + (rem >= F.G ? F.bx : (F.bx + rem) % F.G);
        if (it >= nA) break;
        const int head = it & 7, qi = it >> 3;
        attn_item_v3(F, ZIN, YALL, rpb, qi < NROWS / 2 ? qi * 2 * GRID_W : SEQ + (qi - NROWS / 2) * 128, head); }
}
__device__ __forceinline__ void four_stageC(const Ctx& F0, bool last) {
    const Ctx F = ctx_local(F0);
    const KAp ka = ka_opaque(); unsigned char* const ws = ka->ws;
    LAS v4u* CS = (LAS v4u*)(F.lds + RING_OFF + 2 * A3_BUF + 2048);
    fourC_table_v2(F, CS); __syncthreads();
    const int nFC = last ? 2048 : 2048 + 64;
    for (int q = F.gw; q < nFC; q += F.NGW) { const unsigned* FY2 = (const unsigned*)(ws + WS_FY);
        if (q < 2048) fourC_item_v2(FY2, (bf16*)(ws + WS_YALL), CS, 0, NROWS, q >> 4, (q >> 2) & 3, q & 3, F.lane);
        else { const int qq = q - 2048; fourC_item_v2(FY2 + FY2_CTX, (bf16*)(ws + WS_YALL), CS, SEQ, CTX / GRID_W, qq >> 4, (qq >> 2) & 3, qq & 3, F.lane); } }
    __syncthreads();
}
__device__ __forceinline__ void site_gate(const Ctx& F, int l, bool last) {
    four_stageC(F, last);
    const KAp ka = ka_opaque(); unsigned char* const ws = ka->ws; unsigned char* wl = ws + WS_W + (size_t)l * WL_SIZE;
    pg8::Gemm g{(const bf16*)(ws + WS_H), (const bf16*)(wl + WL_WG), 0, 0, DM, DM}; pg8::StaticOrder S; S.init(32, 3 * DM / 256, F.G, F.bx, DM / 64);
    pg8::EpiBf16<1> E{(bf16*)(ws + WS_GATES), 3 * DM, ka->in[I_BGATE] + (size_t)l * 3 * DM, nullptr, 0};
    pg8::gemm_phase<pg8::EpiBf16<1>, pg8::StaticOrder, true, true>(F.lds + RING_OFF, g, S, E, F.wave);
}
__device__ __forceinline__ void site_branch(const Ctx& F, int l, bool last) {
    const KAp ka = ka_opaque(); unsigned char* const ws = ka->ws; unsigned char* wl = ws + WS_W + (size_t)l * WL_SIZE;
    pg8::Gemm g{(const bf16*)(ws + WS_YALL), (const bf16*)(wl + WL_WB), 0, 0, DM, DM}; pg8::StaticOrder S; S.init(last ? 32 : 33, DM / 256, F.G, F.bx, DM / 64);
    pg8::EpiBranch E{(bf16*)(ws + WS_MB), DM, (const bf16*)(ws + WS_GATES), 3 * DM};
    pg8::gemm_phase<pg8::EpiBranch, pg8::StaticOrder, true, true>(F.lds + RING_OFF, g, S, E, F.wave);
    if (l == 0) helper_convert(F, (33 * (DM / 256)) % F.G, 1, 6 * TI_FF, TI_LAYER - 6 * TI_FF, 0, 3 * TI_FF, 2 * TI_FF);
}
__device__ __forceinline__ void site_o(const Ctx& F, int l, bool last) {
    const KAp ka = ka_opaque(); unsigned char* const ws = ka->ws; unsigned char* wl = ws + WS_W + (size_t)l * WL_SIZE;
    const bf16* Mb = (const bf16*)(ws + WS_MB); const bf16* Wo = (const bf16*)(wl + WL_WO);
    pg8::Gemm g{Mb, Wo, 0, 0, DM, DM};
    pg8::OrderPlus S; S.base.init(32, DM / 256, F.G, F.bx, DM / 64); S.ext.init(last ? 0 : 1, DM / 256, F.G, F.bx, 0); S.chunks = CTXK_O; S.ntc = DM / 64 / CTXK_O; S.pmx = 32;
    pg8::EpiDelta E{(bf16*)(ws + WS_T), DM, mod_vec(ws, l, 0, 5), mod_vec(ws, l, 1, 5), 1.0f, (long)((WS_PART - WS_T) / 2)};
    pg8::gemm_phase<pg8::EpiDelta, pg8::OrderPlus, true, true>(F.lds + RING_OFF, g, S, E, F.wave);
}

__global__ void __launch_bounds__(NWAVES * 64, 2) mk_fwd(Args args) {
    extern __shared__ __attribute__((aligned(16))) unsigned char lds[];
    Ctx F;
    F.lds = (LAS unsigned char*)lds; F.tid = -1; F.lane = -1; F.wave = __builtin_amdgcn_readfirstlane(threadIdx.x >> 6);
    F.bx = blockIdx.x; F.G = gridDim.x; F.gw = F.bx * NWAVES + F.wave; F.NGW = F.G * NWAVES;
    volatile LAS unsigned* MISC = (volatile LAS unsigned*)(F.lds + MISC_OFF);
    for (int u = threadIdx.x; u < (LDS_BYTES - LDSCTL_OFF) / 4; u += NWAVES * 64) ((LAS unsigned*)(F.lds + LDSCTL_OFF))[u] = 0u;
    __syncthreads();
    unsigned* barw = (unsigned*)(args.ws + WS_CTL) + CW_BAR;
    XcdBarrier bar; bar.bar = barw; bar.x = 0; bar.st = nullptr; bar.wave = F.wave;
    if (args.use_bar) bar = xcd_barrier_post(barw, MISC + 8);
    const int lo = args.ph_lo, hi = args.ph_hi;
#define IN(k) (lo <= (k) && (k) < hi)
#define SEAM(k) do { if (IN(k) && IN((k) + 1)) xcd_barrier(bar); } while (0)
#if MK_STAMP
    unsigned long long t_prev = __builtin_amdgcn_s_memrealtime(), t_cat0 = 0, t_cat1 = 0, t_cat2 = 0, t_cat3 = 0, t_cat4 = 0;
#define STAMP(cat) do { const unsigned long long t_now = __builtin_amdgcn_s_memrealtime(); t_cat##cat += t_now - t_prev; t_prev = t_now; } while (0)
#else
#define STAMP(cat) do { } while (0)
#endif

    for (int rp = 0; rp < REPN(0); ++rp) { if (rp) xcd_barrier(bar); if (PH_ON(0)) { if (IN(0)) p0_prologue(ctx_local(F)); } }
    SEAM(0); STAMP(4);
    for (int rp = 0; rp < REPN(1); ++rp) { if (rp) xcd_barrier(bar); if (PH_ON(1)) { if (IN(1)) p1_prologue(ctx_local(F)); } }
    SEAM(1); STAMP(4);

    for (int hl = 0; hl < 2 * DEPTH; ++hl) {
        const int l = hl >> 1, f = hl & 1; const bool last = (l == DEPTH - 1);
        const int pb = 2 + 3 * hl + 7 * ((hl + 1) >> 1);
        const int nMf = (last && f == 1) ? 32 : 33;
        for (int rp = 0; rp < REPN(2); ++rp) { if (rp) xcd_barrier(bar); if (PH_ON(2)) { if (IN(pb + 0)) site_up(F, l, f, nMf); } }
        SEAM(pb + 0); STAMP(0);
        for (int rp = 0; rp < REPN(3); ++rp) { if (rp) xcd_barrier(bar); if (PH_ON(3)) { if (IN(pb + 1)) site_down(F, l, f, nMf); } }
        SEAM(pb + 1); STAMP(0);
        for (int rp = 0; rp < REPN(4); ++rp) { if (rp) xcd_barrier(bar); if (PH_ON(4)) { if (IN(pb + 2)) site_ln(F, l, f == 0 ? 0 : 2, (rp || (last && f == 1)) ? SEQ : MTOT, last && f == 1); } }
        if (!(last && f == 1)) SEAM(pb + 2);
        STAMP(2);
        if (f == 1) continue;
        const int mb = pb + 3;
        for (int rp = 0; rp < REPN(5); ++rp) { if (rp) xcd_barrier(bar); if (PH_ON(5)) { if (IN(mb + 0)) site_in(F, l, last); } }
        SEAM(mb + 0); STAMP(0);
        for (int rp = 0; rp < REPN(6); ++rp) { if (rp) xcd_barrier(bar); if (PH_ON(6)) { if (IN(mb + 1)) site_mixA(F, l, last); } }
        SEAM(mb + 1); STAMP(1);
        for (int rp = 0; rp < REPN(7); ++rp) { if (rp) xcd_barrier(bar); if (PH_ON(7)) { if (IN(mb + 3)) site_gate(F, l, last); } }
        SEAM(mb + 3); STAMP(0);
        for (int rp = 0; rp < REPN(8); ++rp) { if (rp) xcd_barrier(bar); if (PH_ON(8)) { if (IN(mb + 4)) site_branch(F, l, last); } }
        SEAM(mb + 4); STAMP(0);
        for (int rp = 0; rp < REPN(9); ++rp) { if (rp) xcd_barrier(bar); if (PH_ON(9)) { if (IN(mb + 5)) site_o(F, l, last); } }
        SEAM(mb + 5); STAMP(0);
        for (int rp = 0; rp < REPN(10); ++rp) { if (rp) xcd_barrier(bar); if (PH_ON(10)) { if (IN(mb + 6)) site_ln(F, l, 1, (rp || last) ? SEQ : MTOT, false); } }
        SEAM(mb + 6); STAMP(2);
    }
    for (int eb = 0; eb < PROBE_EXTRA_BARRIERS; ++eb) xcd_barrier(bar);
#if MK_STAMP
    if (F.bx == 0 && threadIdx.x == 0) { const KAp ka = ka_opaque(); float* o = ka->out;
#define QZ(t) (1000.0f * 0.01f * exp2f(rintf(log2f((float)(t) + 1.0f) * 6.0f) / 6.0f))
        const float a0 = QZ(t_cat0), a1 = QZ(t_cat1), a2 = QZ(t_cat2), a3 = QZ(t_cat3), a4 = QZ(t_cat4);
        if (MK_STAMP == 1) { o[0] = a1; o[1] = a3; } else if (MK_STAMP == 2) { o[0] = a4; o[1] = a2; } else { o[0] = a0; o[1] = 0.f; } }

#endif
#undef IN
#undef SEAM
}

extern "C" void kernel_launch(void* const* d_in, const int* in_sizes, int n_in, void* d_out, int out_size, void* d_ws, size_t ws_size, hipStream_t stream) {
    static int grid = 0;
    if (grid == 0) {
        if (n_in != N_IN || in_sizes[0] != SEQ * DM || out_size != SEQ * DM || ws_size < WS_END) { fprintf(stderr, "kernel_launch: unexpected shapes (n_in %d, in0 %d, out %d, ws %zu); nothing launched\n", n_in, n_in > 0 ? in_sizes[0] : -1, out_size, ws_size); grid = -1; return; }
        int dev = 0, cus = 0, per_cu = 0;
        if (hipGetDevice(&dev) != hipSuccess || hipDeviceGetAttribute(&cus, hipDeviceAttributeMultiprocessorCount, dev) != hipSuccess) { grid = -1; return; }
        if (hipFuncSetAttribute((const void*)mk_fwd, hipFuncAttributeMaxDynamicSharedMemorySize, LDS_BYTES) != hipSuccess) { fprintf(stderr, "kernel_launch: hipFuncSetAttribute failed\n"); grid = -1; return; }
        if (hipOccupancyMaxActiveBlocksPerMultiprocessor(&per_cu, (const void*)mk_fwd, NWAVES * 64, LDS_BYTES) != hipSuccess || per_cu < 1) fprintf(stderr, "kernel_launch: note: occupancy query reports %d\n", per_cu);
        (void)hipGetLastError();
        grid = cus;
    }
    if (grid < 0) return;
    if (hipMemsetAsync((char*)d_ws + WS_CTL, 0, CTL_ZERO_BYTES, stream) != hipSuccess) return;
    Args a{};
    for (int i = 0; i < N_IN; ++i) a.in[i] = (const float*)d_in[i];
    a.out = (float*)d_out; a.ws = (unsigned char*)d_ws; a.pad = 0;
#if MK_PER_PHASE
    for (int k = 0; k < N_PHASES; ++k) { a.ph_lo = k; a.ph_hi = k + 1; a.use_bar = 0; hipLaunchKernelGGL(mk_fwd, dim3(grid), dim3(NWAVES * 64), LDS_BYTES, stream, a);
#if MK_DIAG
        const int id = 2 * k + 4;
        if (k == 0) hipLaunchKernelGGL(dg_trans, dim3(4096), dim3(256), 0, stream, a, id, 0, 0xFDBu);
        else if (k == 1) hipLaunchKernelGGL(dg_mod, dim3(1024), dim3(256), 0, stream, a, id);
        else for (int hl = 0; hl < 2 * DEPTH; ++hl) { const int pb = 2 + 3 * hl + 7 * ((hl + 1) >> 1), l = hl >> 1, f = hl & 1; const bool last = l == DEPTH - 1;
            const int nMf = (last && f == 1) ? 32 : 33, nMm = last ? 32 : 33; int type = -1;
            if (k >= pb && k <= pb + 2) type = k - pb; else if (f == 0 && k >= pb + 3 && k <= pb + 9) type = k - pb;
            if (type == 0) hipLaunchKernelGGL(dg_gemm, dim3(2048), dim3(256), 0, stream, a, 0, l, f, nMf * 256, id, 0.f, 0);
            if (type == 0 && hl == 0 && DIAG_PREC == 1) hipLaunchKernelGGL(dg_prec_up, dim3(512), dim3(256), 0, stream, a);
            if (type == 1 && hl == 0 && DIAG_PREC == 2) hipLaunchKernelGGL(dg_prec_dn, dim3(512), dim3(256), 0, stream, a);
            if (type == 0 && hl == 1) hipLaunchKernelGGL(dg_trans, dim3(4096), dim3(256), 0, stream, a, id + 1, 0, 0x024u);
            if (type == 0 && hl == 3) hipLaunchKernelGGL(dg_trans, dim3(4096), dim3(256), 0, stream, a, id + 1, 1, 0xFFFu);
            if (type == 1) hipLaunchKernelGGL(dg_gemm, dim3(2048), dim3(256), 0, stream, a, 1, l, f, SEQ, id, 0.5f, f == 0 ? 2 : 5);
            if (type == 2) hipLaunchKernelGGL(dg_ln, dim3(512), dim3(256), 0, stream, a, l, f == 0 ? 0 : 2, SEQ, (last && f == 1) ? 1 : 0, id);
            if (type == 3) hipLaunchKernelGGL(dg_gemm, dim3(2048), dim3(256), 0, stream, a, 2, l, 0, MTOT, id, 0.f, 0);
            if (type == 4) hipLaunchKernelGGL(dg_conv, dim3(1024), dim3(256), 0, stream, a, l, last ? SEQ : MTOT, id + 1);
            if (type == 5) hipLaunchKernelGGL(dg_attn, dim3(1024), dim3(256), 0, stream, a, l, last ? SEQ : MTOT, id);
            if (type == 6) { hipLaunchKernelGGL(dg_gemm, dim3(2048), dim3(256), 0, stream, a, 3, l, 0, nMm * 256, id, 0.f, 0); hipLaunchKernelGGL(dg_four, dim3(64), dim3(256), 0, stream, a, last ? SEQ : MTOT, id + 1); }
            if (type == 7) hipLaunchKernelGGL(dg_gemm, dim3(2048), dim3(256), 0, stream, a, 4, l, 0, nMm * 256, id, 0.f, 0);
            if (type == 8) hipLaunchKernelGGL(dg_gemm, dim3(2048), dim3(256), 0, stream, a, 1, l, 0, SEQ, id, 1.0f, 5);
            if (type == 8 && l == 0 && DIAG_PREC == 4) hipLaunchKernelGGL(dg_prec_mix, dim3(256), dim3(256), 0, stream, a);
            if (type == 9) hipLaunchKernelGGL(dg_ln, dim3(512), dim3(256), 0, stream, a, l, 1, SEQ, 0, id);
        }
#endif
    }
#if MK_DIAG
    hipLaunchKernelGGL(dg_final, dim3(1), dim3(1), 0, stream, a);
#endif
#else
    a.ph_lo = 0; a.ph_hi = N_PHASES; a.use_bar = 1;
    hipLaunchKernelGGL(mk_fwd, dim3(grid), dim3(NWAVES * 64), LDS_BYTES, stream, a);
#endif
    const hipError_t le = hipPeekAtLastError();
    if (le != hipSuccess) fprintf(stderr, "kernel_launch: launch failed: %s\n", hipGetErrorName(le));
}
```

```cpp
#include <hip/hip_runtime.h>
#include <cstdio>
#include <cstdint>

#ifndef MK_DIAG
#define MK_DIAG 0
#endif
#ifndef DIAG_PREC
#define DIAG_PREC 0
#endif
#ifndef MK_STAMP
#define MK_STAMP 0
#endif
#ifndef MK_PER_PHASE
#define MK_PER_PHASE 0
#endif

__device__ __forceinline__ int hw_lane() { int l; asm volatile("v_mbcnt_lo_u32_b32 %0, -1, 0\n\tv_mbcnt_hi_u32_b32 %0, -1, %0" : "=v"(l)); return l; }
namespace pg8 {
#define PG8_LAS __attribute__((address_space(3)))
typedef unsigned short bf16_t;
typedef short bf16x8 __attribute__((ext_vector_type(8)));
typedef float f32x4 __attribute__((ext_vector_type(4)));
typedef unsigned u32x4 __attribute__((ext_vector_type(4)));
constexpr int BM = 256, BK = 64, HALF = 128, HTB = HALF * BK * 2  , STAGE_BYTES = 8 * HTB, NXCD = 8, WGM = 8;

__host__ __device__ __forceinline__ int lds_byte(int r, int c) { const int st = (r >> 4) * 2 + (c >> 5), rr = r & 15, cc = c & 31, ob = rr * 64 + cc * 2; return st * 1024 + (ob ^ (((ob >> 9) & 1) << 5)); }
__host__ __device__ __forceinline__ void stage_rc(int b, int& R, int& C) { const int st = b / 1024, sb = b % 1024, swz = sb ^ (((sb >> 9) & 1) << 5); R = (st >> 1) * 16 + swz / 64; C = (st & 1) * 32 + (swz % 64) / 2; }
__host__ __device__ __forceinline__ int perm32(int rho) { const int n = rho >> 4, i = rho & 15; return 8 * (i >> 2) + 4 * n + (i & 3); }

struct Unit { int pm, pn, kt0, nt, job; };
struct Gemm { const bf16_t* A; const bf16_t* Bt; long dA1, dB1; int lda, ldb; };

struct StaticOrder {
    int nM, nN, nwg, G, c, ntK;
    __host__ __device__ void init(int nM_, int nN_, int G_, int c_, int ntK_) { nM = nM_; nN = nN_; nwg = nM * nN; G = G_; c = c_; ntK = ntK_; }
    __host__ __device__ __forceinline__ void map(int L, int& pm, int& pn) const {
        int wgid = L; { const int q = nwg / NXCD, r = nwg % NXCD, xcd = wgid % NXCD, off = wgid / NXCD; wgid = (xcd < r ? xcd * (q + 1) : r * (q + 1) + (xcd - r) * q) + off; }
        const int nig = WGM * nN, gid = wgid / nig, fm = gid * WGM, gsz = (nM - fm) < WGM ? (nM - fm) : WGM;
        pm = fm + ((wgid % nig) % gsz); pn = (wgid % nig) / gsz;
    }
    __host__ __device__ __forceinline__ bool next(int i, Unit& u) const {
        const long L = (long)i * G + c; const bool ok = L < nwg; int pm = 0, pn = 0; if (ok) map((int)L, pm, pn);
        u.pm = pm; u.pn = pn; u.kt0 = 0; u.nt = ntK; u.job = 0; return ok;
    }
    __device__ __forceinline__ void a_ready(const Unit&) const {}
    __device__ __forceinline__ void done(const Unit&) const {}
};
struct OrderPlus {
    StaticOrder base, ext; int chunks, ntc, pmx;
    __host__ __device__ __forceinline__ bool next(int i, Unit& u) const {
        const long L = (long)i * base.G + base.c; int pm = 0, pn = 0, kt0 = 0, nt = base.ntK, job = 0; bool ok = true;
        if (L < base.nwg) base.map((int)L, pm, pn);
        else { const int q = (int)(L - base.nwg); ok = q < ext.nwg * chunks; if (ok) ext.map(q / chunks, pm, pn); pm += pmx; kt0 = (q % chunks) * ntc; nt = ntc; job = 1; }
        u.pm = pm; u.pn = pn; u.kt0 = kt0; u.nt = nt; u.job = job; return ok;
    }
    __device__ __forceinline__ void a_ready(const Unit&) const {}
    __device__ __forceinline__ void done(const Unit&) const {}
};

typedef float f32x2_t __attribute__((ext_vector_type(2))); typedef __bf16 bf16x2_t __attribute__((ext_vector_type(2)));
__device__ __forceinline__ unsigned cvt_pk_bf16(float lo, float hi) { const f32x2_t v = {lo, hi}; const bf16x2_t b = __builtin_convertvector(v, bf16x2_t); return __builtin_bit_cast(unsigned, b); }
__device__ __forceinline__ float sigmoid_f(float x) { return __builtin_amdgcn_rcpf(1.0f + __builtin_amdgcn_exp2f(-1.4426950408889634f * x)); }
__device__ __forceinline__ float bf_lo(unsigned w) { return __builtin_bit_cast(float, w << 16); }
__device__ __forceinline__ float bf_hi(unsigned w) { return __builtin_bit_cast(float, w & 0xffff0000u); }
constexpr int CTX_PM = 32;

struct EpiSwiGLU {
    static constexpr bool PERM = true, AFTER_DRAIN = false, MIDK = false; static constexpr int T1 = 0, T2 = 0, NST = 8;
    bf16_t* O; int ldc;
    __device__ __forceinline__ void mid(f32x4 (&)[2][2][4][2], const Unit&, int, int, int, int, int) const {}
    __device__ __forceinline__ void operator()(const f32x4 (&acc)[2][2][4][2], const Unit& u, int wr, int wc, int fr, int fq) const {
        const int row0 = u.pm * BM + wr * 64 + fr, col0 = u.pn * HALF + wc * 32 + 8 * fq;
#pragma unroll
        for (int ai = 0; ai < 2; ++ai)
#pragma unroll
            for (int m = 0; m < 4; ++m) {
                bf16_t* rowp = O + (size_t)(row0 + ai * HALF + m * 16) * ldc + col0;
                float g[8];
#pragma unroll
                for (int n = 0; n < 2; ++n)
#pragma unroll
                    for (int j = 0; j < 4; ++j) { const float a = acc[ai][0][m][n][j], b = acc[ai][1][m][n][j]; g[n * 4 + j] = a * sigmoid_f(a) * b; }
                u32x4 w; w.x = cvt_pk_bf16(g[0], g[1]); w.y = cvt_pk_bf16(g[2], g[3]); w.z = cvt_pk_bf16(g[4], g[5]); w.w = cvt_pk_bf16(g[6], g[7]);
                *(u32x4*)rowp = w; }
    }
};
struct EpiDelta {
    static constexpr bool PERM = true, AFTER_DRAIN = false, MIDK = false; static constexpr int T1 = 0, T2 = 0, NST = 16;
    bf16_t* D; int ldc; const float* gate_lat; const float* gate_ctx; float gmul; long part_off;
    __device__ __forceinline__ void mid(f32x4 (&)[2][2][4][2], const Unit&, int, int, int, int, int) const {}
    __device__ __forceinline__ void operator()(const f32x4 (&acc)[2][2][4][2], const Unit& u, int wr, int wc, int fr, int fq) const {
        const int row0 = u.pm * BM + wr * 64 + fr, col0 = u.pn * BM + wc * 32 + 8 * fq;
        const long joff = (long)u.job * (part_off + ((long)(u.kt0 / u.nt) - u.pm) * BM * ldc);
        const float gm = u.job ? 0.f : gmul, g1 = u.job ? 1.f : 0.f;
        const float* gv = (u.pm >= CTX_PM) ? gate_ctx : gate_lat;
        f32x4 gg[2][2];
#pragma unroll
        for (int bj = 0; bj < 2; ++bj)
#pragma unroll
            for (int n = 0; n < 2; ++n) gg[bj][n] = *(const f32x4*)(gv + col0 + bj * HALF + 4 * n) * gm + g1;
#pragma unroll
        for (int ai = 0; ai < 2; ++ai)
#pragma unroll
            for (int m = 0; m < 4; ++m) { bf16_t* rowp = D + joff + (size_t)(row0 + ai * HALF + m * 16) * ldc + col0;
#pragma unroll
                for (int bj = 0; bj < 2; ++bj) { const f32x4 v0 = acc[ai][bj][m][0] * gg[bj][0], v1 = acc[ai][bj][m][1] * gg[bj][1];
                    u32x4 w; w.x = cvt_pk_bf16(v0[0], v0[1]); w.y = cvt_pk_bf16(v0[2], v0[3]); w.z = cvt_pk_bf16(v1[0], v1[1]); w.w = cvt_pk_bf16(v1[2], v1[3]);
                    *(u32x4*)(rowp + bj * HALF) = w; } }
    }
};
template <int ACT> struct EpiBf16 {
    static constexpr bool PERM = true, AFTER_DRAIN = false, MIDK = false; static constexpr int T1 = 0, T2 = 0, NST = 16;
    bf16_t* O; int ldc; const float* bias; bf16_t* O1; int ldc1;
    __device__ __forceinline__ void mid(f32x4 (&)[2][2][4][2], const Unit&, int, int, int, int, int) const {}
    __device__ __forceinline__ void operator()(const f32x4 (&acc)[2][2][4][2], const Unit& u, int wr, int wc, int fr, int fq) const {
        if constexpr (ACT == 2) { if (u.job) { EpiBf16<1> e{O1, ldc1, bias, nullptr, 0}; e(acc, u, wr, wc, fr, fq); } else { EpiBf16<0> e{O, ldc, nullptr, nullptr, 0}; e(acc, u, wr, wc, fr, fq); } return; } else {
        const int row0 = u.pm * BM + wr * 64 + fr, col0 = u.pn * BM + wc * 32 + 8 * fq;
        f32x4 bv[2][2];
#pragma unroll
        for (int bj = 0; bj < 2; ++bj)
#pragma unroll
            for (int n = 0; n < 2; ++n) bv[bj][n] = bias ? *(const f32x4*)(bias + col0 + bj * HALF + 4 * n) : (f32x4){0.f, 0.f, 0.f, 0.f};
#pragma unroll
        for (int ai = 0; ai < 2; ++ai)
#pragma unroll
            for (int m = 0; m < 4; ++m) { bf16_t* rowp = O + (size_t)(row0 + ai * HALF + m * 16) * ldc + col0;
#pragma unroll
                for (int bj = 0; bj < 2; ++bj) { f32x4 v0 = acc[ai][bj][m][0] + bv[bj][0], v1 = acc[ai][bj][m][1] + bv[bj][1];
                    if (ACT == 1) {
#pragma unroll
                        for (int j = 0; j < 4; ++j) { v0[j] = fminf(__builtin_amdgcn_exp2f(-1.4426950408889634f * v0[j]), 1e20f); v1[j] = fminf(__builtin_amdgcn_exp2f(-1.4426950408889634f * v1[j]), 1e20f); } }
                    u32x4 w; w.x = cvt_pk_bf16(v0[0], v0[1]); w.y = cvt_pk_bf16(v0[2], v0[3]); w.z = cvt_pk_bf16(v1[0], v1[1]); w.w = cvt_pk_bf16(v1[2], v1[3]);
                    *(u32x4*)(rowp + bj * HALF) = w; } }
        }
    }
};
struct EpiBranch {
    static constexpr bool PERM = true, AFTER_DRAIN = false, MIDK = true; static constexpr int T1 = 16, T2 = 24, NST = 16;
    bf16_t* O; int ldc; const bf16_t* gates; int ldg;
    __device__ __forceinline__ static void ld8(const bf16_t* p, float (&g)[8]) { const u32x4 w = *(const u32x4*)p;
        g[0] = bf_lo(w.x); g[1] = bf_hi(w.x); g[2] = bf_lo(w.y); g[3] = bf_hi(w.y); g[4] = bf_lo(w.z); g[5] = bf_hi(w.z); g[6] = bf_lo(w.w); g[7] = bf_hi(w.w);
        }
    __device__ __forceinline__ void mid(f32x4 (&acc)[2][2][4][2], const Unit& u, int t, int wr, int wc, int fr, int fq) const {
        int row0 = u.pm * BM + wr * 64 + fr; asm volatile("" : "+v"(row0));
        const int col0 = u.pn * BM + wc * 32 + 8 * fq;
        const int bnum = (t == T1) ? 0 : 1;
#pragma unroll
        for (int ai = 0; ai < 2; ++ai)
#pragma unroll
            for (int m = 0; m < 4; ++m) { const bf16_t* gp = gates + (size_t)(row0 + ai * HALF + m * 16) * ldg + col0 + bnum * 2048;
#pragma unroll
                for (int bj = 0; bj < 2; ++bj) { float gn[8], gd[8]; ld8(gp + bj * HALF, gn); ld8(gp + bj * HALF + 2048, gd);
#pragma unroll
                    for (int n = 0; n < 2; ++n)
#pragma unroll
                        for (int j = 0; j < 4; ++j) acc[ai][bj][m][n][j] *= (1.0f + gd[n * 4 + j]) * __builtin_amdgcn_rcpf(1.0f + gn[n * 4 + j]); }
                if (m == 3) asm volatile("" ::: "memory"); }
    }
    __device__ __forceinline__ void operator()(const f32x4 (&acc)[2][2][4][2], const Unit& u, int wr, int wc, int fr, int fq) const {
        const int row0 = u.pm * BM + wr * 64 + fr, col0 = u.pn * BM + wc * 32 + 8 * fq;
#pragma unroll
        for (int ai = 0; ai < 2; ++ai)
#pragma unroll
            for (int m = 0; m < 4; ++m) { const size_t r = (size_t)(row0 + ai * HALF + m * 16); const bf16_t* gp = gates + r * ldg + col0 + 2 * 2048; bf16_t* rowp = O + r * ldc + col0;
#pragma unroll
                for (int bj = 0; bj < 2; ++bj) { float g2[8]; ld8(gp + bj * HALF, g2);
                    const f32x4 v0 = acc[ai][bj][m][0], v1 = acc[ai][bj][m][1];
#pragma unroll
                    for (int j = 0; j < 8; ++j) g2[j] = __builtin_amdgcn_rcpf(1.0f + g2[j]);
                    u32x4 w; w.x = cvt_pk_bf16(v0[0] * g2[0], v0[1] * g2[1]); w.y = cvt_pk_bf16(v0[2] * g2[2], v0[3] * g2[3]); w.z = cvt_pk_bf16(v1[0] * g2[4], v1[1] * g2[5]); w.w = cvt_pk_bf16(v1[2] * g2[6], v1[3] * g2[7]);
                    *(u32x4*)(rowp + bj * HALF) = w; }
                }
    }
};
template <class Epi, class Sched, bool ALIGN_EPI = false, bool SP2 = false>
__device__ __forceinline__ void gemm_phase(PG8_LAS unsigned char* lds, const Gemm g, const Sched& S, const Epi& E, int wave_id) {
    int tid_ = (wave_id << 6) | hw_lane();
    const int tid = tid_, wid = __builtin_amdgcn_readfirstlane(tid >> 6), lane = tid & 63, wr = wid >> 2, wc = wid & 3, fr = lane & 15, fq = lane >> 4;
    unsigned voffA[2], voffB[2];
#pragma unroll
    for (int i = 0; i < 2; ++i) { int R, C; stage_rc(tid * 16 + i * 8192, R, C); const int Rb = Epi::PERM ? ((R & ~31) + perm32(R & 31)) : R;
        voffA[i] = (unsigned)(R * g.lda + C) * 2u; voffB[i] = (unsigned)(Rb * g.ldb + C) * 2u; }
    const size_t kstep = (size_t)(BK * 2);
    const size_t hstepA = (size_t)HALF * g.lda * 2, hstepB = (size_t)HALF * g.ldb * 2;
    const size_t tstepA = 2 * hstepA, tstepB = 2 * hstepB;
    const unsigned ldsw = (unsigned)wid * 1024u;
    const int aoff = lds_byte(wr * 64 + fr, fq * 8), boff = lds_byte(wc * 32 + fr, fq * 8);
#define PG8_SA(b, h) (((b) * 2 + (h)) * HTB)
#define PG8_SB(b, h) ((4 + (b) * 2 + (h)) * HTB)
#define PG8_STAGE(bufoff, gbase, voff) do { _Pragma("unroll") for (int _i = 0; _i < 2; ++_i) \
        __builtin_amdgcn_global_load_lds((const unsigned*)((const char*)(gbase) + (voff)[_i]), (PG8_LAS unsigned*)(lds + (bufoff) + ldsw + _i * 8192), 16, 0, 0); } while (0)
#define PG8_LDA(dst, b, h) do { _Pragma("unroll") for (int m = 0; m < 4; ++m) _Pragma("unroll") for (int k = 0; k < 2; ++k) dst[m][k] = *(const PG8_LAS bf16x8*)(lds + PG8_SA(b, h) + aoff + m * 2048 + k * 1024); } while (0)
#define PG8_LDB(dst, b, h) do { _Pragma("unroll") for (int n = 0; n < 2; ++n) _Pragma("unroll") for (int k = 0; k < 2; ++k) dst[n][k] = *(const PG8_LAS bf16x8*)(lds + PG8_SB(b, h) + boff + n * 2048 + k * 1024); } while (0)
#define PG8_MMA(ai, bj, At, Bt) do { __builtin_amdgcn_s_setprio(1); _Pragma("unroll") for (int m = 0; m < 4; ++m) _Pragma("unroll") for (int n = 0; n < 2; ++n) _Pragma("unroll") for (int k = 0; k < 2; ++k) \
        acc[ai][bj][m][n] = __builtin_amdgcn_mfma_f32_16x16x32_bf16(Bt[n][k], At[m][k], acc[ai][bj][m][n], 0, 0, 0); __builtin_amdgcn_s_setprio(0); } while (0)
#define PG8_WAIT_V(n) asm volatile("s_waitcnt vmcnt(" #n ")" ::: "memory")
#define PG8_WAIT_L(n) asm volatile("s_waitcnt lgkmcnt(" #n ")" ::: "memory")
#define PG8_BAR __builtin_amdgcn_s_barrier()
#define PG8_SCHED __builtin_amdgcn_sched_barrier(0)
    Unit cur, nxt; int ui = 0;
    if (!S.next(0, cur)) return;
    f32x4 acc[2][2][4][2];
#pragma unroll
    for (int a = 0; a < 2; ++a)
#pragma unroll
        for (int b = 0; b < 2; ++b)
#pragma unroll
            for (int m = 0; m < 4; ++m)
#pragma unroll
                for (int n = 0; n < 2; ++n) acc[a][b][m][n] = (f32x4){0.f, 0.f, 0.f, 0.f};
    bf16x8 At[4][2], B0[2][2], B1[2][2];
#define PG8_UA(u) ((const char*)g.A + (long)(u).job * g.dA1 + (size_t)(u).pm * tstepA + (size_t)(u).kt0 * kstep)
#define PG8_UB(u) ((const char*)g.Bt + (long)(u).job * g.dB1 + (size_t)(u).pn * tstepB + (size_t)(u).kt0 * kstep)
    const char* cA = PG8_UA(cur); const char* cB = PG8_UB(cur);
    S.a_ready(cur);
    if constexpr (SP2) {
        PG8_STAGE(PG8_SB(0, 0), cB, voffB); PG8_STAGE(PG8_SB(0, 1), cB + hstepB, voffB); PG8_STAGE(PG8_SA(0, 0), cA, voffA); PG8_STAGE(PG8_SA(0, 1), cA + hstepA, voffA);
        if (wr == 1) PG8_BAR;
        PG8_WAIT_V(2); PG8_BAR;
        PG8_STAGE(PG8_SB(1, 0), cB + kstep, voffB); PG8_STAGE(PG8_SA(1, 0), cA + kstep, voffA); PG8_STAGE(PG8_SB(1, 1), cB + hstepB + kstep, voffB);
        PG8_WAIT_V(6); PG8_BAR;
    } else {
        PG8_STAGE(PG8_SB(0, 0), cB, voffB); PG8_STAGE(PG8_SA(0, 0), cA, voffA); PG8_STAGE(PG8_SB(0, 1), cB + hstepB, voffB); PG8_STAGE(PG8_SA(0, 1), cA + hstepA, voffA);
        if (wr == 1) PG8_BAR;
        PG8_WAIT_V(4); PG8_BAR;
        PG8_STAGE(PG8_SB(1, 0), cB + kstep, voffB); PG8_STAGE(PG8_SA(1, 0), cA + kstep, voffA); PG8_STAGE(PG8_SB(1, 1), cB + hstepB + kstep, voffB);
        PG8_WAIT_V(6); PG8_BAR;
    }
    for (;;) {
        const bool has_next = S.next(ui + 1, nxt);
        const char* nA = has_next ? PG8_UA(nxt) : cA; const char* nB = has_next ? PG8_UB(nxt) : cB;
        const int nt = cur.nt;
        for (int t = 0; t < nt; t += 2) {
            if constexpr (Epi::MIDK) { if (t == Epi::T1 || t == Epi::T2) E.mid(acc, cur, t, wr, wc, fr, fq); }
            const bool last = (t == nt - 2);
            const char* a1 = cA + (size_t)(t + 1) * kstep;
            const char* a2 = last ? nA : cA + (size_t)(t + 2) * kstep; const char* b2 = last ? nB : cB + (size_t)(t + 2) * kstep;
            const char* a3 = a2 + kstep; const char* b3 = b2 + kstep;
            if (last && has_next) S.a_ready(nxt);
            if constexpr (SP2) {
            const int loose = __builtin_amdgcn_readfirstlane(((t == 0) && (ui > 0)) ? 1 : 0);
#define PG8_WAIT_V8L do { if constexpr (Epi::NST == 8) asm volatile("s_waitcnt vmcnt(16)\n\ts_cmp_lg_u32 %0, 0\n\ts_cbranch_scc1 1f\n\ts_waitcnt vmcnt(8)\n1:" :: "s"(loose) : "memory", "scc"); \
                          else asm volatile("s_waitcnt vmcnt(24)\n\ts_cmp_lg_u32 %0, 0\n\ts_cbranch_scc1 1f\n\ts_waitcnt vmcnt(8)\n1:" :: "s"(loose) : "memory", "scc"); } while (0)
            PG8_LDB(B0, 0, 0); PG8_LDB(B1, 0, 1); PG8_SCHED; PG8_LDA(At, 0, 0); PG8_STAGE(PG8_SA(1, 1), a1 + hstepA, voffA);
            PG8_WAIT_V8L; PG8_WAIT_L(0); PG8_BAR; PG8_MMA(0, 0, At, B0); PG8_MMA(0, 1, At, B1); PG8_BAR; PG8_SCHED;
            PG8_LDA(At, 0, 1); PG8_STAGE(PG8_SB(0, 0), b2, voffB); PG8_STAGE(PG8_SB(0, 1), b2 + hstepB, voffB); PG8_STAGE(PG8_SA(0, 0), a2, voffA);
            PG8_WAIT_V8L; PG8_WAIT_L(0); PG8_BAR; PG8_MMA(1, 0, At, B0); PG8_MMA(1, 1, At, B1); PG8_BAR; PG8_SCHED;
#undef PG8_WAIT_V8L
            PG8_LDB(B0, 1, 0); PG8_LDB(B1, 1, 1); PG8_SCHED; PG8_LDA(At, 1, 0); PG8_STAGE(PG8_SA(0, 1), a2 + hstepA, voffA);
            PG8_WAIT_V(8); PG8_WAIT_L(0); PG8_BAR; PG8_MMA(0, 0, At, B0); PG8_MMA(0, 1, At, B1); PG8_BAR; PG8_SCHED;
            PG8_LDA(At, 1, 1); PG8_STAGE(PG8_SB(1, 0), b3, voffB); PG8_STAGE(PG8_SB(1, 1), b3 + hstepB, voffB); PG8_STAGE(PG8_SA(1, 0), a3, voffA);
            PG8_WAIT_V(8); PG8_WAIT_L(0); PG8_BAR; PG8_MMA(1, 0, At, B0); PG8_MMA(1, 1, At, B1); PG8_BAR; PG8_SCHED;
            } else {
            PG8_LDB(B0, 0, 0); PG8_SCHED; PG8_LDA(At, 0, 0); PG8_STAGE(PG8_SA(1, 1), a1 + hstepA, voffA);
            PG8_WAIT_L(8); PG8_BAR; PG8_WAIT_L(0); PG8_MMA(0, 0, At, B0); PG8_BAR; PG8_SCHED;
            PG8_LDB(B1, 0, 1); PG8_STAGE(PG8_SB(0, 0), b2, voffB);
            PG8_BAR; PG8_WAIT_L(0); PG8_MMA(0, 1, At, B1); PG8_BAR;
            PG8_LDA(At, 0, 1); PG8_STAGE(PG8_SA(0, 0), a2, voffA);
            PG8_BAR; PG8_WAIT_L(0); PG8_MMA(1, 0, At, B0); PG8_BAR; PG8_SCHED;
            PG8_STAGE(PG8_SB(0, 1), b2 + hstepB, voffB);
            PG8_WAIT_V(6); PG8_BAR; PG8_MMA(1, 1, At, B1); PG8_BAR;
            PG8_LDB(B0, 1, 0); PG8_SCHED; PG8_LDA(At, 1, 0); PG8_STAGE(PG8_SA(0, 1), a2 + hstepA, voffA);
            PG8_WAIT_L(8); PG8_BAR; PG8_WAIT_L(0); PG8_MMA(0, 0, At, B0); PG8_BAR; PG8_SCHED;
            PG8_LDB(B1, 1, 1); PG8_STAGE(PG8_SB(1, 0), b3, voffB);
            PG8_BAR; PG8_WAIT_L(0); PG8_MMA(0, 1, At, B1); PG8_BAR;
            PG8_LDA(At, 1, 1); PG8_STAGE(PG8_SA(1, 0), a3, voffA);
            PG8_BAR; PG8_WAIT_L(0); PG8_MMA(1, 0, At, B0); PG8_BAR; PG8_SCHED;
            PG8_STAGE(PG8_SB(1, 1), b3 + hstepB, voffB);
            PG8_WAIT_V(6); PG8_BAR; PG8_MMA(1, 1, At, B1); PG8_BAR;
            }
        }
        if constexpr (ALIGN_EPI) { if (wr == 0) PG8_BAR; }
        if constexpr (!Epi::AFTER_DRAIN) { E(acc, cur, wr, wc, fr, fq); S.done(cur); }
        if (!has_next) break;
#pragma unroll
        for (int a = 0; a < 2; ++a)
#pragma unroll
            for (int b = 0; b < 2; ++b)
#pragma unroll
                for (int m = 0; m < 4; ++m)
#pragma unroll
                    for (int n = 0; n < 2; ++n) acc[a][b][m][n] = (f32x4){0.f, 0.f, 0.f, 0.f};
        cur = nxt; cA = nA; cB = nB; ++ui;
        if constexpr (ALIGN_EPI) { if (wr == 1) PG8_BAR; }
    }
    PG8_WAIT_V(0);
    if constexpr (!ALIGN_EPI) { if (wr == 0) PG8_BAR; }
    PG8_BAR;
    if constexpr (Epi::AFTER_DRAIN) { E.fused(acc, cur, wr, wc, fr, fq, lds, wid, lane); S.done(cur); }
#undef PG8_UA
#undef PG8_UB
#undef PG8_SA
#undef PG8_SB
#undef PG8_STAGE
#undef PG8_LDA
#undef PG8_LDB
#undef PG8_MMA
#undef PG8_WAIT_V
#undef PG8_WAIT_L
#undef PG8_BAR
#undef PG8_SCHED
}
}

#ifndef PG8_SP2
#define PG8_SP2 true
#endif
#ifndef PG8_ALIGN
#define PG8_ALIGN true
#endif

constexpr int NWAVES = 8;
constexpr int DM = 2048, SEQ = 8192, CTX = 256, DEPTH = 2, GRID_W = 64, NROWS = SEQ / GRID_W;
constexpr int MTOT = SEQ + CTX;
constexpr int NH = 8, HD = 128, DNA = 1024, WIN_R = 8, WIN_C = 16;
constexpr int DFOUR = 512, FG = 128, DCONV = 512, CONVW = 31;
constexpr int DFF = 5632, DIN = 4608, NMODU = 6;
constexpr int ADA_N = 9 * DM;
constexpr float LN_EPS = 1e-5f, ALPHA = 1.4142135623730951f;
constexpr int ZQ = 0, ZK = DNA, ZV = 2 * DNA, ZF = 3 * DNA, ZA = 3 * DNA + DFOUR, ZG = 3 * DNA + DFOUR + DCONV;
constexpr int YNA = 0, YF = DNA, YC = DNA + DFOUR;

enum { I_X = 0, I_C, I_CTX, I_CCTX, I_WADA, I_BADA, I_F1W1, I_F1W3, I_F1W2, I_F2W1, I_F2W3, I_F2W2, I_WIN, I_WDW, I_BDW, I_CLNG, I_CLNB, I_RPB, I_WGATE, I_BGATE, I_WBNA, I_WBF, I_WBC, I_WO, I_LNG, I_LNB, N_IN };

constexpr size_t MiB = 1u << 20;
constexpr size_t WS_CTL = 0, CTL_ZERO_BYTES = 1 * MiB;
constexpr int MODP_CH = 16;
constexpr size_t WS_MODP = 2 * MiB;
constexpr size_t WS_MOD = 6 * MiB;
constexpr size_t WS_W = 8 * MiB;
constexpr size_t WL_W13A = 0, WL_W2A = 44 * MiB, WL_W13B = 66 * MiB, WL_W2B = 110 * MiB, WL_WIN = 132 * MiB, WL_WG = 150 * MiB, WL_WB = 174 * MiB, WL_WO = 182 * MiB, WL_SIZE = 190 * MiB;
constexpr size_t WS_X = 388 * MiB;
constexpr size_t WS_T = 454 * MiB;
constexpr size_t WS_H = 520 * MiB;
constexpr size_t WS_G = 553 * MiB;
constexpr size_t WS_ZIN = 644 * MiB;
constexpr size_t WS_YALL = 719 * MiB;
constexpr size_t WS_GATES = 752 * MiB;
constexpr size_t WS_MB = 851 * MiB;
constexpr size_t WS_FY = 884 * MiB;
constexpr size_t WS_VT = 917 * MiB;
constexpr size_t WS_PART = 934 * MiB;
constexpr size_t WS_END = 978 * MiB;
static_assert(WS_W + 2 * WL_SIZE <= WS_X && WS_G + (size_t)MTOT * DFF * 2 <= WS_ZIN && WS_ZIN + (size_t)MTOT * DIN * 2 <= WS_YALL && WS_GATES + (size_t)MTOT * 3 * DM * 2 <= WS_MB && WS_FY + (size_t)MTOT * DFOUR * 8 <= WS_END, "d_ws map");
constexpr int CW_TMO = 0, CW_BAR = 4096;

constexpr int RING_OFF = 0, RING_BYTES = 131072;
constexpr int LDSCTL_OFF = RING_BYTES, MISC_OFF = LDSCTL_OFF + 320;
constexpr int LDS_BYTES = 147456;

#define GAS __attribute__((address_space(1)))
#define LAS __attribute__((address_space(3)))
typedef unsigned short bf16;
typedef unsigned v4u __attribute__((ext_vector_type(4)));
typedef unsigned v2u __attribute__((ext_vector_type(2)));
typedef float f32x4 __attribute__((ext_vector_type(4)));
typedef float f32x2 __attribute__((ext_vector_type(2)));
typedef short bf16x8 __attribute__((ext_vector_type(8)));
typedef GAS unsigned gu32;
typedef float xh;
typedef float xh4 __attribute__((ext_vector_type(4)));
__device__ __forceinline__ f32x4 xld4(const xh* p) { return __builtin_convertvector(*(const GAS xh4*)p, f32x4); }
__device__ __forceinline__ void xst4(xh* p, f32x4 v) { *(GAS xh4*)p = __builtin_convertvector(v, xh4); }
#define RLX_AGENT __ATOMIC_RELAXED, __HIP_MEMORY_SCOPE_AGENT
#define LDS_WAIT() asm volatile("s_waitcnt lgkmcnt(0)" ::: "memory")
#define VM_WAIT() asm volatile("s_waitcnt vmcnt(0)" ::: "memory")
__device__ __forceinline__ unsigned f2bf(float f) { unsigned u = __builtin_bit_cast(unsigned, f); return (u + 0x7fffu + ((u >> 16) & 1u)) >> 16; }
__device__ __forceinline__ unsigned pk2(float lo, float hi) { return f2bf(lo) | (f2bf(hi) << 16); }
typedef __bf16 bf16x2v __attribute__((ext_vector_type(2)));
__device__ __forceinline__ unsigned pkbf(float lo, float hi) { const f32x2 v = {lo, hi}; const bf16x2v b = __builtin_convertvector(v, bf16x2v); return __builtin_bit_cast(unsigned, b); }
__device__ __forceinline__ float bf2f(bf16 b) { return __builtin_bit_cast(float, (unsigned)b << 16); }
__device__ __forceinline__ float sigm(float x) { return 1.0f / (1.0f + __expf(-x)); }
template <int CTRL> __device__ __forceinline__ float dppf(float v) { return __builtin_bit_cast(float, __builtin_amdgcn_update_dpp(0, __builtin_bit_cast(int, v), CTRL, 0xF, 0xF, false)); }
template <int CTRL, int ROWMASK> __device__ __forceinline__ float dppfm(float v) { return __builtin_bit_cast(float, __builtin_amdgcn_update_dpp(0, __builtin_bit_cast(int, v), CTRL, ROWMASK, 0xF, true)); }
__device__ __forceinline__ float wave_sum(float v) {
    v += dppf<0x128>(v); v += dppf<0x124>(v); v += dppf<0x122>(v); v += dppf<0x121>(v);
    v += dppfm<0x142, 0xA>(v);
    v += dppfm<0x143, 0xC>(v);
    return __builtin_bit_cast(float, __builtin_amdgcn_readlane(__builtin_bit_cast(int, v), 63));
}
__device__ __forceinline__ float wave_max(float v) {
#pragma unroll
    for (int o = 1; o < 64; o <<= 1) v = fmaxf(v, __shfl_xor(v, o));
    return v;
}
#define XB_TMO      128
#define XB_XCNT(j)  (256  + 64 * (j))
#define XB_XSUB(j)  (1280 + 64 * (j))
#define XB_XGEN(j)  (2304 + 64 * (j))
#define XB_TOP      3328
#define XB_TOPGEN   3392
#define XCD_BAR_WORDS 3456
#define XB_SPIN_CAP (1u << 18)

__device__ __forceinline__ unsigned xb_ld(unsigned* p)              { return __hip_atomic_load(p, __ATOMIC_RELAXED, __HIP_MEMORY_SCOPE_AGENT); }
__device__ __forceinline__ unsigned xb_add(unsigned* p, unsigned v) { return __hip_atomic_fetch_add(p, v, __ATOMIC_RELAXED, __HIP_MEMORY_SCOPE_AGENT); }
__device__ __forceinline__ unsigned xb_xcc_id() { return (unsigned)__builtin_amdgcn_s_getreg((3 << 11) | 20) & 0xFu; }
#define XB_SPIN(cond, bar) do { unsigned _sp = 0; while (cond) { __builtin_amdgcn_s_sleep(1); \
    if ((++_sp & 255u) == 0u) { if (xb_ld(&(bar)[XB_TMO])) break; if (_sp > XB_SPIN_CAP) { atomicAdd(&(bar)[XB_TMO], 1u); break; } } } } while (0)

struct XcdBarrier {
    unsigned* bar; unsigned x; int wave;
    volatile LAS unsigned* st;
};

__device__ __forceinline__ XcdBarrier xcd_barrier_post(unsigned* bar, volatile LAS unsigned* st) {
    XcdBarrier b; b.bar = bar; b.x = xb_xcc_id(); b.st = st; b.wave = __builtin_amdgcn_readfirstlane(threadIdx.x >> 6);
    if (threadIdx.x == 0) (void)xb_add(&bar[XB_XCNT(b.x)], 1u);
    return b;
}
__device__ __forceinline__ void xcd_barrier_complete(unsigned* bar, unsigned x, unsigned& nloc, unsigned& nx) {
    const unsigned G = gridDim.x * gridDim.y * gridDim.z;
    unsigned sum, cnt, mine, sp = 0u;
    for (;;) {
        sum = 0u; cnt = 0u; mine = 0u;
#pragma unroll
        for (unsigned j = 0; j < 16; ++j) { const unsigned c = xb_ld(&bar[XB_XCNT(j)]); sum += c; cnt += (c > 0u) ? 1u : 0u; mine = (j == x) ? c : mine; }
        if (sum == G) break;
        __builtin_amdgcn_s_sleep(1);
        if ((++sp & 255u) == 0u) { if (xb_ld(&bar[XB_TMO])) break; if (sp > XB_SPIN_CAP) { atomicAdd(&bar[XB_TMO], 1u); break; } }
    }
    nloc = mine > 0u ? mine : 1u; nx = cnt > 0u ? cnt : 1u;
}

__device__ __forceinline__ void xcd_barrier(const XcdBarrier& b) {
    asm volatile("s_waitcnt vmcnt(0)" ::: "memory");
    __syncthreads();
    if (b.wave == 0 && hw_lane() == 0) {
        unsigned* bar = b.bar;
        __builtin_amdgcn_s_waitcnt(0);
        unsigned nloc = b.st[0], nx = b.st[1];
        if (nloc == 0u) { xcd_barrier_complete(bar, b.x, nloc, nx); b.st[0] = nloc; b.st[1] = nx; }
        const unsigned old = xb_add(&bar[XB_XSUB(b.x)], 1u);
        const unsigned gen = old / nloc;
        if (old + 1u == (gen + 1u) * nloc) {
            __builtin_amdgcn_fence(__ATOMIC_RELEASE, "agent");
            asm volatile("s_waitcnt vmcnt(0)" ::: "memory");
            const unsigned og = xb_add(&bar[XB_TOP], 1u);
            const unsigned tg = og / nx;
            if (og + 1u == (tg + 1u) * nx) xb_add(&bar[XB_TOPGEN], 1u);
            else XB_SPIN(xb_ld(&bar[XB_TOPGEN]) == tg, bar);
            __builtin_amdgcn_fence(__ATOMIC_ACQUIRE, "agent");
            xb_add(&bar[XB_XGEN(b.x)], 1u);
            asm volatile("s_waitcnt vmcnt(0)" ::: "memory");
        } else {
            XB_SPIN(xb_ld(&bar[XB_XGEN(b.x)]) == gen, bar);
            __builtin_amdgcn_fence(__ATOMIC_ACQUIRE, "agent");
            asm volatile("s_waitcnt vmcnt(0)" ::: "memory");
        }
    }
    __syncthreads();
}


struct Ctx {
    LAS unsigned char* lds; int tid, lane, wave, bx, G, gw, NGW;
};
struct Args { const float* in[26]; float* out; unsigned char* ws; int ph_lo, ph_hi, use_bar, pad; };
typedef const __attribute__((address_space(4))) Args* KAp;
typedef unsigned u32x4p __attribute__((ext_vector_type(4)));
__device__ __forceinline__ KAp ka_opaque() { KAp p = (KAp)__builtin_amdgcn_kernarg_segment_ptr(); asm volatile("" : "+s"(p)); return p; }

struct TrDesc { const float* W; int N; bf16* WT; int ldk, koff, grp, gstride, goff, item; };
#ifndef TR_MAP
#define TR_MAP 1
#endif
__device__ __forceinline__ void tr_kn(const TrDesc& d, int& kb, int& nb) {
    const int nblk = d.N / 64;
#if TR_MAP == 1
    const int pr = d.item / (2 * nblk), j = d.item % (2 * nblk); kb = 2 * pr + ((j >> 2) & 1); nb = 4 * (j >> 3) + (j & 3);
#elif TR_MAP == 2
    const int pr = d.item / (8 * nblk), j = d.item % (8 * nblk); kb = 8 * pr + (j & 7); nb = j >> 3;
#else
    kb = d.item / nblk; nb = d.item % nblk;
#endif
}
__device__ __forceinline__ void tr_load(const TrDesc& d, f32x4 (&a)[8], f32x4 (&b)[8], int lane) {
    int kb, nb; tr_kn(d, kb, nb); const int k0 = 64 * kb, n0 = 64 * nb, nq = lane & 15, kr = lane >> 4;
#pragma unroll
    for (int i = 0; i < 8; ++i) { const float* wp = d.W + (size_t)(k0 + 8 * i + 2 * kr) * d.N + n0 + 4 * nq; a[i] = *(const GAS f32x4*)wp; b[i] = *(const GAS f32x4*)(wp + d.N); }
}
__device__ __forceinline__ void tr_finish(const TrDesc& d, const f32x4 (&a)[8], const f32x4 (&b)[8], LAS unsigned* scr, int lane) {
    int kb, nb; tr_kn(d, kb, nb); const int k0 = 64 * kb, n0 = 64 * nb, nq = lane & 15, kr = lane >> 4;
#pragma unroll
    for (int i = 0; i < 8; ++i) { const int kd = 4 * i + kr;
#pragma unroll
        for (int e = 0; e < 4; ++e) scr[(4 * nq + e) * 33 + kd] = pkbf(a[i][e], b[i][e]); }
    LDS_WAIT(); asm volatile("" ::: "memory");
#pragma unroll
    for (int j = 0; j < 8; ++j) { const int n = (lane >> 3) + 8 * j, ch = lane & 7; const LAS unsigned* s = scr + n * 33 + 4 * ch;
        v4u o; o.x = s[0]; o.y = s[1]; o.z = s[2]; o.w = s[3];
        const int nn = n0 + n, drow = (nn / d.grp) * d.gstride + d.goff + (nn % d.grp);
        *(GAS v4u*)(d.WT + (size_t)drow * d.ldk + d.koff + k0 + 8 * ch) = o; }
    LDS_WAIT(); asm volatile("" ::: "memory");
}
constexpr int TI_FF = (DM / 64) * (DFF / 64);
constexpr int TI_IN = (DM / 64) * (DIN / 64), TI_G = (DM / 64) * (3 * DM / 64), TI_BNA = (DNA / 64) * (DM / 64), TI_BF = (DFOUR / 64) * (DM / 64), TI_BC = (DCONV / 64) * (DM / 64), TI_O = (DM / 64) * (DM / 64);
constexpr int TI_LAYER = 6 * TI_FF + TI_IN + TI_G + TI_BNA + TI_BF + TI_BC + TI_O;
constexpr int MOD_CB = NMODU * DM / 256;
constexpr int MODI = DEPTH * MOD_CB * MODP_CH;

__device__ __forceinline__ TrDesc weight_desc(const KAp ka, unsigned char* ws, int l, int r) {
    unsigned char* wl = ws + WS_W + (size_t)l * WL_SIZE;
    const float* W; int N; bf16* WT; int ldk, koff = 0, grp, gstride = 0, goff = 0;
    if (r < TI_FF) { W = ka->in[I_F1W1] + (size_t)l * DM * DFF; N = DFF; WT = (bf16*)(wl + WL_W13A); ldk = DM; grp = 128; gstride = 256; goff = 0; }
    else if ((r -= TI_FF) < TI_FF) { W = ka->in[I_F1W3] + (size_t)l * DM * DFF; N = DFF; WT = (bf16*)(wl + WL_W13A); ldk = DM; grp = 128; gstride = 256; goff = 128; }
    else if ((r -= TI_FF) < TI_FF) { W = ka->in[I_F1W2] + (size_t)l * DFF * DM; N = DM; WT = (bf16*)(wl + WL_W2A); ldk = DFF; grp = DM; }
    else if ((r -= TI_FF) < TI_FF) { W = ka->in[I_F2W1] + (size_t)l * DM * DFF; N = DFF; WT = (bf16*)(wl + WL_W13B); ldk = DM; grp = 128; gstride = 256; goff = 0; }
    else if ((r -= TI_FF) < TI_FF) { W = ka->in[I_F2W3] + (size_t)l * DM * DFF; N = DFF; WT = (bf16*)(wl + WL_W13B); ldk = DM; grp = 128; gstride = 256; goff = 128; }
    else if ((r -= TI_FF) < TI_FF) { W = ka->in[I_F2W2] + (size_t)l * DFF * DM; N = DM; WT = (bf16*)(wl + WL_W2B); ldk = DFF; grp = DM; }
    else if ((r -= TI_FF) < TI_IN) { W = ka->in[I_WIN] + (size_t)l * DM * DIN; N = DIN; WT = (bf16*)(wl + WL_WIN); ldk = DM; grp = DIN; }
    else if ((r -= TI_IN) < TI_G) { W = ka->in[I_WGATE] + (size_t)l * DM * 3 * DM; N = 3 * DM; WT = (bf16*)(wl + WL_WG); ldk = DM; grp = 3 * DM; }
    else if ((r -= TI_G) < TI_BNA) { W = ka->in[I_WBNA] + (size_t)l * DNA * DM; N = DM; WT = (bf16*)(wl + WL_WB); ldk = DM; grp = DM; koff = 0; }
    else if ((r -= TI_BNA) < TI_BF) { W = ka->in[I_WBF] + (size_t)l * DFOUR * DM; N = DM; WT = (bf16*)(wl + WL_WB); ldk = DM; grp = DM; koff = DNA; }
    else if ((r -= TI_BF) < TI_BC) { W = ka->in[I_WBC] + (size_t)l * DCONV * DM; N = DM; WT = (bf16*)(wl + WL_WB); ldk = DM; grp = DM; koff = DNA + DFOUR; }
    else { r -= TI_BC; W = ka->in[I_WO] + (size_t)l * DM * DM; N = DM; WT = (bf16*)(wl + WL_WO); ldk = DM; grp = DM; }
    TrDesc d; d.W = W; d.N = N; d.WT = WT; d.ldk = ldk; d.koff = koff; d.grp = grp; d.gstride = gstride; d.goff = goff; d.item = r; return d;
}
__device__ __forceinline__ void weight_item(const KAp ka, unsigned char* ws, int l, int r, LAS unsigned* scr, int lane) {
    const TrDesc d = weight_desc(ka, ws, l, r); f32x4 a[8], b[8]; tr_load(d, a, b, lane); tr_finish(d, a, b, scr, lane);
}
__device__ __forceinline__ int w2_lo(int f) { return f == 0 ? 2 * TI_FF : 5 * TI_FF; }
constexpr int L1_OTHER = TI_LAYER - 2 * TI_FF;
constexpr int TI_MIX = TI_LAYER - 6 * TI_FF;
__device__ __forceinline__ int l1_other_item(int q) { return q < 2 * TI_FF ? q : (q < 4 * TI_FF ? q + TI_FF : q + 2 * TI_FF); }
__device__ __forceinline__ void helper_convert(const Ctx& F, int first_idle_block, int la, int qa0, int nA, int lb = 0, int qb0 = 0, int nB = 0) {
    if (F.bx < first_idle_block) return;
    const KAp ka = ka_opaque(); unsigned char* const ws = ka->ws;
    LAS unsigned* scr = (LAS unsigned*)(F.lds + RING_OFF + F.wave * 16384);
    const int hw = (F.bx - first_idle_block) * NWAVES + F.wave, nhw = (F.G - first_idle_block) * NWAVES;
    const int lane = hw_lane();
    for (int q = hw; q < nA + nB; q += nhw) { const bool inA = q < nA; weight_item(ka, ws, inA ? la : lb, inA ? qa0 + q : qb0 + (q - nA), scr, lane); }
}
__device__ __forceinline__ TrDesc p0_desc(const KAp ka, unsigned char* ws, int r) {
    return weight_desc(ka, ws, 0, r < 2 * TI_FF ? r : r + 4 * TI_FF);
}
__device__ __forceinline__ void p0_prologue(const Ctx& F) {
    const KAp ka = ka_opaque(); unsigned char* const ws = ka->ws;
    LAS unsigned* scr = (LAS unsigned*)(F.lds + RING_OFF + F.wave * 16384);
    for (int it = F.gw; it < MODI; it += F.NGW) {
        const int l = it / (MOD_CB * MODP_CH), r = it % (MOD_CB * MODP_CH), cb = r / MODP_CH, kc = r % MODP_CH;
        const float* cv = ka->in[I_C]; const float* cc = ka->in[I_CCTX];
        const float a0 = cv[kc * 128 + F.lane], a1 = cv[kc * 128 + 64 + F.lane], b0 = cc[kc * 128 + F.lane], b1 = cc[kc * 128 + 64 + F.lane];
        const float sl0 = a0 * sigm(a0), sl1 = a1 * sigm(a1), sc0 = b0 * sigm(b0), sc1 = b1 * sigm(b1);
        const float* W = ka->in[I_WADA] + (size_t)l * DM * ADA_N + (size_t)(kc * 128) * ADA_N + cb * 256 + 4 * F.lane;
        f32x4 aL = {0.f, 0.f, 0.f, 0.f}, aC = {0.f, 0.f, 0.f, 0.f};
#pragma unroll 16
        for (int k = 0; k < 64; ++k) { const f32x4 w = *(const GAS f32x4*)(W + (size_t)k * ADA_N); aL += w * __shfl(sl0, k); aC += w * __shfl(sc0, k); }
#pragma unroll 16
        for (int k = 0; k < 64; ++k) { const f32x4 w = *(const GAS f32x4*)(W + (size_t)(64 + k) * ADA_N); aL += w * __shfl(sl1, k); aC += w * __shfl(sc1, k); }
        float* P = (float*)(ws + WS_MODP);
        *(GAS f32x4*)(P + (size_t)((kc * 2 + l) * 2 + 0) * (NMODU * DM) + cb * 256 + 4 * F.lane) = aL;
        *(GAS f32x4*)(P + (size_t)((kc * 2 + l) * 2 + 1) * (NMODU * DM) + cb * 256 + 4 * F.lane) = aC;
    }
    const int NT = 2 * TI_FF + (TI_LAYER - 6 * TI_FF);
    int r = (F.gw + MODI) % F.NGW;
    f32x4 a0[8], b0[8], a1[8], b1[8];
    if (r < NT) { TrDesc d0 = p0_desc(ka, ws, r); tr_load(d0, a0, b0, F.lane);
        for (;;) {
            const int r1 = r + F.NGW; const bool v1 = r1 < NT; TrDesc d1 = d0;
            if (v1) { d1 = p0_desc(ka, ws, r1); tr_load(d1, a1, b1, F.lane); }
            tr_finish(d0, a0, b0, scr, F.lane);
            if (!v1) break;
            const int r2 = r1 + F.NGW; const bool v2 = r2 < NT;
            if (v2) { d0 = p0_desc(ka, ws, r2); tr_load(d0, a0, b0, F.lane); }
            tr_finish(d1, a1, b1, scr, F.lane);
            if (!v2) break;
            r = r2;
        } }
}

__device__ __forceinline__ const float* mod_vec(unsigned char* ws, int l, int s, int i) { return (const float*)(ws + WS_MOD) + (size_t)((l * 2 + s) * NMODU + i) * DM; }
__device__ __forceinline__ void p1_prologue(const Ctx& F) {
    const KAp ka = ka_opaque(); unsigned char* const ws = ka->ws;
    const float* P = (const float*)(ws + WS_MODP); const float* bada = ka->in[I_BADA];
    LAS float* mv = (LAS float*)(F.lds + RING_OFF);
#pragma unroll 1
    for (int v = 0; v < 4; ++v) { const int s = v >> 1, i = v & 1;
        float pa[4][MODP_CH], a0[4];
#pragma unroll
        for (int q = 0; q < 4; ++q) { const int col = F.tid + 512 * q; a0[q] = bada[i * DM + col];
#pragma unroll
            for (int kc = 0; kc < MODP_CH; ++kc) pa[q][kc] = P[(size_t)((kc * 2 + 0) * 2 + s) * (NMODU * DM) + i * DM + col]; }
#pragma unroll
        for (int q = 0; q < 4; ++q) { float a = a0[q];
#pragma unroll
            for (int kc = 0; kc < MODP_CH; ++kc) a += pa[q][kc];
            mv[v * DM + F.tid + 512 * q] = a; } }
    const int gt = F.bx * 512 + F.tid;
    if (gt < DEPTH * 2 * NMODU * DM) { const int l = gt / (2 * NMODU * DM), s = (gt / (NMODU * DM)) & 1, j = gt % (NMODU * DM); float a = bada[(size_t)l * ADA_N + j];
        for (int kc = 0; kc < MODP_CH; ++kc) a += P[(size_t)((kc * 2 + l) * 2 + s) * (NMODU * DM) + j];
        ((float*)(ws + WS_MOD))[(size_t)(l * 2 + s) * (NMODU * DM) + j] = a; }
    __syncthreads();
    xh* X = (xh*)(ws + WS_X); bf16* H = (bf16*)(ws + WS_H);
    for (int row0 = F.gw; row0 < MTOT; row0 += 2 * F.NGW) {
        const int row1 = row0 + F.NGW; const bool two = row1 < MTOT;
        f32x4 va[8], vb[8];
        { const float* src = row0 < SEQ ? ka->in[I_X] + (size_t)row0 * DM : ka->in[I_CTX] + (size_t)(row0 - SEQ) * DM;
#pragma unroll
          for (int j = 0; j < 8; ++j) va[j] = *(const GAS f32x4*)(src + 4 * F.lane + 256 * j); }
        if (two) { const float* src = row1 < SEQ ? ka->in[I_X] + (size_t)row1 * DM : ka->in[I_CTX] + (size_t)(row1 - SEQ) * DM;
#pragma unroll
          for (int j = 0; j < 8; ++j) vb[j] = *(const GAS f32x4*)(src + 4 * F.lane + 256 * j); }
#pragma unroll
        for (int h2 = 0; h2 < 2; ++h2) { if (h2 == 1 && !two) break;
            const int row = h2 ? row1 : row0;
            const LAS float* sh = mv + (row < SEQ ? 0 : 2 * DM); const LAS float* sc = sh + DM;
#pragma unroll
            for (int j = 0; j < 8; ++j) { const int col = 4 * F.lane + 256 * j; const f32x4 v = h2 ? vb[j] : va[j];
                xst4(X + (size_t)row * DM + col, v);
                const f32x4 s4 = *(const LAS f32x4*)(sc + col), h4 = *(const LAS f32x4*)(sh + col); const f32x4 h = v * (s4 + 1.0f) + h4;
                v2u o; o.x = pk2(h[0], h[1]); o.y = pk2(h[2], h[3]); *(GAS v2u*)(H + (size_t)row * DM + col) = o; } }
    }
    __syncthreads();
}

#ifndef DIAG_ZERO_NA
#define DIAG_ZERO_NA 0
#endif
#ifndef DIAG_ZERO_C
#define DIAG_ZERO_C 0
#endif
#ifndef DIAG_ZERO_ROW0
#define DIAG_ZERO_ROW0 0
#endif
__device__ __forceinline__ f32x4 bf4(v2u w) { return (f32x4){pg8::bf_lo(w.x), pg8::bf_hi(w.x), pg8::bf_lo(w.y), pg8::bf_hi(w.y)}; }
__device__ __forceinline__ void ln_load_row(const Ctx& F, f32x4 (&v)[8], int row, const bf16* Dl, const xh* Xin, const bf16* parts, int nparts, const float* gate_ctx, float gmul) {
    if (parts && row >= SEQ) {
        f32x4 a[8];
#pragma unroll
        for (int j = 0; j < 8; ++j) a[j] = (f32x4){0.f, 0.f, 0.f, 0.f};
#pragma unroll 2
        for (int ch = 0; ch < nparts; ++ch) { const bf16* pp = parts + ((size_t)ch * 256 + (row - SEQ)) * DM + 4 * F.lane;
#pragma unroll
            for (int j = 0; j < 8; ++j) a[j] += bf4(*(const GAS v2u*)(pp + 256 * j)); }
#pragma unroll
        for (int j = 0; j < 8; ++j) { const int col = 4 * F.lane + 256 * j; v[j] = xld4(Xin + (size_t)row * DM + col) * ALPHA + a[j] * (*(const GAS f32x4*)(gate_ctx + col) * gmul); }
    } else {
#pragma unroll
        for (int j = 0; j < 8; ++j) { const int col = 4 * F.lane + 256 * j; v[j] = xld4(Xin + (size_t)row * DM + col) * ALPHA + bf4(*(const GAS v2u*)(Dl + (size_t)row * DM + col)); }
    }
}
__device__ __forceinline__ void ln_stats2(f32x4 (&v0)[8], f32x4 (&v1)[8], bool two, float& r0, float& r1) {
    float s0 = 0.f, s1 = 0.f;
#pragma unroll
    for (int j = 0; j < 8; ++j) { s0 += (v0[j][0] + v0[j][1]) + (v0[j][2] + v0[j][3]); if (two) s1 += (v1[j][0] + v1[j][1]) + (v1[j][2] + v1[j][3]); }
    s0 = wave_sum(s0); s1 = wave_sum(s1);
    const float m0 = s0 * (1.0f / DM), m1 = s1 * (1.0f / DM); float q0 = 0.f, q1 = 0.f;
#pragma unroll
    for (int j = 0; j < 8; ++j) { v0[j] = v0[j] - m0; q0 += (v0[j][0] * v0[j][0] + v0[j][1] * v0[j][1]) + (v0[j][2] * v0[j][2] + v0[j][3] * v0[j][3]);
        if (two) { v1[j] = v1[j] - m1; q1 += (v1[j][0] * v1[j][0] + v1[j][1] * v1[j][1]) + (v1[j][2] * v1[j][2] + v1[j][3] * v1[j][3]); } }
    q0 = wave_sum(q0); q1 = wave_sum(q1);
    r0 = 1.0f / sqrtf(q0 * (1.0f / DM) + LN_EPS); r1 = 1.0f / sqrtf(q1 * (1.0f / DM) + LN_EPS);
}
__device__ __forceinline__ void ln_finish_row(const Ctx& F, f32x4 (&v)[8], float rstd, int row, float* Xo32, xh* Xo, bf16* H, const f32x4 (&gv)[8], const f32x4 (&bv)[8], const float* shL, const float* scL, const float* shC, const float* scC) {
    const float* sh = row < SEQ ? shL : shC; const float* sc = row < SEQ ? scL : scC;
#pragma unroll
    for (int j = 0; j < 8; ++j) { const int col = 4 * F.lane + 256 * j; const f32x4 y = v[j] * rstd * gv[j] + bv[j];
        if (Xo32) *(GAS f32x4*)(Xo32 + (size_t)row * DM + col) = y; else xst4(Xo + (size_t)row * DM + col, y);
        if (H) { const f32x4 s4 = *(const GAS f32x4*)(sc + col), h4 = *(const GAS f32x4*)(sh + col); const f32x4 h = y * (s4 + 1.0f) + h4;
            v2u o; o.x = pk2(h[0], h[1]); o.y = pk2(h[2], h[3]); *(GAS v2u*)(H + (size_t)row * DM + col) = o; } }
}
template <int NP>
__device__ __forceinline__ void ln_ctx_row_wg(const Ctx& F, int row, xh* Xo, bf16* H, const float* g, const float* b, const float* shC, const float* scC, const xh* Xin, const bf16* parts, const float* gate_ctx, float gmul) {
    LAS float* red = (LAS float*)(F.lds + RING_OFF);
    const int col = 256 * F.wave + 4 * F.lane;
    const bf16* pp0 = parts + (size_t)(row - SEQ) * DM + col;
    v2u t[NP];
#pragma unroll
    for (int ch = 0; ch < NP; ++ch) t[ch] = *(const GAS v2u*)(pp0 + (size_t)ch * 256 * DM);
    const f32x4 x = xld4(Xin + (size_t)row * DM + col), gt = *(const GAS f32x4*)(gate_ctx + col);
    f32x4 a = {0.f, 0.f, 0.f, 0.f};
#pragma unroll
    for (int ch = 0; ch < NP; ++ch) a += bf4(t[ch]);
    f32x4 v = x * ALPHA + a * (gt * gmul);
    const float s = wave_sum((v[0] + v[1]) + (v[2] + v[3]));
    if (F.lane == 0) red[F.wave] = s;
    __syncthreads();
    const float mean = (((red[0] + red[1]) + (red[2] + red[3])) + ((red[4] + red[5]) + (red[6] + red[7]))) * (1.0f / DM);
    v = v - mean;
    const float q = wave_sum((v[0] * v[0] + v[1] * v[1]) + (v[2] * v[2] + v[3] * v[3]));
    if (F.lane == 0) red[8 + F.wave] = q;
    __syncthreads();
    const float rstd = 1.0f / sqrtf((((red[8] + red[9]) + (red[10] + red[11])) + ((red[12] + red[13]) + (red[14] + red[15]))) * (1.0f / DM) + LN_EPS);
    const f32x4 y = v * rstd * *(const GAS f32x4*)(g + col) + *(const GAS f32x4*)(b + col);
    xst4(Xo + (size_t)row * DM + col, y);
    if (H) { const f32x4 s4 = *(const GAS f32x4*)(scC + col), h4 = *(const GAS f32x4*)(shC + col); const f32x4 h = y * (s4 + 1.0f) + h4;
        v2u o; o.x = pk2(h[0], h[1]); o.y = pk2(h[2], h[3]); *(GAS v2u*)(H + (size_t)row * DM + col) = o; }
    __syncthreads();
}
__device__ __forceinline__ void ln_raw_load(const Ctx& F, f32x4 (&xr)[8], v2u (&dr)[8], int row, const bf16* Dl, const xh* Xin) {
#pragma unroll
    for (int j = 0; j < 8; ++j) { const int col = 4 * F.lane + 256 * j; xr[j] = xld4(Xin + (size_t)row * DM + col); dr[j] = *(const GAS v2u*)(Dl + (size_t)row * DM + col); }
}
__device__ __forceinline__ void ln_phase(const Ctx& F, const bf16* Dl, float* Xo32, xh* Xo, bf16* H, const float* g, const float* b, const float* shL, const float* scL, const float* shC, const float* scC, int nrows,
                                         const xh* Xin, const bf16* parts, int nparts, const float* gate_ctx, float gmul) {
    const int nlat = parts ? SEQ : nrows;
    int row = F.gw; int row1 = row + F.NGW; bool two = row1 < nlat;
    f32x4 v0[8], v1[8]; v2u d0[8], d1[8];
    if (row < nlat) { ln_raw_load(F, v0, d0, row, Dl, Xin); if (two) ln_raw_load(F, v1, d1, row1, Dl, Xin); }
    if (parts) {
        for (int crow = SEQ + F.bx; crow < nrows; crow += F.G) { if (nparts == 22) ln_ctx_row_wg<22>(F, crow, Xo, H, g, b, shC, scC, Xin, parts, gate_ctx, gmul); else ln_ctx_row_wg<8>(F, crow, Xo, H, g, b, shC, scC, Xin, parts, gate_ctx, gmul); } }
    f32x4 gv[8], bv[8];
#pragma unroll
    for (int j = 0; j < 8; ++j) { const int col = 4 * F.lane + 256 * j; gv[j] = *(const GAS f32x4*)(g + col); bv[j] = *(const GAS f32x4*)(b + col); }
    while (row < nlat) {
#pragma unroll
        for (int j = 0; j < 8; ++j) { v0[j] = v0[j] * ALPHA + bf4(d0[j]); if (two) v1[j] = v1[j] * ALPHA + bf4(d1[j]); }
        float r0, r1; ln_stats2(v0, v1, two, r0, r1);
        ln_finish_row(F, v0, r0, row, Xo32, Xo, H, gv, bv, shL, scL, shC, scC);
        if (two) ln_finish_row(F, v1, r1, row1, Xo32, Xo, H, gv, bv, shL, scL, shC, scC);
        row += 2 * F.NGW; row1 = row + F.NGW; two = row1 < nlat;
        if (row < nlat) { ln_raw_load(F, v0, d0, row, Dl, Xin); if (two) ln_raw_load(F, v1, d1, row1, Dl, Xin); }
    }
}

__device__ __forceinline__ void attn_item_v1(const bf16* ZIN, bf16* YALL, const float* rpb, int tok, int head, LAS float* pb, int lane) {
    const bool isctx = tok >= SEQ;
    const int r = tok / GRID_W, c = tok % GRID_W;
    const int r0 = min(max(r - WIN_R / 2, 0), NROWS - WIN_R), c0 = min(max(c - WIN_C / 2, 0), GRID_W - WIN_C);
    const int nband = isctx ? 0 : WIN_R * WIN_C, nkeys = nband + CTX;
    const int sub = lane & 15, grp = lane >> 4;
    float q[8];
    { const v4u w = *(const GAS v4u*)(ZIN + (size_t)tok * DIN + ZQ + head * HD + 8 * sub);
      q[0] = pg8::bf_lo(w.x); q[1] = pg8::bf_hi(w.x); q[2] = pg8::bf_lo(w.y); q[3] = pg8::bf_hi(w.y); q[4] = pg8::bf_lo(w.z); q[5] = pg8::bf_hi(w.z); q[6] = pg8::bf_lo(w.w); q[7] = pg8::bf_hi(w.w); }
    const float scale = 0.08838834764831845f;
    for (int kk0 = 0; kk0 < nkeys; kk0 += 4) {
        const int kk = kk0 + grp; int ktok; float bias = 0.f;
        if (kk < nband) { const int i = kk >> 4, j = kk & 15; ktok = (r0 + i) * GRID_W + c0 + j; bias = rpb[(head * (2 * WIN_R - 1) + (r0 + i - r + WIN_R - 1)) * (2 * WIN_C - 1) + (c0 + j - c + WIN_C - 1)]; }
        else ktok = SEQ + (kk - nband);
        const v4u w = *(const GAS v4u*)(ZIN + (size_t)ktok * DIN + ZK + head * HD + 8 * sub);
        float d = q[0] * pg8::bf_lo(w.x) + q[1] * pg8::bf_hi(w.x) + q[2] * pg8::bf_lo(w.y) + q[3] * pg8::bf_hi(w.y) + q[4] * pg8::bf_lo(w.z) + q[5] * pg8::bf_hi(w.z) + q[6] * pg8::bf_lo(w.w) + q[7] * pg8::bf_hi(w.w);
        d += __shfl_xor(d, 1); d += __shfl_xor(d, 2); d += __shfl_xor(d, 4); d += __shfl_xor(d, 8);
        if (sub == 0) pb[kk] = d * scale + bias;
    }
    LDS_WAIT(); asm volatile("" ::: "memory");
    float mx = -3.0e38f;
    for (int kk = lane; kk < nkeys; kk += 64) mx = fmaxf(mx, pb[kk]);
    mx = wave_max(mx);
    float sum = 0.f;
    for (int kk = lane; kk < nkeys; kk += 64) { const float e = __expf(pb[kk] - mx); pb[kk] = e; sum += e; }
    sum = wave_sum(sum);
    LDS_WAIT(); asm volatile("" ::: "memory");
    float o0 = 0.f, o1 = 0.f;
#pragma unroll 8
    for (int kk = 0; kk < nkeys; ++kk) {
        int ktok; if (kk < nband) { const int i = kk >> 4, j = kk & 15; ktok = (r0 + i) * GRID_W + c0 + j; } else ktok = SEQ + (kk - nband);
        const unsigned vw = *(const GAS unsigned*)(ZIN + (size_t)ktok * DIN + ZV + head * HD + 2 * lane); const float p = pb[kk];
        o0 += p * pg8::bf_lo(vw); o1 += p * pg8::bf_hi(vw); }
    const float inv = 1.0f / sum;
    *(GAS unsigned*)(YALL + (size_t)tok * DM + YNA + head * HD + 2 * lane) = DIAG_ZERO_NA ? 0u : pk2(o0 * inv, o1 * inv);
    LDS_WAIT(); asm volatile("" ::: "memory");
}


__device__ __forceinline__ void vt_item(const bf16* ZIN, bf16* VT, int item, LAS bf16* scr, int lane) {
    const int t0 = (item >> 4) * 64, c0 = (item & 15) * 64;
#pragma unroll
    for (int i = 0; i < 8; ++i) { const int row = 8 * i + (lane >> 3); const v4u w = *(const GAS v4u*)(ZIN + (size_t)(t0 + row) * DIN + ZV + c0 + 8 * (lane & 7)); *(LAS v4u*)(scr + row * 72 + 8 * (lane & 7)) = w; }
    LDS_WAIT(); asm volatile("" ::: "memory");
#pragma unroll
    for (int i = 0; i < 8; ++i) { const int dd = 8 * i + (lane >> 3), ch = lane & 7; unsigned short e[8];
#pragma unroll
        for (int k = 0; k < 8; ++k) e[k] = scr[(8 * ch + k) * 72 + dd];
        v4u o; o.x = e[0] | ((unsigned)e[1] << 16); o.y = e[2] | ((unsigned)e[3] << 16); o.z = e[4] | ((unsigned)e[5] << 16); o.w = e[6] | ((unsigned)e[7] << 16);
        *(GAS v4u*)(VT + (size_t)(c0 + dd) * MTOT + t0 + 8 * ch) = o; }
    LDS_WAIT(); asm volatile("" ::: "memory");
}

__device__ __forceinline__ void attn_task_v2(const bf16* ZIN, const bf16* VT, bf16* YALL, const float* rpb, int tok0, int head, int lane) {
    const bool isctx = tok0 >= SEQ;
    const int qn = lane & 15, g = lane >> 4;
    const int r = tok0 >> 6, cq0 = tok0 & 63, c = cq0 + qn;
    const int r0 = min(max(r - WIN_R / 2, 0), NROWS - WIN_R), cb = min(max(cq0 - WIN_C / 2, 0), GRID_W - 32), c0 = min(max(c - WIN_C / 2, 0), GRID_W - WIN_C);
    const float C1 = 0.08838834764831845f * 1.4426950408889634f, LOG2E = 1.4426950408889634f;
    bf16x8 qf[4];
#pragma unroll
    for (int s = 0; s < 4; ++s) qf[s] = *(const GAS bf16x8*)(ZIN + (size_t)(tok0 + qn) * DIN + ZQ + head * HD + 32 * s + 8 * g);
    f32x4 o[8];
#pragma unroll
    for (int db = 0; db < 8; ++db) o[db] = (f32x4){0.f, 0.f, 0.f, 0.f};
    float m_run = -1.0e30f, l_run = 0.f;
    const float* rpbh = rpb + head * (2 * WIN_R - 1) * (2 * WIN_C - 1) + (r0 - r + WIN_R - 1) * (2 * WIN_C - 1);
    int bo[8]; unsigned okm = 0u;
#pragma unroll
    for (int i = 0; i < 8; ++i) { const int kc = cb + 8 * g + i; okm |= ((kc >= c0) && (kc < c0 + WIN_C)) ? (1u << i) : 0u; bo[i] = min(max(kc - c + WIN_C - 1, 0), 2 * WIN_C - 2); }
    const int km = lane & 15, kmo = 8 * (km >> 2) + (km & 3);
    bf16x8 kc0[4], kc1[4];
    { const int ksf = isctx ? 8 : 0; const int kb0 = ksf < 8 ? (r0 + ksf) * GRID_W + cb : SEQ + (ksf - 8) * 32;
      const bf16* kp0 = ZIN + (size_t)(kb0 + kmo) * DIN + ZK + head * HD + 8 * g;
#pragma unroll
      for (int s = 0; s < 4; ++s) { kc0[s] = *(const GAS bf16x8*)(kp0 + 32 * s); kc1[s] = *(const GAS bf16x8*)(kp0 + 4 * DIN + 32 * s); } }
    for (int ks = isctx ? 8 : 0; ks < 16; ++ks) {
        const bool band = ks < 8;
        const int kbase = band ? (r0 + ks) * GRID_W + cb : SEQ + (ks - 8) * 32;
        bf16x8 vf[8];
        { const bf16* vp = VT + (size_t)(head * HD + (lane & 15)) * MTOT + kbase + 8 * g;
#pragma unroll
          for (int db = 0; db < 8; ++db) vf[db] = *(const GAS bf16x8*)(vp + (size_t)(16 * db) * MTOT); }
        f32x4 s0 = {0.f, 0.f, 0.f, 0.f}, s1 = {0.f, 0.f, 0.f, 0.f};
#pragma unroll
        for (int s = 0; s < 4; ++s) { s0 = __builtin_amdgcn_mfma_f32_16x16x32_bf16(kc0[s], qf[s], s0, 0, 0, 0); s1 = __builtin_amdgcn_mfma_f32_16x16x32_bf16(kc1[s], qf[s], s1, 0, 0, 0); }
        if (ks + 1 < 16) { const int kn = ks + 1; const int kb1 = kn < 8 ? (r0 + kn) * GRID_W + cb : SEQ + (kn - 8) * 32;
            const bf16* kp0 = ZIN + (size_t)(kb1 + kmo) * DIN + ZK + head * HD + 8 * g;
#pragma unroll
            for (int s = 0; s < 4; ++s) { kc0[s] = *(const GAS bf16x8*)(kp0 + 32 * s); kc1[s] = *(const GAS bf16x8*)(kp0 + 4 * DIN + 32 * s); } }
        float sc[8];
        if (band) { const float* brow = rpbh + ks * (2 * WIN_C - 1);
#pragma unroll
            for (int i = 0; i < 8; ++i) { const float sv = (i < 4 ? s0[i & 3] : s1[i & 3]); sc[i] = ((okm >> i) & 1u) ? sv * C1 + brow[bo[i]] * LOG2E : -1.0e30f; } }
        else {
#pragma unroll
            for (int i = 0; i < 8; ++i) sc[i] = (i < 4 ? s0[i & 3] : s1[i & 3]) * C1; }
        float mx = fmaxf(fmaxf(fmaxf(sc[0], sc[1]), fmaxf(sc[2], sc[3])), fmaxf(fmaxf(sc[4], sc[5]), fmaxf(sc[6], sc[7])));
        mx = fmaxf(mx, __shfl_xor(mx, 16)); mx = fmaxf(mx, __shfl_xor(mx, 32));
        const bool resc = __any(mx > m_run + 6.0f);
        float alpha = 1.0f;
        if (resc) { const float m_new = fmaxf(m_run, mx); alpha = __builtin_amdgcn_exp2f(m_run - m_new); m_run = m_new; l_run *= alpha;
#pragma unroll
            for (int db = 0; db < 8; ++db) o[db] = o[db] * alpha; }
        float p[8], ps = 0.f;
#pragma unroll
        for (int i = 0; i < 8; ++i) { p[i] = __builtin_amdgcn_exp2f(sc[i] - m_run); ps += p[i]; }
        l_run += ps;
        u32x4p pfw; pfw.x = pkbf(p[0], p[1]); pfw.y = pkbf(p[2], p[3]); pfw.z = pkbf(p[4], p[5]); pfw.w = pkbf(p[6], p[7]);
        const bf16x8 pf = __builtin_bit_cast(bf16x8, pfw);
#pragma unroll
        for (int db = 0; db < 8; ++db) o[db] = __builtin_amdgcn_mfma_f32_16x16x32_bf16(vf[db], pf, o[db], 0, 0, 0);
    }
    float lt = l_run; lt += __shfl_xor(lt, 16); lt += __shfl_xor(lt, 32);
    const float inv = 1.0f / lt;
#pragma unroll
    for (int db = 0; db < 8; ++db) { v2u w; w.x = pkbf(o[db][0] * inv, o[db][1] * inv); w.y = pkbf(o[db][2] * inv, o[db][3] * inv);
        *(GAS v2u*)(YALL + (size_t)(tok0 + qn) * DM + YNA + head * HD + 16 * db + 4 * g) = w; }
}


__device__ __forceinline__ size_t fy2_idx(int k1, int grp, int cp, int n2) { return (size_t)((((k1 * 4 + grp) * (GRID_W / 4) + (n2 >> 2)) * FG + cp) * 4 + (n2 & 3)); }
__device__ __forceinline__ v4u pk8(const float (&v)[8]) { v4u o; o.x = pkbf(v[0], v[1]); o.y = pkbf(v[2], v[3]); o.z = pkbf(v[4], v[5]); o.w = pkbf(v[6], v[7]); return o; }
__device__ __forceinline__ void fourAB_item_v3(const Ctx& F0, const bf16* ZIN, unsigned* FY2, int nq, int grp, int cblk) {
    Ctx F = F0; asm volatile("" : "+v"(F.tid)); F.lane = F.tid & 63;
    LAS f32x2* tab = (LAS f32x2*)(F.lds + RING_OFF); LAS v4u* CwP = (LAS v4u*)(F.lds + RING_OFF + 1024); LAS v4u* SwP = CwP + 2048;
    LAS f32x2* twt = (LAS f32x2*)(F.lds + RING_OFF + 1024 + 65536);
    LAS unsigned* XB = (LAS unsigned*)(F.lds + RING_OFF + 1024);
    if (F.tid < 128) { float s, c; sincospif((float)F.tid * (1.0f / 64.0f), &s, &c); tab[F.tid] = (f32x2){c, s}; }
    { const int k1 = F.tid & 127, jj = F.tid >> 7; float s, c; sincospif((float)((4 * nq + jj) * k1) * (2.0f / (float)(NROWS * GRID_W)), &s, &c); twt[jj * 128 + k1] = (f32x2){c, s}; }
    __syncthreads();
#pragma unroll
    for (int q = 0; q < 4; ++q) { const int e = F.tid + 512 * q, ln = e & 63, ks = (e >> 6) & 3, kt = e >> 8; const int k1 = 16 * kt + (ln & 15), gg = ln >> 4; float cv[8], sv[8];
#pragma unroll
        for (int j = 0; j < 8; ++j) { const int n1 = 32 * ks + 16 * (j >> 2) + 4 * gg + (j & 3); const f32x2 t = tab[(k1 * n1) & 127]; cv[j] = t.x; sv[j] = t.y; }
        CwP[e] = pk8(cv); SwP[e] = pk8(sv); }
    const int lane = F.lane, g = lane >> 4, jw = F.wave & 3, n2 = 4 * nq + jw, cpl = 16 * (F.wave >> 2) + (lane & 15), cp = 32 * cblk + cpl;
    bf16x8 Bc[4], Bs[4];
#pragma unroll
    for (int s = 0; s < 4; ++s) { float cv[8], sv[8];
#pragma unroll
        for (int j = 0; j < 8; ++j) { const f32x2 t = tab[((32 * s + 8 * g + j) * cp) & 127]; cv[j] = t.x; sv[j] = t.y; }
        Bc[s] = __builtin_bit_cast(bf16x8, pk8(cv)); Bs[s] = __builtin_bit_cast(bf16x8, pk8(sv)); }
    __syncthreads();
    f32x4 Zc[8], Zs[8];
#pragma unroll
    for (int rt = 0; rt < 8; ++rt) { Zc[rt] = (f32x4){0.f, 0.f, 0.f, 0.f}; Zs[rt] = (f32x4){0.f, 0.f, 0.f, 0.f};
        const bf16* fp = ZIN + (size_t)((16 * rt + (lane & 15)) * GRID_W + n2) * DIN + ZF + grp * FG + 8 * g;
#pragma unroll
        for (int s = 0; s < 4; ++s) { const bf16x8 a = *(const GAS bf16x8*)(fp + 32 * s);
            Zc[rt] = __builtin_amdgcn_mfma_f32_16x16x32_bf16(a, Bc[s], Zc[rt], 0, 0, 0); Zs[rt] = __builtin_amdgcn_mfma_f32_16x16x32_bf16(a, Bs[s], Zs[rt], 0, 0, 0); }
        if (rt & 1) asm volatile("" ::: "memory"); }
    bf16x8 zc[4], zs[4], zn[4];
#pragma unroll
    for (int ks = 0; ks < 4; ++ks) { v4u a, b; a.x = pkbf(Zc[2 * ks][0], Zc[2 * ks][1]); a.y = pkbf(Zc[2 * ks][2], Zc[2 * ks][3]); a.z = pkbf(Zc[2 * ks + 1][0], Zc[2 * ks + 1][1]); a.w = pkbf(Zc[2 * ks + 1][2], Zc[2 * ks + 1][3]);
        b.x = pkbf(Zs[2 * ks][0], Zs[2 * ks][1]); b.y = pkbf(Zs[2 * ks][2], Zs[2 * ks][3]); b.z = pkbf(Zs[2 * ks + 1][0], Zs[2 * ks + 1][1]); b.w = pkbf(Zs[2 * ks + 1][2], Zs[2 * ks + 1][3]);
        zc[ks] = __builtin_bit_cast(bf16x8, a); zs[ks] = __builtin_bit_cast(bf16x8, b); v4u n = b ^ 0x80008000u; zn[ks] = __builtin_bit_cast(bf16x8, n); }
    unsigned ow[8][4];
#pragma unroll
    for (int kt = 0; kt < 8; ++kt) { f32x4 yr = {0.f, 0.f, 0.f, 0.f}, yi = {0.f, 0.f, 0.f, 0.f};
#pragma unroll
        for (int ks = 0; ks < 4; ++ks) { const bf16x8 aC = __builtin_bit_cast(bf16x8, CwP[(kt * 4 + ks) * 64 + lane]), aS = __builtin_bit_cast(bf16x8, SwP[(kt * 4 + ks) * 64 + lane]);
            yr = __builtin_amdgcn_mfma_f32_16x16x32_bf16(aC, zc[ks], yr, 0, 0, 0); yr = __builtin_amdgcn_mfma_f32_16x16x32_bf16(aS, zn[ks], yr, 0, 0, 0);
            yi = __builtin_amdgcn_mfma_f32_16x16x32_bf16(aC, zs[ks], yi, 0, 0, 0); yi = __builtin_amdgcn_mfma_f32_16x16x32_bf16(aS, zc[ks], yi, 0, 0, 0); }
#pragma unroll
        for (int rg = 0; rg < 4; ++rg) { const int k1 = 16 * kt + 4 * g + rg; const f32x2 tw = twt[jw * 128 + k1]; const float ct = tw.x, st = tw.y;
            const float a = yr[rg], b = -yi[rg];
            ow[kt][rg] = pkbf(a * ct + b * st, b * ct - a * st); } }
    __syncthreads();
#pragma unroll
    for (int kt = 0; kt < 8; ++kt)
#pragma unroll
        for (int rg = 0; rg < 4; ++rg) XB[((16 * kt + 4 * g + rg) * 32 + cpl) * 4 + jw] = ow[kt][rg];
    __syncthreads();
#pragma unroll
    for (int i = 0; i < 8; ++i) { const int s = F.tid + 512 * i, k1 = s >> 5, c2 = s & 31;
        *(GAS v4u*)(FY2 + fy2_idx(k1, grp, 32 * cblk + c2, 4 * nq)) = *(const LAS v4u*)(XB + 4 * s); }
    __syncthreads();
}
__device__ __forceinline__ void fourC_table_v2(const Ctx& F, LAS v4u* CS) {
    LAS f32x2* t64 = (LAS f32x2*)(CS + 1024);
    if (F.tid < 64) { float s, c; sincospif((float)F.tid * (1.0f / 32.0f), &s, &c); t64[F.tid] = (f32x2){c, s}; }
    __syncthreads();
#pragma unroll
    for (int q = 0; q < 2; ++q) { const int e = F.tid + 512 * q, ln = e & 63, nt = (e >> 6) & 3, ks = e >> 8; const int k2 = 16 * nt + (ln & 15), gg = ln >> 4; float v[8];
#pragma unroll
        for (int j = 0; j < 8; ++j) { const int k = 32 * ks + 8 * gg + j, n2v = k >> 1; const f32x2 t = t64[(n2v * k2) & 63]; v[j] = (k & 1) ? t.y : t.x; }
        CS[e] = pk8(v); }
}
__device__ __forceinline__ void fourC_item_v2(const unsigned* FY2, bf16* YALL, const LAS v4u* CS, int base, int N1, int k1, int grp, int cq, int lane) {
    const int g = lane >> 4; const float norm = 1.0f / sqrtf((float)(N1 * GRID_W * FG));
    f32x4 acc[2][4];
#pragma unroll
    for (int mt = 0; mt < 2; ++mt)
#pragma unroll
        for (int nt = 0; nt < 4; ++nt) acc[mt][nt] = (f32x4){0.f, 0.f, 0.f, 0.f};
#pragma unroll
    for (int ks = 0; ks < 4; ++ks) { bf16x8 bfr[4];
#pragma unroll
        for (int nt = 0; nt < 4; ++nt) bfr[nt] = __builtin_bit_cast(bf16x8, CS[(ks * 4 + nt) * 64 + lane]);
#pragma unroll
        for (int mt = 0; mt < 2; ++mt) { const int cp = 32 * cq + 16 * mt + (lane & 15);
            const bf16x8 a = *(const GAS bf16x8*)(FY2 + fy2_idx(k1, grp, cp, 16 * ks + 4 * g));
#pragma unroll
            for (int nt = 0; nt < 4; ++nt) acc[mt][nt] = __builtin_amdgcn_mfma_f32_16x16x32_bf16(a, bfr[nt], acc[mt][nt], 0, 0, 0); } }
#pragma unroll
    for (int mt = 0; mt < 2; ++mt)
#pragma unroll
        for (int nt = 0; nt < 4; ++nt) { const int k2 = 16 * nt + (lane & 15), cp0 = 32 * cq + 16 * mt + 4 * g; v2u w; w.x = pkbf(acc[mt][nt][0] * norm, acc[mt][nt][1] * norm); w.y = pkbf(acc[mt][nt][2] * norm, acc[mt][nt][3] * norm);
            *(GAS v2u*)(YALL + (size_t)(base + k1 + N1 * k2) * DM + YF + grp * FG + cp0) = w; }
}


constexpr int A3_KROW = 272, A3_VROW = 144, A3_KB = 64 * A3_KROW, A3_BUF = A3_KB + 128 * A3_VROW;
typedef short s16x4 __attribute__((ext_vector_type(4)));
__device__ __forceinline__ void attn_item_v3(const Ctx& F, const bf16* ZIN, bf16* YALL, const float* rpb, int qtok0, int head) {
    const bool isctx = qtok0 >= SEQ;
    const int lane = F.lane, qn = lane & 15, g = lane >> 4, tid = F.tid;
    const int tok0 = qtok0 + 16 * F.wave;
    const int r = tok0 >> 6, cq0 = tok0 & 63, c = cq0 + qn;
    const int r0w = min(max(r - WIN_R / 2, 0), NROWS - WIN_R), cb = min(max(cq0 - WIN_C / 2, 0), GRID_W - 32), c0 = min(max(c - WIN_C / 2, 0), GRID_W - WIN_C);
    const int rA = qtok0 >> 6, r0A = min(max(rA - WIN_R / 2, 0), NROWS - WIN_R), r0B = min(max(rA + 1 - WIN_R / 2, 0), NROWS - WIN_R);
    const int nband = isctx ? 0 : WIN_R + (r0B - r0A), nsteps = nband + CTX / 64;
    const float C1 = 0.08838834764831845f * 1.4426950408889634f, LOG2E = 1.4426950408889634f;
    LAS unsigned char* const lb = F.lds + RING_OFF;
    bf16x8 qf[4];
#pragma unroll
    for (int s = 0; s < 4; ++s) qf[s] = *(const GAS bf16x8*)(ZIN + (size_t)(tok0 + qn) * DIN + ZQ + head * HD + 32 * s + 8 * g);
    f32x4 o[8];
#pragma unroll
    for (int db = 0; db < 8; ++db) o[db] = (f32x4){0.f, 0.f, 0.f, 0.f};
    float m_run = -1.0e30f, l_run = 0.f;
    const float* rpbh = rpb + head * (2 * WIN_R - 1) * (2 * WIN_C - 1);
    LAS float* bl = (LAS float*)(lb + 2 * A3_BUF);
    if (tid < (2 * WIN_R - 1) * (2 * WIN_C - 1)) bl[tid] = rpbh[tid] * LOG2E;
    int bo[8]; unsigned okm = 0u;
#pragma unroll
    for (int i = 0; i < 8; ++i) { const int kc = cb + 8 * g + i; okm |= ((kc >= c0) && (kc < c0 + WIN_C)) ? (1u << i) : 0u; bo[i] = min(max(kc - c + WIN_C - 1, 0), 2 * WIN_C - 2); }
    v4u st[4];
    const bf16* kp0[2];
#pragma unroll
    for (int i = 0; i < 2; ++i) { const int ch = tid + 512 * i; kp0[i] = ZIN + (size_t)(ch >> 4) * DIN + ZK + head * HD + 8 * (ch & 15); }
#define A3_LOAD(s_) do { const int s__ = (s_); const int tb = s__ < nband ? (r0A + s__) * GRID_W : SEQ + 64 * (s__ - nband); const size_t toff = (size_t)tb * DIN; \
        _Pragma("unroll") for (int i = 0; i < 2; ++i) { st[i] = *(const GAS v4u*)(kp0[i] + toff); st[2 + i] = *(const GAS v4u*)(kp0[i] + toff + (ZV - ZK)); } } while (0)
#define A3_STORE(b_) do { LAS unsigned char* bb = lb + (b_) * A3_BUF; \
        _Pragma("unroll") for (int i = 0; i < 2; ++i) { const int ch = tid + 512 * i; *(LAS v4u*)(bb + (ch >> 4) * A3_KROW + 16 * (ch & 15)) = st[i]; { const int r_ = ch >> 4, c_ = ch & 15, sv_ = (r_ & 3) | (((r_ >> 3) & 1) << 2); *(LAS v4u*)(bb + A3_KB + r_ * 256 + ((((c_ >> 1) ^ sv_) << 5) | ((c_ & 1) << 4))) = st[2 + i]; } } } while (0)
    A3_LOAD(0); A3_STORE(0);
    __builtin_amdgcn_s_waitcnt(0x0F70);
    __syncthreads();
    if (nsteps > 1) A3_LOAD(1);
    const int km = lane & 15, kmo = 8 * (km >> 2) + (km & 3);
    for (int s = 0; s < nsteps; ++s) {
        if (s + 1 < nsteps) A3_STORE((s + 1) & 1);
        if (s + 2 < nsteps) A3_LOAD(s + 2);
        const LAS unsigned char* bb = lb + (s & 1) * A3_BUF;
        const bool band = s < nband; const int rb = r0A + s;
        const int nk = band ? ((rb >= r0w && rb < r0w + WIN_R) ? 1 : 0) : 2;
        for (int kq = 0; kq < nk; ++kq) {
            const int koff = band ? cb : 32 * kq;
            const LAS unsigned char* kp = bb + (koff + kmo) * A3_KROW + 16 * g;
            f32x4 s0 = {0.f, 0.f, 0.f, 0.f}, s1 = {0.f, 0.f, 0.f, 0.f};
#pragma unroll
            for (int sk = 0; sk < 4; ++sk) { const bf16x8 k0 = *(const LAS bf16x8*)(kp + 64 * sk), k1 = *(const LAS bf16x8*)(kp + 4 * A3_KROW + 64 * sk);
                s0 = __builtin_amdgcn_mfma_f32_16x16x32_bf16(k0, qf[sk], s0, 0, 0, 0); s1 = __builtin_amdgcn_mfma_f32_16x16x32_bf16(k1, qf[sk], s1, 0, 0, 0); }
            const int tq = (lane & 15) >> 2, tp = lane & 3, vsw = tq | ((((koff >> 3) + g) & 1) << 2);
            const LAS unsigned char* vb0 = bb + A3_KB + (koff + 8 * g + tq) * 256 + 8 * tp;
            bf16x8 vf[8];
#pragma unroll
            for (int db = 0; db < 8; ++db) { const int blk = (db ^ vsw) << 5;
                const s16x4 lo = __builtin_amdgcn_ds_read_tr16_b64_v4i16((LAS s16x4*)(vb0 + blk)), hi = __builtin_amdgcn_ds_read_tr16_b64_v4i16((LAS s16x4*)(vb0 + 4 * 256 + blk));
                vf[db] = (bf16x8){lo[0], lo[1], lo[2], lo[3], hi[0], hi[1], hi[2], hi[3]}; }
            float sc[8];
            if (band) { const LAS float* brow = bl + (rb - r + WIN_R - 1) * (2 * WIN_C - 1); float bv[8];
#pragma unroll
                for (int i = 0; i < 8; ++i) bv[i] = brow[bo[i]];
                asm volatile("" : "+v"(bv[0]), "+v"(bv[1]), "+v"(bv[2]), "+v"(bv[3]), "+v"(bv[4]), "+v"(bv[5]), "+v"(bv[6]), "+v"(bv[7]));
#pragma unroll
                for (int i = 0; i < 8; ++i) { const float sv = (i < 4 ? s0[i & 3] : s1[i & 3]); sc[i] = ((okm >> i) & 1u) ? sv * C1 + bv[i] : -1.0e30f; } }
            else {
#pragma unroll
                for (int i = 0; i < 8; ++i) sc[i] = (i < 4 ? s0[i & 3] : s1[i & 3]) * C1; }
            float mx = fmaxf(fmaxf(fmaxf(sc[0], sc[1]), fmaxf(sc[2], sc[3])), fmaxf(fmaxf(sc[4], sc[5]), fmaxf(sc[6], sc[7])));
            const bool resc = __any(mx > m_run + 6.0f);
            if (resc) { mx = fmaxf(mx, __shfl_xor(mx, 16)); mx = fmaxf(mx, __shfl_xor(mx, 32));
                const float m_new = fmaxf(m_run, mx); const float alpha = __builtin_amdgcn_exp2f(m_run - m_new); m_run = m_new; l_run *= alpha;
#pragma unroll
                for (int db = 0; db < 8; ++db) o[db] = o[db] * alpha; }
            float p[8], ps = 0.f;
#pragma unroll
            for (int i = 0; i < 8; ++i) { p[i] = __builtin_amdgcn_exp2f(sc[i] - m_run); ps += p[i]; }
            l_run += ps;
            u32x4p pfw; pfw.x = pkbf(p[0], p[1]); pfw.y = pkbf(p[2], p[3]); pfw.z = pkbf(p[4], p[5]); pfw.w = pkbf(p[6], p[7]);
            const bf16x8 pf = __builtin_bit_cast(bf16x8, pfw);
#pragma unroll
            for (int db = 0; db < 8; ++db) o[db] = __builtin_amdgcn_mfma_f32_16x16x32_bf16(vf[db], pf, o[db], 0, 0, 0);
        }
        __syncthreads();
    }
#undef A3_LOAD
#undef A3_STORE
    float lt = l_run; lt += __shfl_xor(lt, 16); lt += __shfl_xor(lt, 32);
    const float inv = 1.0f / lt;
#pragma unroll
    for (int db = 0; db < 8; ++db) { v2u w; w.x = pkbf(o[db][0] * inv, o[db][1] * inv); w.y = pkbf(o[db][2] * inv, o[db][3] * inv);
        *(GAS v2u*)(YALL + (size_t)(tok0 + qn) * DM + YNA + head * HD + 16 * db + 4 * g) = w; }
}

__device__ __forceinline__ void conv_item_v1(const Ctx& F, const bf16* ZIN, bf16* YALL, const float* wdw, const float* bdw, const float* lg, const float* lb, int base, int len, int t0) {
    LAS float* ut = (LAS float*)(F.lds + RING_OFF);
    const int ch = F.tid;
    { const int chunk = F.tid & 63, rsub = F.tid >> 6;
        v4u aw[4], gw[4];
#define CV_LOAD(slot_, ps_) do { const int rr_ = 8 * (ps_) + rsub, t_ = t0 - CONVW / 2 + rr_; aw[slot_] = (v4u){0u, 0u, 0u, 0u}; gw[slot_] = aw[slot_]; \
            if (rr_ < 32 + CONVW - 1 && t_ >= 0 && t_ < len) { const bf16* zp = ZIN + (size_t)(base + t_) * DIN + 8 * chunk; aw[slot_] = *(const GAS v4u*)(zp + ZA); gw[slot_] = *(const GAS v4u*)(zp + ZG); } } while (0)
#define CV_COMP(slot_, ps_) do { const int rr_ = 8 * (ps_) + rsub; \
            if (rr_ < 32 + CONVW - 1) { f32x4 u0, u1; const v4u A_ = aw[slot_], G_ = gw[slot_]; \
                u0[0] = pg8::bf_lo(A_.x) * sigm(pg8::bf_lo(G_.x)); u0[1] = pg8::bf_hi(A_.x) * sigm(pg8::bf_hi(G_.x)); u0[2] = pg8::bf_lo(A_.y) * sigm(pg8::bf_lo(G_.y)); u0[3] = pg8::bf_hi(A_.y) * sigm(pg8::bf_hi(G_.y)); \
                u1[0] = pg8::bf_lo(A_.z) * sigm(pg8::bf_lo(G_.z)); u1[1] = pg8::bf_hi(A_.z) * sigm(pg8::bf_hi(G_.z)); u1[2] = pg8::bf_lo(A_.w) * sigm(pg8::bf_lo(G_.w)); u1[3] = pg8::bf_hi(A_.w) * sigm(pg8::bf_hi(G_.w)); \
                *(LAS f32x4*)(ut + rr_ * DCONV + 8 * chunk) = u0; *(LAS f32x4*)(ut + rr_ * DCONV + 8 * chunk + 4) = u1; } } while (0)
        CV_LOAD(0, 0); CV_LOAD(1, 1); CV_LOAD(2, 2); CV_LOAD(3, 3);
#pragma unroll
        for (int s = 0; s < 8; ++s) { CV_COMP(s & 3, s); if (s + 4 < 8) CV_LOAD(s & 3, s + 4); asm volatile("" ::: "memory"); }
#undef CV_LOAD
#undef CV_COMP
    }
    float w[CONVW];
#pragma unroll
    for (int j = 0; j < CONVW; ++j) w[j] = wdw[j * DCONV + ch];
    const float bias = bdw[ch];
    __syncthreads();
    float y[32];
#pragma unroll
    for (int n = 0; n < 32; ++n) { float a = bias;
#pragma unroll
        for (int j = 0; j < CONVW; ++j) a += ut[(n + j) * DCONV + ch] * w[j];
        y[n] = a; }
    __syncthreads();
#pragma unroll
    for (int n = 0; n < 32; ++n) ut[n * DCONV + ch] = y[n];
    __syncthreads();
    { float v[4][8], s[4], q[4];
#pragma unroll
      for (int qn = 0; qn < 4; ++qn) { const int n = F.wave * 4 + qn; s[qn] = 0.f;
#pragma unroll
        for (int i = 0; i < 8; ++i) { v[qn][i] = ut[n * DCONV + F.lane + 64 * i]; s[qn] += v[qn][i]; } }
#pragma unroll
      for (int qn = 0; qn < 4; ++qn) s[qn] = wave_sum(s[qn]);
#pragma unroll
      for (int qn = 0; qn < 4; ++qn) { const float mean = s[qn] * (1.0f / DCONV); q[qn] = 0.f;
#pragma unroll
        for (int i = 0; i < 8; ++i) { v[qn][i] -= mean; q[qn] += v[qn][i] * v[qn][i]; } }
#pragma unroll
      for (int qn = 0; qn < 4; ++qn) q[qn] = wave_sum(q[qn]);
#pragma unroll
      for (int qn = 0; qn < 4; ++qn) { const int n = F.wave * 4 + qn; const float rstd = 1.0f / sqrtf(q[qn] * (1.0f / DCONV) + LN_EPS);
#pragma unroll
        for (int i = 0; i < 8; ++i) { const int c2 = F.lane + 64 * i; const float z = v[qn][i] * rstd * lg[c2] + lb[c2]; YALL[(size_t)(base + t0 + n) * DM + YC + c2] = DIAG_ZERO_C ? (bf16)0 : (bf16)f2bf(z * sigm(z)); } } }
    __syncthreads();
}

__device__ __forceinline__ void four_cs_table(const Ctx& F, LAS f32x2* cs) { if (F.tid < 128) { float s, c; sincospif((float)F.tid * (1.0f / 64.0f), &s, &c); cs[F.tid] = (f32x2){c, s}; } }
__device__ __forceinline__ void fourAB_ctx_v3(const Ctx& F, const bf16* ZIN, unsigned* FY2s, int nq, int grp) {
    constexpr int N1 = CTX / GRID_W;
    LAS f32x2* tab = (LAS f32x2*)(F.lds + RING_OFF);
    LAS f32x2* tw = (LAS f32x2*)(F.lds + RING_OFF + 1024);
    LAS unsigned char* fin = F.lds + RING_OFF + 2048;
    LAS unsigned* XO = (LAS unsigned*)(F.lds + RING_OFF + 8192);
    if (F.tid < 128) { float s, c; sincospif((float)F.tid * (1.0f / 64.0f), &s, &c); tab[F.tid] = (f32x2){c, s}; }
    else if (F.tid < 144) { const int e = F.tid - 128, jj = e >> 2, k1 = e & 3; float s, c; sincospif(2.0f * (float)((4 * nq + jj) * k1) / (float)(N1 * GRID_W), &s, &c); tw[e] = (f32x2){c, s}; }
    else if (F.tid >= 256) { const int e = F.tid - 256, r = e >> 4, chn = e & 15, jj = r >> 2, n1 = r & 3;
        *(LAS v4u*)(fin + r * 272 + 16 * chn) = *(const GAS v4u*)(ZIN + (size_t)(SEQ + n1 * GRID_W + 4 * nq + jj) * DIN + ZF + grp * FG + 8 * chn); }
    __syncthreads();
    const int lane = F.lane, g = lane >> 4, cp = 16 * F.wave + (lane & 15);
    f32x4 Zc = {0.f, 0.f, 0.f, 0.f}, Zs = {0.f, 0.f, 0.f, 0.f};
#pragma unroll
    for (int s = 0; s < 4; ++s) { float cv[8], sv[8];
#pragma unroll
        for (int j = 0; j < 8; ++j) { const f32x2 t = tab[((32 * s + 8 * g + j) * cp) & 127]; cv[j] = t.x; sv[j] = t.y; }
        const bf16x8 bc = __builtin_bit_cast(bf16x8, pk8(cv)), bs = __builtin_bit_cast(bf16x8, pk8(sv));
        const bf16x8 a = *(const LAS bf16x8*)(fin + (lane & 15) * 272 + 64 * s + 16 * g);
        Zc = __builtin_amdgcn_mfma_f32_16x16x32_bf16(a, bc, Zc, 0, 0, 0); Zs = __builtin_amdgcn_mfma_f32_16x16x32_bf16(a, bs, Zs, 0, 0, 0); }
#pragma unroll
    for (int k1 = 0; k1 < N1; ++k1) { float yr = 0.f, yi = 0.f;
#pragma unroll
        for (int n1 = 0; n1 < N1; ++n1) { const int m = (k1 * n1) & 3; const float c4 = (m == 0) ? 1.f : (m == 2 ? -1.f : 0.f), s4 = (m == 1) ? 1.f : (m == 3 ? -1.f : 0.f);
            const float a = Zc[n1], b = Zs[n1]; yr += c4 * a - s4 * b; yi -= c4 * b + s4 * a; }
        const f32x2 t = tw[g * 4 + k1]; const float ct = t.x, st = t.y;
        XO[(k1 * 128 + cp) * 4 + g] = pkbf(yr * ct + yi * st, yi * ct - yr * st); }
    __syncthreads();
    { const int k1 = F.tid >> 7, c2 = F.tid & 127; *(GAS v4u*)(FY2s + fy2_idx(k1, grp, c2, 4 * nq)) = *(const LAS v4u*)(XO + 4 * F.tid); }
    __syncthreads();
}
__device__ __forceinline__ void fourAB_ctx_v2(const Ctx& F, const bf16* ZIN, unsigned* FY2s, int nq, int grp, int half) {
    constexpr int N1 = CTX / GRID_W;
    LAS f32x2* cs = (LAS f32x2*)(F.lds + RING_OFF); LAS bf16* fin = (LAS bf16*)(F.lds + RING_OFF + 1024);
    LAS float* Fc = (LAS float*)(F.lds + RING_OFF + 1024 + 4096); LAS float* Fs = Fc + 1024;
    LAS unsigned* XO = (LAS unsigned*)(F.lds + RING_OFF + 1024 + 3 * 4096);
    four_cs_table(F, cs);
#pragma unroll
    for (int i = 0; i < 4; ++i) { const int idx = F.tid + 512 * i, jj = idx >> 9, n1 = (idx >> 7) & 3, c = idx & 127; fin[idx] = ZIN[(size_t)(SEQ + n1 * GRID_W + 4 * nq + jj) * DIN + ZF + grp * FG + c]; }
    __syncthreads();
    const int cpp = F.tid & 63, h2 = (F.tid >> 6) & 1, j = F.tid >> 7, cp = half * 64 + cpp, n2 = 4 * nq + j;
#pragma unroll
    for (int u = 0; u < 2; ++u) { const int n1 = 2 * h2 + u; float fc = 0.f, fs = 0.f;
        for (int c = 0; c < 128; ++c) { const float x = bf2f(fin[(j * 4 + n1) * 128 + c]); const f32x2 t = cs[(c * cp) & 127]; fc += x * t.x; fs += x * t.y; }
        Fc[(j * 4 + n1) * 64 + cpp] = fc; Fs[(j * 4 + n1) * 64 + cpp] = fs; }
    __syncthreads();
    const int tstep = 128 / N1;
#pragma unroll
    for (int u = 0; u < 2; ++u) { const int k1 = 2 * h2 + u; float yr = 0.f, yi = 0.f;
#pragma unroll
        for (int n1 = 0; n1 < N1; ++n1) { const f32x2 t = cs[((k1 * n1) & (N1 - 1)) * tstep]; const float a = Fc[(j * 4 + n1) * 64 + cpp], b = Fs[(j * 4 + n1) * 64 + cpp]; yr += t.x * a - t.y * b; yi -= t.x * b + t.y * a; }
        float st, ct; sincospif(2.0f * (float)(n2 * k1) / (float)(N1 * GRID_W), &st, &ct);
        XO[(k1 * 64 + cpp) * 4 + j] = pkbf(yr * ct + yi * st, yi * ct - yr * st); }
    __syncthreads();
    if (F.tid < 256) { const int k1 = F.tid >> 6, c2 = F.tid & 63; *(GAS v4u*)(FY2s + fy2_idx(k1, grp, half * 64 + c2, 4 * nq)) = *(const LAS v4u*)(XO + 4 * F.tid); }
    __syncthreads();
}
__device__ __forceinline__ void fourC_item_v1(const Ctx& F, const float* FY, bf16* YALL, int base, int N1, int k1, int grp) {
    LAS f32x2* cs = (LAS f32x2*)(F.lds + RING_OFF); LAS f32x2* Yt = (LAS f32x2*)(F.lds + RING_OFF + 1024);
    four_cs_table(F, cs);
    for (int idx = F.tid; idx < 64 * 128; idx += 512) { const int n2 = idx >> 7, cp = idx & 127; Yt[idx] = *(const GAS f32x2*)(FY + ((size_t)(base + k1 * GRID_W + n2) * DFOUR + grp * FG + cp) * 2); }
    __syncthreads();
    const int cp = F.tid & 127, kg = F.tid >> 7; const float norm = 1.0f / sqrtf((float)(N1 * GRID_W * FG));
    for (int k2 = kg; k2 < 64; k2 += 4) { float a = 0.f;
        for (int n2 = 0; n2 < 64; ++n2) { const f32x2 t = cs[((n2 * k2) & 63) * 2]; const f32x2 y = Yt[n2 * 128 + cp]; a += t.x * y.x + t.y * y.y; }
        YALL[(size_t)(base + k1 + N1 * k2) * DM + YF + grp * FG + cp] = (bf16)f2bf(a * norm); }
    __syncthreads();
}

#if MK_DIAG
constexpr int CW_DIAG = 64;
__device__ __forceinline__ unsigned dg_hash(unsigned x) { x ^= x >> 16; x *= 0x7feb352du; x ^= x >> 15; x *= 0x846ca68bu; x ^= x >> 16; return x; }
__device__ __forceinline__ void dg_fail(unsigned char* ws, int id) { atomicMax((unsigned*)(ws + WS_CTL) + CW_DIAG, (unsigned)(200 - id)); }
__device__ __forceinline__ bool dg_bad(float got, float exp, float rel, float ab) { return !(fabsf(got - exp) <= ab + rel * fabsf(exp)); }
__device__ __forceinline__ float dg_dot(const bf16* a, const bf16* b, int K, int lane) { float s = 0.f; for (int k = lane; k < K; k += 64) s += bf2f(a[k]) * bf2f(b[k]); return wave_sum(s); }

__global__ void __launch_bounds__(256) dg_gemm(Args a, int mode, int l, int f, int nrows, int id, float gmul, int gi) {
    unsigned char* ws = a.ws; unsigned char* wl = ws + WS_W + (size_t)l * WL_SIZE; const int lane = threadIdx.x & 63;
    const int smp = blockIdx.x * 4 + (threadIdx.x >> 6);
    const unsigned h1 = dg_hash(smp * 2 + 1 + 7919u * id), h2 = dg_hash(smp * 2 + 2 + 104729u * id);
    const int row = h1 % nrows;
    const bf16* H = (const bf16*)(ws + WS_H); const bf16* G = (const bf16*)(ws + WS_G); const bf16* YALL = (const bf16*)(ws + WS_YALL); const bf16* MB = (const bf16*)(ws + WS_MB); const bf16* GATES = (const bf16*)(ws + WS_GATES);
    if (mode == 0) { const int c = h2 % DFF; const bf16* W = (const bf16*)(wl + (f == 0 ? WL_W13A : WL_W13B));
        const float av = dg_dot(H + (size_t)row * DM, W + (size_t)((c / 128) * 256 + c % 128) * DM, DM, lane), bv = dg_dot(H + (size_t)row * DM, W + (size_t)((c / 128) * 256 + 128 + c % 128) * DM, DM, lane);
        const float exp = av * sigm(av) * bv, got = bf2f(G[(size_t)row * DFF + c]);
        if (lane == 0 && dg_bad(got, exp, 1e-2f, 2e-3f)) dg_fail(ws, id); }
    else if (mode == 1) { const int c = h2 % DM; float d;
        if (gi == 5 && gmul == 1.0f) d = dg_dot(MB + (size_t)row * DM, (const bf16*)(wl + WL_WO) + (size_t)c * DM, DM, lane);
        else d = dg_dot(G + (size_t)row * DFF, (const bf16*)(wl + (f == 0 ? WL_W2A : WL_W2B)) + (size_t)c * DFF, DFF, lane);
        const float gate = mod_vec(ws, l, row >= SEQ ? 1 : 0, gi)[c];
        const float exp = gmul * gate * d, got = bf2f(((const bf16*)(ws + WS_T))[(size_t)row * DM + c]);
        if (lane == 0 && dg_bad(got, exp, 1e-2f, 1e-3f)) dg_fail(ws, id); }
    else if (mode == 2) { const int c = h2 % DIN;
        const float exp = dg_dot(H + (size_t)row * DM, (const bf16*)(wl + WL_WIN) + (size_t)c * DM, DM, lane), got = bf2f(((const bf16*)(ws + WS_ZIN))[(size_t)row * DIN + c]);
        if (lane == 0 && dg_bad(got, exp, 1e-2f, 2e-3f)) dg_fail(ws, id); }
    else if (mode == 3) { const int c = h2 % (3 * DM);
        const float pre = dg_dot(H + (size_t)row * DM, (const bf16*)(wl + WL_WG) + (size_t)c * DM, DM, lane) + a.in[I_BGATE][(size_t)l * 3 * DM + c];
        const float exp = sigm(pre), got = bf2f(GATES[(size_t)row * 3 * DM + c]);
        if (lane == 0 && dg_bad(got, exp, 1e-2f, 2e-3f)) { dg_fail(ws, id); unsigned* D = (unsigned*)(ws + WS_CTL) + CW_DIAG; atomicAdd(D + 2, 1u);
            const float bias = a.in[I_BGATE][(size_t)l * 3 * DM + c]; int hyp = 4;
            if (!dg_bad(got, sigm(pre - bias), 1e-2f, 2e-3f)) hyp = 1; else if (!dg_bad(got, pre, 1e-2f, 2e-3f)) hyp = 2; else if (got == 0.5f || got < 1e-6f) hyp = 3;
            atomicAdd(D + 4 + hyp, 1u); atomicMax(D + 10, (unsigned)(100 - row / 256)); } }
    else { const int c = h2 % DM; const bf16* W = (const bf16*)(wl + WL_WB) + (size_t)c * DM; const bf16* y = YALL + (size_t)row * DM;
        const float p0 = dg_dot(y, W, DNA, lane), p1 = dg_dot(y + DNA, W + DNA, DFOUR, lane), p2 = dg_dot(y + DNA + DFOUR, W + DNA + DFOUR, DCONV, lane);
        const float g0 = bf2f(GATES[(size_t)row * 3 * DM + c]), g1 = bf2f(GATES[(size_t)row * 3 * DM + DM + c]), g2 = bf2f(GATES[(size_t)row * 3 * DM + 2 * DM + c]);
        const float exp = g0 * p0 + g1 * p1 + g2 * p2, got = bf2f(MB[(size_t)row * DM + c]);
        if (lane == 0 && dg_bad(got, exp, 1.5e-2f, 3e-3f)) dg_fail(ws, id); }
}
__global__ void __launch_bounds__(256) dg_trans(Args a, int id, int l, unsigned wmask) {
    unsigned char* ws = a.ws; const int t = blockIdx.x * 256 + threadIdx.x; const int which = (t >> 1) % 12; if (!((wmask >> which) & 1u)) return; const unsigned h1 = dg_hash(t * 3 + 1), h2 = dg_hash(t * 3 + 2);
    unsigned char* wl = ws + WS_W + (size_t)l * WL_SIZE; float src; bf16 got;
    if (which < 6) { const int ff = which / 3, w = which % 3;
        if (w < 2) { const int k = h1 % DM, n = h2 % DFF; src = a.in[(ff ? I_F2W1 : I_F1W1) + w][(size_t)l * DM * DFF + (size_t)k * DFF + n]; got = ((const bf16*)(wl + (ff ? WL_W13B : WL_W13A)))[(size_t)((n / 128) * 256 + w * 128 + n % 128) * DM + k]; }
        else { const int k = h1 % DFF, n = h2 % DM; src = a.in[ff ? I_F2W2 : I_F1W2][(size_t)l * DFF * DM + (size_t)k * DM + n]; got = ((const bf16*)(wl + (ff ? WL_W2B : WL_W2A)))[(size_t)n * DFF + k]; } }
    else if (which == 6) { const int k = h1 % DM, n = h2 % DIN; src = a.in[I_WIN][(size_t)l * DM * DIN + (size_t)k * DIN + n]; got = ((const bf16*)(wl + WL_WIN))[(size_t)n * DM + k]; }
    else if (which == 7) { const int k = h1 % DM, n = h2 % (3 * DM); src = a.in[I_WGATE][(size_t)l * DM * 3 * DM + (size_t)k * 3 * DM + n]; got = ((const bf16*)(wl + WL_WG))[(size_t)n * DM + k]; }
    else if (which == 8) { const int k = h1 % DNA, n = h2 % DM; src = a.in[I_WBNA][(size_t)l * DNA * DM + (size_t)k * DM + n]; got = ((const bf16*)(wl + WL_WB))[(size_t)n * DM + k]; }
    else if (which == 9) { const int k = h1 % DFOUR, n = h2 % DM; src = a.in[I_WBF][(size_t)l * DFOUR * DM + (size_t)k * DM + n]; got = ((const bf16*)(wl + WL_WB))[(size_t)n * DM + DNA + k]; }
    else if (which == 10) { const int k = h1 % DCONV, n = h2 % DM; src = a.in[I_WBC][(size_t)l * DCONV * DM + (size_t)k * DM + n]; got = ((const bf16*)(wl + WL_WB))[(size_t)n * DM + DNA + DFOUR + k]; }
    else { const int k = h1 % DM, n = h2 % DM; src = a.in[I_WO][(size_t)l * DM * DM + (size_t)k * DM + n]; got = ((const bf16*)(wl + WL_WO))[(size_t)n * DM + k]; }
    if (got != (bf16)f2bf(src)) dg_fail(ws, id);
}
__global__ void __launch_bounds__(256) dg_mod(Args a, int id) {
    unsigned char* ws = a.ws; const int lane = threadIdx.x & 63; const int smp = blockIdx.x * 4 + (threadIdx.x >> 6);
    const int l = smp & 1, s = (smp >> 1) & 1, j = dg_hash(smp) % (NMODU * DM);
    const float* cv = s ? a.in[I_CCTX] : a.in[I_C]; float acc = 0.f;
    for (int k = lane; k < DM; k += 64) { const float c = cv[k]; acc += c * sigm(c) * a.in[I_WADA][(size_t)l * DM * ADA_N + (size_t)k * ADA_N + j]; }
    acc = wave_sum(acc) + a.in[I_BADA][(size_t)l * ADA_N + j];
    const float got = ((const float*)(ws + WS_MOD))[(size_t)(l * 2 + s) * (NMODU * DM) + j];
    if (lane == 0 && dg_bad(got, acc, 1e-4f, 1e-4f)) dg_fail(ws, id);
    const int row = dg_hash(smp + 77777u) % MTOT, col = dg_hash(smp + 99991u) % DM; const int sx = row >= SEQ;
    const float xv = sx ? a.in[I_CTX][(size_t)(row - SEQ) * DM + col] : a.in[I_X][(size_t)row * DM + col];
    const float sh = mod_vec(ws, 0, sx, 0)[col], sc = mod_vec(ws, 0, sx, 1)[col];
    if (lane == 0 && (dg_bad((float)((const xh*)(ws + WS_X))[(size_t)row * DM + col], xv, 1e-3f, 1e-4f) || dg_bad(bf2f(((const bf16*)(ws + WS_H))[(size_t)row * DM + col]), xv * (1.f + sc) + sh, 1e-2f, 1e-3f))) dg_fail(ws, id + 1);
}
__global__ void __launch_bounds__(256) dg_ln(Args a, int l, int which, int nrows, int final_out, int id) {
    unsigned char* ws = a.ws; const int lane = threadIdx.x & 63; const int smp = blockIdx.x * 4 + (threadIdx.x >> 6); const int row = dg_hash(smp + 31u * id) % nrows;
    const float* Xo32 = a.out + (size_t)row * DM; const xh* Xo16 = (const xh*)(ws + WS_X) + (size_t)row * DM;
#define Xo(k_) (final_out ? Xo32[k_] : (float)Xo16[k_])
    const float* lg = a.in[I_LNG] + (size_t)(l * 3 + which) * DM; const float* lb = a.in[I_LNB] + (size_t)(l * 3 + which) * DM;
    float s = 0.f, q = 0.f;
    for (int k = lane; k < DM; k += 64) { const float z = (Xo(k) - lb[k]) / lg[k]; s += z; q += z * z; }
    s = wave_sum(s) / DM; q = wave_sum(q) / DM; bool bad = fabsf(s) > 1e-3f || fabsf(q - 1.0f) > 1e-2f;
    const int ml = which == 2 ? l + 1 : l, mi = which == 2 ? 0 : 3, sx = row >= SEQ;
    if (!final_out) for (int k = lane; k < DM; k += 64) { const float h = Xo(k) * (1.f + mod_vec(ws, ml, sx, mi + 1)[k]) + mod_vec(ws, ml, sx, mi)[k]; bad |= dg_bad(bf2f(((const bf16*)(ws + WS_H))[(size_t)row * DM + k]), h, 1e-2f, 2e-3f); }
    if (bad) dg_fail(ws, id);
#undef Xo
}
__global__ void __launch_bounds__(256) dg_attn(Args a, int l, int ntok, int id) {
    __shared__ float P[4][384];
    unsigned char* ws = a.ws; const int lane = threadIdx.x & 63, wv = threadIdx.x >> 6; const int smp = blockIdx.x * 4 + wv;
    const int tok = dg_hash(smp * 2 + 5u) % ntok, head = dg_hash(smp * 2 + 6u) % NH; const bf16* Z = (const bf16*)(ws + WS_ZIN);
    const float* rpb = a.in[I_RPB] + (size_t)l * NH * 15 * 31;
    const int r = tok / 64, c = tok % 64, r0 = min(max(r - 4, 0), 120), c0 = min(max(c - 8, 0), 48); const bool cx = tok >= SEQ; const int nk = cx ? 256 : 384;
    float mx = -1e30f;
    for (int kk = lane; kk < nk; kk += 64) { int kt; float bias = 0.f;
        if (!cx && kk < 128) { const int kr = r0 + kk / 16, kc = c0 + kk % 16; kt = kr * 64 + kc; bias = rpb[(head * 15 + (kr - r + 7)) * 31 + (kc - c + 15)]; } else kt = SEQ + (cx ? kk : kk - 128);
        float d = 0.f; for (int e = 0; e < 128; ++e) d += bf2f(Z[(size_t)tok * DIN + head * 128 + e]) * bf2f(Z[(size_t)kt * DIN + 1024 + head * 128 + e]);
        d = d * 0.08838834764831845f + bias; P[wv][kk] = d; mx = fmaxf(mx, d); }
    mx = wave_max(mx); float sum = 0.f;
    for (int kk = lane; kk < nk; kk += 64) { const float e = expf(P[wv][kk] - mx); P[wv][kk] = e; sum += e; }
    sum = wave_sum(sum); __syncthreads(); bool bad = false;
    for (int d = lane; d < 128; d += 64) { float o = 0.f;
        for (int kk = 0; kk < nk; ++kk) { int kt; if (!cx && kk < 128) kt = (r0 + kk / 16) * 64 + c0 + kk % 16; else kt = SEQ + (cx ? kk : kk - 128); o += P[wv][kk] * bf2f(Z[(size_t)kt * DIN + 2048 + head * 128 + d]); }
        o /= sum; bad |= dg_bad(bf2f(((const bf16*)(ws + WS_YALL))[(size_t)tok * DM + head * 128 + d]), o, 1e-2f, 2e-3f); }
    if (bad) dg_fail(ws, id);
}
__global__ void __launch_bounds__(256) dg_conv(Args a, int l, int ntok, int id) {
    unsigned char* ws = a.ws; const int lane = threadIdx.x & 63; const int smp = blockIdx.x * 4 + (threadIdx.x >> 6); const int tok = dg_hash(smp + 1234567u) % ntok;
    const bf16* Z = (const bf16*)(ws + WS_ZIN); const int base = tok >= SEQ ? SEQ : 0, len = tok >= SEQ ? CTX : SEQ, t = tok - base;
    float y[8]; float s = 0.f;
#pragma unroll
    for (int i = 0; i < 8; ++i) { const int ch = lane + 64 * i; float acc = a.in[I_BDW][l * DCONV + ch];
        for (int j = 0; j < CONVW; ++j) { const int tt = t + j - 15; if (tt >= 0 && tt < len) { const float av = bf2f(Z[(size_t)(base + tt) * DIN + 3584 + ch]), gv = bf2f(Z[(size_t)(base + tt) * DIN + 4096 + ch]); acc += av * sigm(gv) * a.in[I_WDW][(size_t)l * CONVW * DCONV + j * DCONV + ch]; } }
        y[i] = acc; s += acc; }
    const float mean = wave_sum(s) / DCONV; float q = 0.f;
#pragma unroll
    for (int i = 0; i < 8; ++i) { const float d = y[i] - mean; q += d * d; }
    const float rstd = 1.0f / sqrtf(wave_sum(q) / DCONV + LN_EPS); bool bad = false;
#pragma unroll
    for (int i = 0; i < 8; ++i) { const int ch = lane + 64 * i; const float z = (y[i] - mean) * rstd * a.in[I_CLNG][l * DCONV + ch] + a.in[I_CLNB][l * DCONV + ch];
        bad |= dg_bad(bf2f(((const bf16*)(ws + WS_YALL))[(size_t)tok * DM + 1536 + ch]), z * sigm(z), 1e-2f, 3e-3f); }
    if (bad) dg_fail(ws, id);
}
__global__ void __launch_bounds__(256) dg_four(Args a, int ntok, int id) {
    unsigned char* ws = a.ws; const int lane = threadIdx.x & 63; const int smp = blockIdx.x * 4 + (threadIdx.x >> 6);
    const int tok = smp == 0 ? 0 : (int)(dg_hash(smp + 424242u) % ntok), col = dg_hash(smp + 31337u) % DFOUR; const int grp = col / 128, cp = col % 128;
    const int base = tok >= SEQ ? SEQ : 0, N = tok >= SEQ ? CTX : SEQ, k = tok - base; const bf16* Z = (const bf16*)(ws + WS_ZIN);
    float acc = 0.f;
    for (int n = lane; n < N; n += 64) { const int pn = (int)(((long)n * k) % N);
        for (int c = 0; c < 128; ++c) { const float ang = 2.0f * (float)pn / (float)N + 2.0f * (float)((c * cp) & 127) / 128.0f; acc += bf2f(Z[(size_t)(base + n) * DIN + 3072 + grp * 128 + c]) * cospif(ang); } }
    acc = wave_sum(acc) / sqrtf((float)N * 128.f);
    const float gotf = bf2f(((const bf16*)(ws + WS_YALL))[(size_t)tok * DM + 1024 + col]);
    if (lane == 0 && dg_bad(gotf, acc, 2e-2f, 1e-2f)) dg_fail(ws, id);
    if (lane == 0 && DIAG_PREC == 3 && tok != 0 && tok != SEQ) { float* D = (float*)((unsigned*)(ws + WS_CTL) + CW_DIAG + 8); atomicAdd(D, (gotf - acc) * (gotf - acc)); atomicAdd(D + 1, acc * acc); }
}

__global__ void __launch_bounds__(256) dg_prec_up(Args a) {
    unsigned char* ws = a.ws; const int lane = threadIdx.x & 63; const int smp = blockIdx.x * 4 + (threadIdx.x >> 6);
    const int row = dg_hash(smp * 2 + 11u) % SEQ, c = dg_hash(smp * 2 + 12u) % DFF;
    const float* x = a.in[I_X] + (size_t)row * DM; const float* sh = mod_vec(ws, 0, 0, 0); const float* sc = mod_vec(ws, 0, 0, 1);
    float av = 0.f, bv = 0.f;
    for (int k = lane; k < DM; k += 64) { const float h = x[k] * (1.f + sc[k]) + sh[k]; av += h * a.in[I_F1W1][(size_t)k * DFF + c]; bv += h * a.in[I_F1W3][(size_t)k * DFF + c]; }
    av = wave_sum(av); bv = wave_sum(bv);
    const float exp = av * sigm(av) * bv, got = bf2f(((const bf16*)(ws + WS_G))[(size_t)row * DFF + c]);
    if (lane == 0) { float* D = (float*)((unsigned*)(ws + WS_CTL) + CW_DIAG + 8); atomicAdd(D, (got - exp) * (got - exp)); atomicAdd(D + 1, exp * exp); }
}

__global__ void __launch_bounds__(256) dg_prec_dn(Args a) {
    __shared__ float red[256]; __shared__ float hs[DM];
    unsigned char* ws = a.ws; const int tid = threadIdx.x; const int smp = blockIdx.x;
    const int row = dg_hash(smp * 2 + 21u) % SEQ, c = dg_hash(smp * 2 + 22u) % DM;
    const float* x = a.in[I_X] + (size_t)row * DM; const float* sh = mod_vec(ws, 0, 0, 0); const float* sc = mod_vec(ws, 0, 0, 1);
    for (int k = tid; k < DM; k += 256) hs[k] = x[k] * (1.f + sc[k]) + sh[k];
    __syncthreads();
    float y = 0.f;
    for (int j = tid; j < DFF; j += 256) { float av = 0.f, bv = 0.f;
        for (int k = 0; k < DM; ++k) { const float h = hs[k]; av += h * a.in[I_F1W1][(size_t)k * DFF + j]; bv += h * a.in[I_F1W3][(size_t)k * DFF + j]; }
        y += av * sigm(av) * bv * a.in[I_F1W2][(size_t)j * DM + c]; }
    red[tid] = y; __syncthreads();
    for (int s = 128; s > 0; s >>= 1) { if (tid < s) red[tid] += red[tid + s]; __syncthreads(); }
    if (tid == 0) { const float exp = 0.5f * mod_vec(ws, 0, 0, 2)[c] * red[0], got = bf2f(((const bf16*)(ws + WS_T))[(size_t)row * DM + c]);
        float* D = (float*)((unsigned*)(ws + WS_CTL) + CW_DIAG + 8); atomicAdd(D, (got - exp) * (got - exp)); atomicAdd(D + 1, exp * exp); }
}

__global__ void __launch_bounds__(256) dg_prec_mix(Args a) {
    __shared__ float red[256]; __shared__ float hs[DM]; __shared__ float ms[DM];
    unsigned char* ws = a.ws; const int tid = threadIdx.x; const int smp = blockIdx.x;
    const int row = dg_hash(smp * 2 + 31u) % SEQ, c = dg_hash(smp * 2 + 32u) % DM;
    const xh* x = (const xh*)(ws + WS_X) + (size_t)row * DM; const float* sh = mod_vec(ws, 0, 0, 3); const float* sc = mod_vec(ws, 0, 0, 4);
    const bf16* y = (const bf16*)(ws + WS_YALL) + (size_t)row * DM;
    for (int k = tid; k < DM; k += 256) hs[k] = (float)x[k] * (1.f + sc[k]) + sh[k];
    __syncthreads();
    for (int i = tid; i < DM; i += 256) { float g[3];
        for (int b = 0; b < 3; ++b) { float pre = a.in[I_BGATE][b * DM + i]; for (int k = 0; k < DM; ++k) pre += hs[k] * a.in[I_WGATE][(size_t)k * 3 * DM + b * DM + i]; g[b] = sigm(pre); }
        float p0 = 0.f, p1 = 0.f, p2 = 0.f;
        for (int k = 0; k < DNA; ++k) p0 += bf2f(y[k]) * a.in[I_WBNA][(size_t)k * DM + i];
        for (int k = 0; k < DFOUR; ++k) p1 += bf2f(y[DNA + k]) * a.in[I_WBF][(size_t)k * DM + i];
        for (int k = 0; k < DCONV; ++k) p2 += bf2f(y[DNA + DFOUR + k]) * a.in[I_WBC][(size_t)k * DM + i];
        ms[i] = g[0] * p0 + g[1] * p1 + g[2] * p2; }
    __syncthreads();
    float o = 0.f; for (int i = tid; i < DM; i += 256) o += ms[i] * a.in[I_WO][(size_t)i * DM + c];
    red[tid] = o; __syncthreads();
    for (int s = 128; s > 0; s >>= 1) { if (tid < s) red[tid] += red[tid + s]; __syncthreads(); }
    if (tid == 0) { const float exp = mod_vec(ws, 0, 0, 5)[c] * red[0], got = bf2f(((const bf16*)(ws + WS_T))[(size_t)row * DM + c]);
        float* D = (float*)((unsigned*)(ws + WS_CTL) + CW_DIAG + 8); atomicAdd(D, (got - exp) * (got - exp)); atomicAdd(D + 1, exp * exp); }
}
__global__ void dg_final(Args a) { const unsigned* D = (const unsigned*)(a.ws + WS_CTL) + CW_DIAG; const unsigned d = D[0];
    const float* P = (const float*)(D + 8);
    if (P[1] > 0.f) { a.out[0] = 1000.0f * rintf(-10.0f * log10f(sqrtf(P[0] / P[1]))); return; }
    if (d) { float code = (float)(200 - (int)d);
        a.out[0] = 1000.0f * code; } }
#endif

#ifndef DIAG_SKIP_FC
#define DIAG_SKIP_FC 0
#endif
#ifndef PROBE_REPEAT_MASK
#define PROBE_REPEAT_MASK 0u
#endif
#define REPN(id) (1 + (int)(((PROBE_REPEAT_MASK) >> (id)) & 1u))
#ifndef PROBE_EXTRA_BARRIERS
#ifndef PROBE_MIXA
#define PROBE_MIXA 0
#endif
#define PROBE_EXTRA_BARRIERS 0
#endif
#ifndef PROBE_REPEAT_MIX
#define PROBE_REPEAT_MIX 0
#endif
#ifndef PH_MASK
#define PH_MASK 0xFFFFFFFFu
#endif
#define PH_ON(id) (((PH_MASK) >> (id)) & 1u)
constexpr int N_PHASES = 28;
constexpr int CTXK_DN = 22, CTXK_O = 8;
constexpr size_t FY2_CTX = (size_t)NROWS * 4 * FG * GRID_W;
__device__ __forceinline__ Ctx ctx_local(const Ctx& F) { Ctx L = F; L.lane = hw_lane(); L.tid = (F.wave << 6) | L.lane; return L; }

__device__ __forceinline__ void site_up(const Ctx& F, int l, int f, int nM) {
    const KAp ka = ka_opaque(); unsigned char* const ws = ka->ws; unsigned char* wl = ws + WS_W + (size_t)l * WL_SIZE;
    pg8::Gemm g{(const bf16*)(ws + WS_H), (const bf16*)(wl + (f == 0 ? WL_W13A : WL_W13B)), 0, 0, DM, DM}; pg8::StaticOrder S; S.init(nM, 2 * DFF / 256, F.G, F.bx, DM / 64);
    pg8::EpiSwiGLU E{(bf16*)(ws + WS_G), DFF};
    pg8::gemm_phase<pg8::EpiSwiGLU, pg8::StaticOrder, true, true>(F.lds + RING_OFF, g, S, E, F.wave);
    helper_convert(F, (nM * (2 * DFF / 256)) % F.G, l, w2_lo(f), TI_FF);
}
__device__ __forceinline__ void site_down(const Ctx& F, int l, int f, int nM) {
    const KAp ka = ka_opaque(); unsigned char* const ws = ka->ws; unsigned char* wl = ws + WS_W + (size_t)l * WL_SIZE;
    const int gi = f == 0 ? 2 : 5;
    const bf16* Gb = (const bf16*)(ws + WS_G); const bf16* W2 = (const bf16*)(wl + (f == 0 ? WL_W2A : WL_W2B));
    pg8::Gemm g{Gb, W2, 0, 0, DFF, DFF};
    pg8::OrderPlus S; S.base.init(32, DM / 256, F.G, F.bx, DFF / 64); S.ext.init((nM == 33) ? 1 : 0, DM / 256, F.G, F.bx, 0); S.chunks = CTXK_DN; S.ntc = DFF / 64 / CTXK_DN; S.pmx = 32;
    pg8::EpiDelta E{(bf16*)(ws + WS_T), DM, mod_vec(ws, l, 0, gi), mod_vec(ws, l, 1, gi), 0.5f, (long)((WS_PART - WS_T) / 2)};
    pg8::gemm_phase<pg8::EpiDelta, pg8::OrderPlus, true, true>(F.lds + RING_OFF, g, S, E, F.wave);
}
__device__ __forceinline__ void site_ln(const Ctx& F0, int l, int which, int nrows, bool final_out) {
    const Ctx F = ctx_local(F0);
    const KAp ka = ka_opaque(); unsigned char* const ws = ka->ws;
    const float* lg = ka->in[I_LNG] + (size_t)(l * 3 + which) * DM; const float* lb = ka->in[I_LNB] + (size_t)(l * 3 + which) * DM;
    const int ml = which == 2 ? l + 1 : l, mi = which == 2 ? 0 : 3;
    const int gi = which == 0 ? 2 : 5; const float gmul = which == 1 ? 1.0f : 0.5f; const int nparts = which == 1 ? CTXK_O : CTXK_DN;
    if (final_out) ln_phase(F, (const bf16*)(ws + WS_T), ka->out, nullptr, nullptr, lg, lb, nullptr, nullptr, nullptr, nullptr, nrows, (const xh*)(ws + WS_X), nullptr, 0, nullptr, 0.f);
    else ln_phase(F, (const bf16*)(ws + WS_T), nullptr, (xh*)(ws + WS_X), (bf16*)(ws + WS_H), lg, lb, mod_vec(ws, ml, 0, mi), mod_vec(ws, ml, 0, mi + 1), mod_vec(ws, ml, 1, mi), mod_vec(ws, ml, 1, mi + 1), nrows,
                  (const xh*)(ws + WS_X), nrows > SEQ ? (const bf16*)(ws + WS_PART) : nullptr, nparts, mod_vec(ws, l, 1, gi), gmul);
}
__device__ __forceinline__ void site_in(const Ctx& F, int l, bool last) {
    const KAp ka = ka_opaque(); unsigned char* const ws = ka->ws; unsigned char* wl = ws + WS_W + (size_t)l * WL_SIZE;
    const bf16* Hb = (const bf16*)(ws + WS_H);
    pg8::Gemm g{Hb, (const bf16*)(wl + WL_WIN), 0, (long)WL_WG - (long)WL_WIN, DM, DM};
    pg8::OrderPlus S; S.base.init(33, DIN / 256, F.G, F.bx, DM / 64); S.ext.init(last ? 0 : 1, 3 * DM / 256, F.G, F.bx, 0); S.chunks = 1; S.ntc = DM / 64; S.pmx = 32;
    pg8::EpiBf16<2> E{(bf16*)(ws + WS_ZIN), DIN, ka->in[I_BGATE] + (size_t)l * 3 * DM, (bf16*)(ws + WS_GATES), 3 * DM};
    pg8::gemm_phase<pg8::EpiBf16<2>, pg8::OrderPlus, true, true>(F.lds + RING_OFF, g, S, E, F.wave);
    { const int q0 = last ? 3 * TI_FF : 0; helper_convert(F, (33 * (DIN / 256) + (last ? 0 : 3 * DM / 256)) % F.G, 1, q0, 2 * TI_FF); }
}
__device__ __forceinline__ void site_mixA(const Ctx& F0, int l, bool last) {
    const Ctx F = ctx_local(F0);
    const KAp ka = ka_opaque(); unsigned char* const ws = ka->ws;
    const bf16* ZIN = (const bf16*)(ws + WS_ZIN); bf16* YALL = (bf16*)(ws + WS_YALL); unsigned* FY2 = (unsigned*)(ws + WS_FY);
    const int nFAB = last ? 256 : 320, nConv = last ? 256 : 264;
    const float* wdw = ka->in[I_WDW] + (size_t)l * CONVW * DCONV; const float* bdw = ka->in[I_BDW] + (size_t)l * DCONV;
    const float* clg = ka->in[I_CLNG] + (size_t)l * DCONV; const float* clb = ka->in[I_CLNB] + (size_t)l * DCONV;
    for (int it = F.bx; it < nFAB + nConv; it += F.G) {
      const int reps = 1 + ((PROBE_MIXA == 2 && it < 256) || (PROBE_MIXA == 3 && it >= 256 && it < nFAB) || (PROBE_MIXA == 4 && it >= nFAB) ? 3 : 0);
      for (int rep = 0; rep < reps; ++rep) {
        int r = it;
        if (r < nFAB) { if (r < 256) fourAB_item_v3(F, ZIN, FY2, r & 15, (r >> 4) & 3, r >> 6); else { const int rr = r - 256; fourAB_ctx_v3(F, ZIN, FY2 + FY2_CTX, rr & 15, rr >> 4); } continue; }
        r -= nFAB;
        { const bool cx = r >= 256; conv_item_v1(F, ZIN, YALL, wdw, bdw, clg, clb, cx ? SEQ : 0, cx ? CTX : SEQ, (cx ? r - 256 : r) * 32); }
      }
    }
    const float* rpb = ka->in[I_RPB] + (size_t)l * NH * (2 * WIN_R - 1) * (2 * WIN_C - 1);
    const int nA = (NROWS / 2) * NH + (last ? 0 : (CTX / 128) * NH);
    for (int k = 0; k * F.G < nA; ++k) { const int rem = nA - k * F.G; const int it = k * F.G + (rem >= F.G ? F.bx : (F.bx + rem) % F.G);
        if (it >= nA) break;
        const int head = it & 7, qi = it >> 3;
        attn_item_v3(F, ZIN, YALL, rpb, qi < NROWS / 2 ? qi * 2 * GRID_W : SEQ + (qi - NROWS / 2) * 128, head); }
}
__device__ __forceinline__ void four_stageC(const Ctx& F0, bool last) {
    const Ctx F = ctx_local(F0);
    const KAp ka = ka_opaque(); unsigned char* const ws = ka->ws;
    LAS v4u* CS = (LAS v4u*)(F.lds + RING_OFF + 2 * A3_BUF + 2048);
    fourC_table_v2(F, CS); __syncthreads();
    const int nFC = last ? 2048 : 2048 + 64;
    for (int q = F.gw; q < nFC; q += F.NGW) { const unsigned* FY2 = (const unsigned*)(ws + WS_FY);
        if (q < 2048) fourC_item_v2(FY2, (bf16*)(ws + WS_YALL), CS, 0, NROWS, q >> 4, (q >> 2) & 3, q & 3, F.lane);
        else { const int qq = q - 2048; fourC_item_v2(FY2 + FY2_CTX, (bf16*)(ws + WS_YALL), CS, SEQ, CTX / GRID_W, qq >> 4, (qq >> 2) & 3, qq & 3, F.lane); } }
    __syncthreads();
}
__device__ __forceinline__ void site_gate(const Ctx& F, int l, bool last) {
    four_stageC(F, last);
    const KAp ka = ka_opaque(); unsigned char* const ws = ka->ws; unsigned char* wl = ws + WS_W + (size_t)l * WL_SIZE;
    pg8::Gemm g{(const bf16*)(ws + WS_H), (const bf16*)(wl + WL_WG), 0, 0, DM, DM}; pg8::StaticOrder S; S.init(32, 3 * DM / 256, F.G, F.bx, DM / 64);
    pg8::EpiBf16<1> E{(bf16*)(ws + WS_GATES), 3 * DM, ka->in[I_BGATE] + (size_t)l * 3 * DM, nullptr, 0};
    pg8::gemm_phase<pg8::EpiBf16<1>, pg8::StaticOrder, true, true>(F.lds + RING_OFF, g, S, E, F.wave);
}
__device__ __forceinline__ void site_branch(const Ctx& F, int l, bool last) {
    const KAp ka = ka_opaque(); unsigned char* const ws = ka->ws; unsigned char* wl = ws + WS_W + (size_t)l * WL_SIZE;
    pg8::Gemm g{(const bf16*)(ws + WS_YALL), (const bf16*)(wl + WL_WB), 0, 0, DM, DM}; pg8::StaticOrder S; S.init(last ? 32 : 33, DM / 256, F.G, F.bx, DM / 64);
    pg8::EpiBranch E{(bf16*)(ws + WS_MB), DM, (const bf16*)(ws + WS_GATES), 3 * DM};
    pg8::gemm_phase<pg8::EpiBranch, pg8::StaticOrder, true, true>(F.lds + RING_OFF, g, S, E, F.wave);
    if (l == 0) helper_convert(F, (33 * (DM / 256)) % F.G, 1, 6 * TI_FF, TI_LAYER - 6 * TI_FF, 0, 3 * TI_FF, 2 * TI_FF);
}
__device__ __forceinline__ void site_o(const Ctx& F, int l, bool last) {
    const KAp ka = ka_opaque(); unsigned char* const ws = ka->ws; unsigned char* wl = ws + WS_W + (size_t)l * WL_SIZE;
    const bf16* Mb = (const bf16*)(ws + WS_MB); const bf16* Wo = (const bf16*)(wl + WL_WO);
    pg8::Gemm g{Mb, Wo, 0, 0, DM, DM};
    pg8::OrderPlus S; S.base.init(32, DM / 256, F.G, F.bx, DM / 64); S.ext.init(last ? 0 : 1, DM / 256, F.G, F.bx, 0); S.chunks = CTXK_O; S.ntc = DM / 64 / CTXK_O; S.pmx = 32;
    pg8::EpiDelta E{(bf16*)(ws + WS_T), DM, mod_vec(ws, l, 0, 5), mod_vec(ws, l, 1, 5), 1.0f, (long)((WS_PART - WS_T) / 2)};
    pg8::gemm_phase<pg8::EpiDelta, pg8::OrderPlus, true, true>(F.lds + RING_OFF, g, S, E, F.wave);
}

__global__ void __launch_bounds__(NWAVES * 64, 2) mk_fwd(Args args) {
    extern __shared__ __attribute__((aligned(16))) unsigned char lds[];
    Ctx F;
    F.lds = (LAS unsigned char*)lds; F.tid = -1; F.lane = -1; F.wave = __builtin_amdgcn_readfirstlane(threadIdx.x >> 6);
    F.bx = blockIdx.x; F.G = gridDim.x; F.gw = F.bx * NWAVES + F.wave; F.NGW = F.G * NWAVES;
    volatile LAS unsigned* MISC = (volatile LAS unsigned*)(F.lds + MISC_OFF);
    for (int u = threadIdx.x; u < (LDS_BYTES - LDSCTL_OFF) / 4; u += NWAVES * 64) ((LAS unsigned*)(F.lds + LDSCTL_OFF))[u] = 0u;
    __syncthreads();
    unsigned* barw = (unsigned*)(args.ws + WS_CTL) + CW_BAR;
    XcdBarrier bar; bar.bar = barw; bar.x = 0; bar.st = nullptr; bar.wave = F.wave;
    if (args.use_bar) bar = xcd_barrier_post(barw, MISC + 8);
    const int lo = args.ph_lo, hi = args.ph_hi;
#define IN(k) (lo <= (k) && (k) < hi)
#define SEAM(k) do { if (IN(k) && IN((k) + 1)) xcd_barrier(bar); } while (0)
#if MK_STAMP
    unsigned long long t_prev = __builtin_amdgcn_s_memrealtime(), t_cat0 = 0, t_cat1 = 0, t_cat2 = 0, t_cat3 = 0, t_cat4 = 0;
#define STAMP(cat) do { const unsigned long long t_now = __builtin_amdgcn_s_memrealtime(); t_cat##cat += t_now - t_prev; t_prev = t_now; } while (0)
#else
#define STAMP(cat) do { } while (0)
#endif

    for (int rp = 0; rp < REPN(0); ++rp) { if (rp) xcd_barrier(bar); if (PH_ON(0)) { if (IN(0)) p0_prologue(ctx_local(F)); } }
    SEAM(0); STAMP(4);
    for (int rp = 0; rp < REPN(1); ++rp) { if (rp) xcd_barrier(bar); if (PH_ON(1)) { if (IN(1)) p1_prologue(ctx_local(F)); } }
    SEAM(1); STAMP(4);

    for (int hl = 0; hl < 2 * DEPTH; ++hl) {
        const int l = hl >> 1, f = hl & 1; const bool last = (l == DEPTH - 1);
        const int pb = 2 + 3 * hl + 7 * ((hl + 1) >> 1);
        const int nMf = (last && f == 1) ? 32 : 33;
        for (int rp = 0; rp < REPN(2); ++rp) { if (rp) xcd_barrier(bar); if (PH_ON(2)) { if (IN(pb + 0)) site_up(F, l, f, nMf); } }
        SEAM(pb + 0); STAMP(0);
        for (int rp = 0; rp < REPN(3); ++rp) { if (rp) xcd_barrier(bar); if (PH_ON(3)) { if (IN(pb + 1)) site_down(F, l, f, nMf); } }
        SEAM(pb + 1); STAMP(0);
        for (int rp = 0; rp < REPN(4); ++rp) { if (rp) xcd_barrier(bar); if (PH_ON(4)) { if (IN(pb + 2)) site_ln(F, l, f == 0 ? 0 : 2, (rp || (last && f == 1)) ? SEQ : MTOT, last && f == 1); } }
        if (!(last && f == 1)) SEAM(pb + 2);
        STAMP(2);
        if (f == 1) continue;
        const int mb = pb + 3;
        for (int rp = 0; rp < REPN(5); ++rp) { if (rp) xcd_barrier(bar); if (PH_ON(5)) { if (IN(mb + 0)) site_in(F, l, last); } }
        SEAM(mb + 0); STAMP(0);
        for (int rp = 0; rp < REPN(6); ++rp) { if (rp) xcd_barrier(bar); if (PH_ON(6)) { if (IN(mb + 1)) site_mixA(F, l, last); } }
        SEAM(mb + 1); STAMP(1);
        for (int rp = 0; rp < REPN(7); ++rp) { if (rp) xcd_barrier(bar); if (PH_ON(7)) { if (IN(mb + 3)) site_gate(F, l, last); } }
        SEAM(mb + 3); STAMP(0);
        for (int rp = 0; rp < REPN(8); ++rp) { if (rp) xcd_barrier(bar); if (PH_ON(8)) { if (IN(mb + 4)) site_branch(F, l, last); } }
        SEAM(mb + 4); STAMP(0);
        for (int rp = 0; rp < REPN(9); ++rp) { if (rp) xcd_barrier(bar); if (PH_ON(9)) { if (IN(mb + 5)) site_o(F, l, last); } }
        SEAM(mb + 5); STAMP(0);
        for (int rp = 0; rp < REPN(10); ++rp) { if (rp) xcd_barrier(bar); if (PH_ON(10)) { if (IN(mb + 6)) site_ln(F, l, 1, (rp || last) ? SEQ : MTOT, false); } }
        SEAM(mb + 6); STAMP(2);
    }
    for (int eb = 0; eb < PROBE_EXTRA_BARRIERS; ++eb) xcd_barrier(bar);
#if MK_STAMP
    if (F.bx == 0 && threadIdx.x == 0) { const KAp ka = ka_opaque(); float* o = ka->out;
#define QZ(t) (1000.0f * 0.01f * exp2f(rintf(log2f((float)(t) + 1.0f) * 6.0f) / 6.0f))
        const float a0 = QZ(t_cat0), a1 = QZ(t_cat1), a2 = QZ(t_cat2), a3 = QZ(t_cat3), a4 = QZ(t_cat4);
        if (MK_STAMP == 1) { o[0] = a1; o[1] = a3; } else if (MK_STAMP == 2) { o[0] = a4; o[1] = a2; } else { o[0] = a0; o[1] = 0.f; } }

#endif
#undef IN
#undef SEAM
}

extern "C" void kernel_launch(void* const* d_in, const int* in_sizes, int n_in, void* d_out, int out_size, void* d_ws, size_t ws_size, hipStream_t stream) {
    static int grid = 0;
    if (grid == 0) {
        if (n_in != N_IN || in_sizes[0] != SEQ * DM || out_size != SEQ * DM || ws_size < WS_END) { fprintf(stderr, "kernel_launch: unexpected shapes (n_in %d, in0 %d, out %d, ws %zu); nothing launched\n", n_in, n_in > 0 ? in_sizes[0] : -1, out_size, ws_size); grid = -1; return; }
        int dev = 0, cus = 0, per_cu = 0;
        if (hipGetDevice(&dev) != hipSuccess || hipDeviceGetAttribute(&cus, hipDeviceAttributeMultiprocessorCount, dev) != hipSuccess) { grid = -1; return; }
        if (hipFuncSetAttribute((const void*)mk_fwd, hipFuncAttributeMaxDynamicSharedMemorySize, LDS_BYTES) != hipSuccess) { fprintf(stderr, "kernel_launch: hipFuncSetAttribute failed\n"); grid = -1; return; }
        if (hipOccupancyMaxActiveBlocksPerMultiprocessor(&per_cu, (const void*)mk_fwd, NWAVES * 64, LDS_BYTES) != hipSuccess || per_cu < 1) fprintf(stderr, "kernel_launch: note: occupancy query reports %d\n", per_cu);
        (void)hipGetLastError();
        grid = cus;
    }
    if (grid < 0) return;
    if (hipMemsetAsync((char*)d_ws + WS_CTL, 0, CTL_ZERO_BYTES, stream) != hipSuccess) return;
    Args a{};
    for (int i = 0; i < N_IN; ++i) a.in[i] = (const float*)d_in[i];
    a.out = (float*)d_out; a.ws = (unsigned char*)d_ws; a.pad = 0;
#if MK_PER_PHASE
    for (int k = 0; k < N_PHASES; ++k) { a.ph_lo = k; a.ph_hi = k + 1; a.use_bar = 0; hipLaunchKernelGGL(mk_fwd, dim3(grid), dim3(NWAVES * 64), LDS_BYTES, stream, a);
#if MK_DIAG
        const int id = 2 * k + 4;
        if (k == 0) hipLaunchKernelGGL(dg_trans, dim3(4096), dim3(256), 0, stream, a, id, 0, 0xFDBu);
        else if (k == 1) hipLaunchKernelGGL(dg_mod, dim3(1024), dim3(256), 0, stream, a, id);
        else for (int hl = 0; hl < 2 * DEPTH; ++hl) { const int pb = 2 + 3 * hl + 7 * ((hl + 1) >> 1), l = hl >> 1, f = hl & 1; const bool last = l == DEPTH - 1;
            const int nMf = (last && f == 1) ? 32 : 33, nMm = last ? 32 : 33; int type = -1;
            if (k >= pb && k <= pb + 2) type = k - pb; else if (f == 0 && k >= pb + 3 && k <= pb + 9) type = k - pb;
            if (type == 0) hipLaunchKernelGGL(dg_gemm, dim3(2048), dim3(256), 0, stream, a, 0, l, f, nMf * 256, id, 0.f, 0);
            if (type == 0 && hl == 0 && DIAG_PREC == 1) hipLaunchKernelGGL(dg_prec_up, dim3(512), dim3(256), 0, stream, a);
            if (type == 1 && hl == 0 && DIAG_PREC == 2) hipLaunchKernelGGL(dg_prec_dn, dim3(512), dim3(256), 0, stream, a);
            if (type == 0 && hl == 1) hipLaunchKernelGGL(dg_trans, dim3(4096), dim3(256), 0, stream, a, id + 1, 0, 0x024u);
            if (type == 0 && hl == 3) hipLaunchKernelGGL(dg_trans, dim3(4096), dim3(256), 0, stream, a, id + 1, 1, 0xFFFu);
            if (type == 1) hipLaunchKernelGGL(dg_gemm, dim3(2048), dim3(256), 0, stream, a, 1, l, f, SEQ, id, 0.5f, f == 0 ? 2 : 5);
            if (type == 2) hipLaunchKernelGGL(dg_ln, dim3(512), dim3(256), 0, stream, a, l, f == 0 ? 0 : 2, SEQ, (last && f == 1) ? 1 : 0, id);
            if (type == 3) hipLaunchKernelGGL(dg_gemm, dim3(2048), dim3(256), 0, stream, a, 2, l, 0, MTOT, id, 0.f, 0);
            if (type == 4) hipLaunchKernelGGL(dg_conv, dim3(1024), dim3(256), 0, stream, a, l, last ? SEQ : MTOT, id + 1);
            if (type == 5) hipLaunchKernelGGL(dg_attn, dim3(1024), dim3(256), 0, stream, a, l, last ? SEQ : MTOT, id);
            if (type == 6) { hipLaunchKernelGGL(dg_gemm, dim3(2048), dim3(256), 0, stream, a, 3, l, 0, nMm * 256, id, 0.f, 0); hipLaunchKernelGGL(dg_four, dim3(64), dim3(256), 0, stream, a, last ? SEQ : MTOT, id + 1); }
            if (type == 7) hipLaunchKernelGGL(dg_gemm, dim3(2048), dim3(256), 0, stream, a, 4, l, 0, nMm * 256, id, 0.f, 0);
            if (type == 8) hipLaunchKernelGGL(dg_gemm, dim3(2048), dim3(256), 0, stream, a, 1, l, 0, SEQ, id, 1.0f, 5);
            if (type == 8 && l == 0 && DIAG_PREC == 4) hipLaunchKernelGGL(dg_prec_mix, dim3(256), dim3(256), 0, stream, a);
            if (type == 9) hipLaunchKernelGGL(dg_ln, dim3(512), dim3(256), 0, stream, a, l, 1, SEQ, 0, id);
        }
#endif
    }
#if MK_DIAG
    hipLaunchKernelGGL(dg_final, dim3(1), dim3(1), 0, stream, a);
#endif
#else
    a.ph_lo = 0; a.ph_hi = N_PHASES; a.use_bar = 1;
    hipLaunchKernelGGL(mk_fwd, dim3(grid), dim3(NWAVES * 64), LDS_BYTES, stream, a);
#endif
    const hipError_t le = hipPeekAtLastError();
    if (le != hipSuccess) fprintf(stderr, "kernel_launch: launch failed: %s\n", hipGetErrorName(le));
}
```

```cpp
#include <hip/hip_runtime.h>
#include <cstdio>
#include <cstdint>

#ifndef MK_DIAG
#define MK_DIAG 0
#endif
#ifndef DIAG_PREC
#define DIAG_PREC 0
#endif
#ifndef MK_STAMP
#define MK_STAMP 0
#endif
#ifndef MK_PER_PHASE
#define MK_PER_PHASE 0
#endif

__device__ __forceinline__ int hw_lane() { int l; asm volatile("v_mbcnt_lo_u32_b32 %0, -1, 0\n\tv_mbcnt_hi_u32_b32 %0, -1, %0" : "=v"(l)); return l; }
namespace pg8 {
#define PG8_LAS __attribute__((address_space(3)))
typedef unsigned short bf16_t;
typedef short bf16x8 __attribute__((ext_vector_type(8)));
typedef float f32x4 __attribute__((ext_vector_type(4)));
typedef unsigned u32x4 __attribute__((ext_vector_type(4)));
constexpr int BM = 256, BK = 64, HALF = 128, HTB = HALF * BK * 2  , STAGE_BYTES = 8 * HTB, NXCD = 8, WGM = 8;

__host__ __device__ __forceinline__ int lds_byte(int r, int c) { const int st = (r >> 4) * 2 + (c >> 5), rr = r & 15, cc = c & 31, ob = rr * 64 + cc * 2; return st * 1024 + (ob ^ (((ob >> 9) & 1) << 5)); }
__host__ __device__ __forceinline__ void stage_rc(int b, int& R, int& C) { const int st = b / 1024, sb = b % 1024, swz = sb ^ (((sb >> 9) & 1) << 5); R = (st >> 1) * 16 + swz / 64; C = (st & 1) * 32 + (swz % 64) / 2; }
__host__ __device__ __forceinline__ int perm32(int rho) { const int n = rho >> 4, i = rho & 15; return 8 * (i >> 2) + 4 * n + (i & 3); }

struct Unit { int pm, pn, kt0, nt, job; };
struct Gemm { const bf16_t* A; const bf16_t* Bt; long dA1, dB1; int lda, ldb; };

struct StaticOrder {
    int nM, nN, nwg, G, c, ntK;
    __host__ __device__ void init(int nM_, int nN_, int G_, int c_, int ntK_) { nM = nM_; nN = nN_; nwg = nM * nN; G = G_; c = c_; ntK = ntK_; }
    __host__ __device__ __forceinline__ void map(int L, int& pm, int& pn) const {
        int wgid = L; { const int q = nwg / NXCD, r = nwg % NXCD, xcd = wgid % NXCD, off = wgid / NXCD; wgid = (xcd < r ? xcd * (q + 1) : r * (q + 1) + (xcd - r) * q) + off; }
        const int nig = WGM * nN, gid = wgid / nig, fm = gid * WGM, gsz = (nM - fm) < WGM ? (nM - fm) : WGM;
        pm = fm + ((wgid % nig) % gsz); pn = (wgid % nig) / gsz;
    }
    __host__ __device__ __forceinline__ bool next(int i, Unit& u) const {
        const long L = (long)i * G + c; const bool ok = L < nwg; int pm = 0, pn = 0; if (ok) map((int)L, pm, pn);
        u.pm = pm; u.pn = pn; u.kt0 = 0; u.nt = ntK; u.job = 0; return ok;
    }
    __device__ __forceinline__ void a_ready(const Unit&) const {}
    __device__ __forceinline__ void done(const Unit&) const {}
};
struct OrderPlus {
    StaticOrder base, ext; int chunks, ntc, pmx;
    __host__ __device__ __forceinline__ bool next(int i, Unit& u) const {
        const long L = (long)i * base.G + base.c; int pm = 0, pn = 0, kt0 = 0, nt = base.ntK, job = 0; bool ok = true;
        if (L < base.nwg) base.map((int)L, pm, pn);
        else { const int q = (int)(L - base.nwg); ok = q < ext.nwg * chunks; if (ok) ext.map(q / chunks, pm, pn); pm += pmx; kt0 = (q % chunks) * ntc; nt = ntc; job = 1; }
        u.pm = pm; u.pn = pn; u.kt0 = kt0; u.nt = nt; u.job = job; return ok;
    }
    __device__ __forceinline__ void a_ready(const Unit&) const {}
    __device__ __forceinline__ void done(const Unit&) const {}
};

typedef float f32x2_t __attribute__((ext_vector_type(2))); typedef __bf16 bf16x2_t __attribute__((ext_vector_type(2)));
__device__ __forceinline__ unsigned cvt_pk_bf16(float lo, float hi) { const f32x2_t v = {lo, hi}; const bf16x2_t b = __builtin_convertvector(v, bf16x2_t); return __builtin_bit_cast(unsigned, b); }
__device__ __forceinline__ float sigmoid_f(float x) { return __builtin_amdgcn_rcpf(1.0f + __builtin_amdgcn_exp2f(-1.4426950408889634f * x)); }
__device__ __forceinline__ float bf_lo(unsigned w) { return __builtin_bit_cast(float, w << 16); }
__device__ __forceinline__ float bf_hi(unsigned w) { return __builtin_bit_cast(float, w & 0xffff0000u); }
constexpr int CTX_PM = 32;

struct EpiSwiGLU {
    static constexpr bool PERM = true, AFTER_DRAIN = false, MIDK = false; static constexpr int T1 = 0, T2 = 0, NST = 8;
    bf16_t* O; int ldc;
    __device__ __forceinline__ void mid(f32x4 (&)[2][2][4][2], const Unit&, int, int, int, int, int) const {}
    __device__ __forceinline__ void operator()(const f32x4 (&acc)[2][2][4][2], const Unit& u, int wr, int wc, int fr, int fq) const {
        const int row0 = u.pm * BM + wr * 64 + fr, col0 = u.pn * HALF + wc * 32 + 8 * fq;
#pragma unroll
        for (int ai = 0; ai < 2; ++ai)
#pragma unroll
            for (int m = 0; m < 4; ++m) {
                bf16_t* rowp = O + (size_t)(row0 + ai * HALF + m * 16) * ldc + col0;
                float g[8];
#pragma unroll
                for (int n = 0; n < 2; ++n)
#pragma unroll
                    for (int j = 0; j < 4; ++j) { const float a = acc[ai][0][m][n][j], b = acc[ai][1][m][n][j]; g[n * 4 + j] = a * sigmoid_f(a) * b; }
                u32x4 w; w.x = cvt_pk_bf16(g[0], g[1]); w.y = cvt_pk_bf16(g[2], g[3]); w.z = cvt_pk_bf16(g[4], g[5]); w.w = cvt_pk_bf16(g[6], g[7]);
                *(u32x4*)rowp = w; }
    }
};
struct EpiDelta {
    static constexpr bool PERM = true, AFTER_DRAIN = false, MIDK = false; static constexpr int T1 = 0, T2 = 0, NST = 16;
    bf16_t* D; int ldc; const float* gate_lat; const float* gate_ctx; float gmul; long part_off;
    __device__ __forceinline__ void mid(f32x4 (&)[2][2][4][2], const Unit&, int, int, int, int, int) const {}
    __device__ __forceinline__ void operator()(const f32x4 (&acc)[2][2][4][2], const Unit& u, int wr, int wc, int fr, int fq) const {
        const int row0 = u.pm * BM + wr * 64 + fr, col0 = u.pn * BM + wc * 32 + 8 * fq;
        const long joff = (long)u.job * (part_off + ((long)(u.kt0 / u.nt) - u.pm) * BM * ldc);
        const float gm = u.job ? 0.f : gmul, g1 = u.job ? 1.f : 0.f;
        const float* gv = (u.pm >= CTX_PM) ? gate_ctx : gate_lat;
        f32x4 gg[2][2];
#pragma unroll
        for (int bj = 0; bj < 2; ++bj)
#pragma unroll
            for (int n = 0; n < 2; ++n) gg[bj][n] = *(const f32x4*)(gv + col0 + bj * HALF + 4 * n) * gm + g1;
#pragma unroll
        for (int ai = 0; ai < 2; ++ai)
#pragma unroll
            for (int m = 0; m < 4; ++m) { bf16_t* rowp = D + joff + (size_t)(row0 + ai * HALF + m * 16) * ldc + col0;
#pragma unroll
                for (int bj = 0; bj < 2; ++bj) { const f32x4 v0 = acc[ai][bj][m][0] * gg[bj][0], v1 = acc[ai][bj][m][1] * gg[bj][1];
                    u32x4 w; w.x = cvt_pk_bf16(v0[0], v0[1]); w.y = cvt_pk_bf16(v0[2], v0[3]); w.z = cvt_pk_bf16(v1[0], v1[1]); w.w = cvt_pk_bf16(v1[2], v1[3]);
                    *(u32x4*)(rowp + bj * HALF) = w; } }
    }
};
template <int ACT> struct EpiBf16 {
    static constexpr bool PERM = true, AFTER_DRAIN = false, MIDK = false; static constexpr int T1 = 0, T2 = 0, NST = 16;
    bf16_t* O; int ldc; const float* bias; bf16_t* O1; int ldc1;
    __device__ __forceinline__ void mid(f32x4 (&)[2][2][4][2], const Unit&, int, int, int, int, int) const {}
    __device__ __forceinline__ void operator()(const f32x4 (&acc)[2][2][4][2], const Unit& u, int wr, int wc, int fr, int fq) const {
        if constexpr (ACT == 2) { if (u.job) { EpiBf16<1> e{O1, ldc1, bias, nullptr, 0}; e(acc, u, wr, wc, fr, fq); } else { EpiBf16<0> e{O, ldc, nullptr, nullptr, 0}; e(acc, u, wr, wc, fr, fq); } return; } else {
        const int row0 = u.pm * BM + wr * 64 + fr, col0 = u.pn * BM + wc * 32 + 8 * fq;
        f32x4 bv[2][2];
#pragma unroll
        for (int bj = 0; bj < 2; ++bj)
#pragma unroll
            for (int n = 0; n < 2; ++n) bv[bj][n] = bias ? *(const f32x4*)(bias + col0 + bj * HALF + 4 * n) : (f32x4){0.f, 0.f, 0.f, 0.f};
#pragma unroll
        for (int ai = 0; ai < 2; ++ai)
#pragma unroll
            for (int m = 0; m < 4; ++m) { bf16_t* rowp = O + (size_t)(row0 + ai * HALF + m * 16) * ldc + col0;
#pragma unroll
                for (int bj = 0; bj < 2; ++bj) { f32x4 v0 = acc[ai][bj][m][0] + bv[bj][0], v1 = acc[ai][bj][m][1] + bv[bj][1];
                    if (ACT == 1) {
#pragma unroll
                        for (int j = 0; j < 4; ++j) { v0[j] = fminf(__builtin_amdgcn_exp2f(-1.4426950408889634f * v0[j]), 1e20f); v1[j] = fminf(__builtin_amdgcn_exp2f(-1.4426950408889634f * v1[j]), 1e20f); } }
                    u32x4 w; w.x = cvt_pk_bf16(v0[0], v0[1]); w.y = cvt_pk_bf16(v0[2], v0[3]); w.z = cvt_pk_bf16(v1[0], v1[1]); w.w = cvt_pk_bf16(v1[2], v1[3]);
                    *(u32x4*)(rowp + bj * HALF) = w; } }
        }
    }
};
struct EpiBranch {
    static constexpr bool PERM = true, AFTER_DRAIN = false, MIDK = true; static constexpr int T1 = 16, T2 = 24, NST = 16;
    bf16_t* O; int ldc; const bf16_t* gates; int ldg;
    __device__ __forceinline__ static void ld8(const bf16_t* p, float (&g)[8]) { const u32x4 w = *(const u32x4*)p;
        g[0] = bf_lo(w.x); g[1] = bf_hi(w.x); g[2] = bf_lo(w.y); g[3] = bf_hi(w.y); g[4] = bf_lo(w.z); g[5] = bf_hi(w.z); g[6] = bf_lo(w.w); g[7] = bf_hi(w.w);
        }
    __device__ __forceinline__ void mid(f32x4 (&acc)[2][2][4][2], const Unit& u, int t, int wr, int wc, int fr, int fq) const {
        int row0 = u.pm * BM + wr * 64 + fr; asm volatile("" : "+v"(row0));
        const int col0 = u.pn * BM + wc * 32 + 8 * fq;
        const int bnum = (t == T1) ? 0 : 1;
#pragma unroll
        for (int ai = 0; ai < 2; ++ai)
#pragma unroll
            for (int m = 0; m < 4; ++m) { const bf16_t* gp = gates + (size_t)(row0 + ai * HALF + m * 16) * ldg + col0 + bnum * 2048;
#pragma unroll
                for (int bj = 0; bj < 2; ++bj) { float gn[8], gd[8]; ld8(gp + bj * HALF, gn); ld8(gp + bj * HALF + 2048, gd);
#pragma unroll
                    for (int n = 0; n < 2; ++n)
#pragma unroll
                        for (int j = 0; j < 4; ++j) acc[ai][bj][m][n][j] *= (1.0f + gd[n * 4 + j]) * __builtin_amdgcn_rcpf(1.0f + gn[n * 4 + j]); }
                if (m == 3) asm volatile("" ::: "memory"); }
    }
    __device__ __forceinline__ void operator()(const f32x4 (&acc)[2][2][4][2], const Unit& u, int wr, int wc, int fr, int fq) const {
        const int row0 = u.pm * BM + wr * 64 + fr, col0 = u.pn * BM + wc * 32 + 8 * fq;
#pragma unroll
        for (int ai = 0; ai < 2; ++ai)
#pragma unroll
            for (int m = 0; m < 4; ++m) { const size_t r = (size_t)(row0 + ai * HALF + m * 16); const bf16_t* gp = gates + r * ldg + col0 + 2 * 2048; bf16_t* rowp = O + r * ldc + col0;
#pragma unroll
                for (int bj = 0; bj < 2; ++bj) { float g2[8]; ld8(gp + bj * HALF, g2);
                    const f32x4 v0 = acc[ai][bj][m][0], v1 = acc[ai][bj][m][1];
#pragma unroll
                    for (int j = 0; j < 8; ++j) g2[j] = __builtin_amdgcn_rcpf(1.0f + g2[j]);
                    u32x4 w; w.x = cvt_pk_bf16(v0[0] * g2[0], v0[1] * g2[1]); w.y = cvt_pk_bf16(v0[2] * g2[2], v0[3] * g2[3]); w.z = cvt_pk_bf16(v1[0] * g2[4], v1[1] * g2[5]); w.w = cvt_pk_bf16(v1[2] * g2[6], v1[3] * g2[7]);
                    *(u32x4*)(rowp + bj * HALF) = w; }
                }
    }
};
template <class Epi, class Sched, bool ALIGN_EPI = false, bool SP2 = false>
__device__ __forceinline__ void gemm_phase(PG8_LAS unsigned char* lds, const Gemm g, const Sched& S, const Epi& E, int wave_id) {
    int tid_ = (wave_id << 6) | hw_lane();
    const int tid = tid_, wid = __builtin_amdgcn_readfirstlane(tid >> 6), lane = tid & 63, wr = wid >> 2, wc = wid & 3, fr = lane & 15, fq = lane >> 4;
    unsigned voffA[2], voffB[2];
#pragma unroll
    for (int i = 0; i < 2; ++i) { int R, C; stage_rc(tid * 16 + i * 8192, R, C); const int Rb = Epi::PERM ? ((R & ~31) + perm32(R & 31)) : R;
        voffA[i] = (unsigned)(R * g.lda + C) * 2u; voffB[i] = (unsigned)(Rb * g.ldb + C) * 2u; }
    const size_t kstep = (size_t)(BK * 2);
    const size_t hstepA = (size_t)HALF * g.lda * 2, hstepB = (size_t)HALF * g.ldb * 2;
    const size_t tstepA = 2 * hstepA, tstepB = 2 * hstepB;
    const unsigned ldsw = (unsigned)wid * 1024u;
    const int aoff = lds_byte(wr * 64 + fr, fq * 8), boff = lds_byte(wc * 32 + fr, fq * 8);
#define PG8_SA(b, h) (((b) * 2 + (h)) * HTB)
#define PG8_SB(b, h) ((4 + (b) * 2 + (h)) * HTB)
#define PG8_STAGE(bufoff, gbase, voff) do { _Pragma("unroll") for (int _i = 0; _i < 2; ++_i) \
        __builtin_amdgcn_global_load_lds((const unsigned*)((const char*)(gbase) + (voff)[_i]), (PG8_LAS unsigned*)(lds + (bufoff) + ldsw + _i * 8192), 16, 0, 0); } while (0)
#define PG8_LDA(dst, b, h) do { _Pragma("unroll") for (int m = 0; m < 4; ++m) _Pragma("unroll") for (int k = 0; k < 2; ++k) dst[m][k] = *(const PG8_LAS bf16x8*)(lds + PG8_SA(b, h) + aoff + m * 2048 + k * 1024); } while (0)
#define PG8_LDB(dst, b, h) do { _Pragma("unroll") for (int n = 0; n < 2; ++n) _Pragma("unroll") for (int k = 0; k < 2; ++k) dst[n][k] = *(const PG8_LAS bf16x8*)(lds + PG8_SB(b, h) + boff + n * 2048 + k * 1024); } while (0)
#define PG8_MMA(ai, bj, At, Bt) do { __builtin_amdgcn_s_setprio(1); _Pragma("unroll") for (int m = 0; m < 4; ++m) _Pragma("unroll") for (int n = 0; n < 2; ++n) _Pragma("unroll") for (int k = 0; k < 2; ++k) \
        acc[ai][bj][m][n] = __builtin_amdgcn_mfma_f32_16x16x32_bf16(Bt[n][k], At[m][k], acc[ai][bj][m][n], 0, 0, 0); __builtin_amdgcn_s_setprio(0); } while (0)
#define PG8_WAIT_V(n) asm volatile("s_waitcnt vmcnt(" #n ")" ::: "memory")
#define PG8_WAIT_L(n) asm volatile("s_waitcnt lgkmcnt(" #n ")" ::: "memory")
#define PG8_BAR __builtin_amdgcn_s_barrier()
#define PG8_SCHED __builtin_amdgcn_sched_barrier(0)
    Unit cur, nxt; int ui = 0;
    if (!S.next(0, cur)) return;
    f32x4 acc[2][2][4][2];
#pragma unroll
    for (int a = 0; a < 2; ++a)
#pragma unroll
        for (int b = 0; b < 2; ++b)
#pragma unroll
            for (int m = 0; m < 4; ++m)
#pragma unroll
                for (int n = 0; n < 2; ++n) acc[a][b][m][n] = (f32x4){0.f, 0.f, 0.f, 0.f};
    bf16x8 At[4][2], B0[2][2], B1[2][2];
#define PG8_UA(u) ((const char*)g.A + (long)(u).job * g.dA1 + (size_t)(u).pm * tstepA + (size_t)(u).kt0 * kstep)
#define PG8_UB(u) ((const char*)g.Bt + (long)(u).job * g.dB1 + (size_t)(u).pn * tstepB + (size_t)(u).kt0 * kstep)
    const char* cA = PG8_UA(cur); const char* cB = PG8_UB(cur);
    S.a_ready(cur);
    if constexpr (SP2) {
        PG8_STAGE(PG8_SB(0, 0), cB, voffB); PG8_STAGE(PG8_SB(0, 1), cB + hstepB, voffB); PG8_STAGE(PG8_SA(0, 0), cA, voffA); PG8_STAGE(PG8_SA(0, 1), cA + hstepA, voffA);
        if (wr == 1) PG8_BAR;
        PG8_WAIT_V(2); PG8_BAR;
        PG8_STAGE(PG8_SB(1, 0), cB + kstep, voffB); PG8_STAGE(PG8_SA(1, 0), cA + kstep, voffA); PG8_STAGE(PG8_SB(1, 1), cB + hstepB + kstep, voffB);
        PG8_WAIT_V(6); PG8_BAR;
    } else {
        PG8_STAGE(PG8_SB(0, 0), cB, voffB); PG8_STAGE(PG8_SA(0, 0), cA, voffA); PG8_STAGE(PG8_SB(0, 1), cB + hstepB, voffB); PG8_STAGE(PG8_SA(0, 1), cA + hstepA, voffA);
        if (wr == 1) PG8_BAR;
        PG8_WAIT_V(4); PG8_BAR;
        PG8_STAGE(PG8_SB(1, 0), cB + kstep, voffB); PG8_STAGE(PG8_SA(1, 0), cA + kstep, voffA); PG8_STAGE(PG8_SB(1, 1), cB + hstepB + kstep, voffB);
        PG8_WAIT_V(6); PG8_BAR;
    }
    for (;;) {
        const bool has_next = S.next(ui + 1, nxt);
        const char* nA = has_next ? PG8_UA(nxt) : cA; const char* nB = has_next ? PG8_UB(nxt) : cB;
        const int nt = cur.nt;
        for (int t = 0; t < nt; t += 2) {
            if constexpr (Epi::MIDK) { if (t == Epi::T1 || t == Epi::T2) E.mid(acc, cur, t, wr, wc, fr, fq); }
            const bool last = (t == nt - 2);
            const char* a1 = cA + (size_t)(t + 1) * kstep;
            const char* a2 = last ? nA : cA + (size_t)(t + 2) * kstep; const char* b2 = last ? nB : cB + (size_t)(t + 2) * kstep;
            const char* a3 = a2 + kstep; const char* b3 = b2 + kstep;
            if (last && has_next) S.a_ready(nxt);
            if constexpr (SP2) {
            const int loose = __builtin_amdgcn_readfirstlane(((t == 0) && (ui > 0)) ? 1 : 0);
#define PG8_WAIT_V8L do { if constexpr (Epi::NST == 8) asm volatile("s_waitcnt vmcnt(16)\n\ts_cmp_lg_u32 %0, 0\n\ts_cbranch_scc1 1f\n\ts_waitcnt vmcnt(8)\n1:" :: "s"(loose) : "memory", "scc"); \
                          else asm volatile("s_waitcnt vmcnt(24)\n\ts_cmp_lg_u32 %0, 0\n\ts_cbranch_scc1 1f\n\ts_waitcnt vmcnt(8)\n1:" :: "s"(loose) : "memory", "scc"); } while (0)
            PG8_LDB(B0, 0, 0); PG8_LDB(B1, 0, 1); PG8_SCHED; PG8_LDA(At, 0, 0); PG8_STAGE(PG8_SA(1, 1), a1 + hstepA, voffA);
            PG8_WAIT_V8L; PG8_WAIT_L(0); PG8_BAR; PG8_MMA(0, 0, At, B0); PG8_MMA(0, 1, At, B1); PG8_BAR; PG8_SCHED;
            PG8_LDA(At, 0, 1); PG8_STAGE(PG8_SB(0, 0), b2, voffB); PG8_STAGE(PG8_SB(0, 1), b2 + hstepB, voffB); PG8_STAGE(PG8_SA(0, 0), a2, voffA);
            PG8_WAIT_V8L; PG8_WAIT_L(0); PG8_BAR; PG8_MMA(1, 0, At, B0); PG8_MMA(1, 1, At, B1); PG8_BAR; PG8_SCHED;
#undef PG8_WAIT_V8L
            PG8_LDB(B0, 1, 0); PG8_LDB(B1, 1, 1); PG8_SCHED; PG8_LDA(At, 1, 0); PG8_STAGE(PG8_SA(0, 1), a2 + hstepA, voffA);
            PG8_WAIT_V(8); PG8_WAIT_L(0); PG8_BAR; PG8_MMA(0, 0, At, B0); PG8_MMA(0, 1, At, B1); PG8_BAR; PG8_SCHED;
            PG8_LDA(At, 1, 1); PG8_STAGE(PG8_SB(1, 0), b3, voffB); PG8_STAGE(PG8_SB(1, 1), b3 + hstepB, voffB); PG8_STAGE(PG8_SA(1, 0), a3, voffA);
            PG8_WAIT_V(8); PG8_WAIT_L(0); PG8_BAR; PG8_MMA(1, 0, At, B0); PG8_MMA(1, 1, At, B1); PG8_BAR; PG8_SCHED;
            } else {
            PG8_LDB(B0, 0, 0); PG8_SCHED; PG8_LDA(At, 0, 0); PG8_STAGE(PG8_SA(1, 1), a1 + hstepA, voffA);
            PG8_WAIT_L(8); PG8_BAR; PG8_WAIT_L(0); PG8_MMA(0, 0, At, B0); PG8_BAR; PG8_SCHED;
            PG8_LDB(B1, 0, 1); PG8_STAGE(PG8_SB(0, 0), b2, voffB);
            PG8_BAR; PG8_WAIT_L(0); PG8_MMA(0, 1, At, B1); PG8_BAR;
            PG8_LDA(At, 0, 1); PG8_STAGE(PG8_SA(0, 0), a2, voffA);
            PG8_BAR; PG8_WAIT_L(0); PG8_MMA(1, 0, At, B0); PG8_BAR; PG8_SCHED;
            PG8_STAGE(PG8_SB(0, 1), b2 + hstepB, voffB);
            PG8_WAIT_V(6); PG8_BAR; PG8_MMA(1, 1, At, B1); PG8_BAR;
            PG8_LDB(B0, 1, 0); PG8_SCHED; PG8_LDA(At, 1, 0); PG8_STAGE(PG8_SA(0, 1), a2 + hstepA, voffA);
            PG8_WAIT_L(8); PG8_BAR; PG8_WAIT_L(0); PG8_MMA(0, 0, At, B0); PG8_BAR; PG8_SCHED;
            PG8_LDB(B1, 1, 1); PG8_STAGE(PG8_SB(1, 0), b3, voffB);
            PG8_BAR; PG8_WAIT_L(0); PG8_MMA(0, 1, At, B1); PG8_BAR;
            PG8_LDA(At, 1, 1); PG8_STAGE(PG8_SA(1, 0), a3, voffA);
            PG8_BAR; PG8_WAIT_L(0); PG8_MMA(1, 0, At, B0); PG8_BAR; PG8_SCHED;
            PG8_STAGE(PG8_SB(1, 1), b3 + hstepB, voffB);
            PG8_WAIT_V(6); PG8_BAR; PG8_MMA(1, 1, At, B1); PG8_BAR;
            }
        }
        if constexpr (ALIGN_EPI) { if (wr == 0) PG8_BAR; }
        if constexpr (!Epi::AFTER_DRAIN) { E(acc, cur, wr, wc, fr, fq); S.done(cur); }
        if (!has_next) break;
#pragma unroll
        for (int a = 0; a < 2; ++a)
#pragma unroll
            for (int b = 0; b < 2; ++b)
#pragma unroll
                for (int m = 0; m < 4; ++m)
#pragma unroll
                    for (int n = 0; n < 2; ++n) acc[a][b][m][n] = (f32x4){0.f, 0.f, 0.f, 0.f};
        cur = nxt; cA = nA; cB = nB; ++ui;
        if constexpr (ALIGN_EPI) { if (wr == 1) PG8_BAR; }
    }
    PG8_WAIT_V(0);
    if constexpr (!ALIGN_EPI) { if (wr == 0) PG8_BAR; }
    PG8_BAR;
    if constexpr (Epi::AFTER_DRAIN) { E.fused(acc, cur, wr, wc, fr, fq, lds, wid, lane); S.done(cur); }
#undef PG8_UA
#undef PG8_UB
#undef PG8_SA
#undef PG8_SB
#undef PG8_STAGE
#undef PG8_LDA
#undef PG8_LDB
#undef PG8_MMA
#undef PG8_WAIT_V
#undef PG8_WAIT_L
#undef PG8_BAR
#undef PG8_SCHED
}
}

#ifndef PG8_SP2
#define PG8_SP2 true
#endif
#ifndef PG8_ALIGN
#define PG8_ALIGN true
#endif

constexpr int NWAVES = 8;
constexpr int DM = 2048, SEQ = 8192, CTX = 256, DEPTH = 2, GRID_W = 64, NROWS = SEQ / GRID_W;
constexpr int MTOT = SEQ + CTX;
constexpr int NH = 8, HD = 128, DNA = 1024, WIN_R = 8, WIN_C = 16;
constexpr int DFOUR = 512, FG = 128, DCONV = 512, CONVW = 31;
constexpr int DFF = 5632, DIN = 4608, NMODU = 6;
constexpr int ADA_N = 9 * DM;
constexpr float LN_EPS = 1e-5f, ALPHA = 1.4142135623730951f;
constexpr int ZQ = 0, ZK = DNA, ZV = 2 * DNA, ZF = 3 * DNA, ZA = 3 * DNA + DFOUR, ZG = 3 * DNA + DFOUR + DCONV;
constexpr int YNA = 0, YF = DNA, YC = DNA + DFOUR;

enum { I_X = 0, I_C, I_CTX, I_CCTX, I_WADA, I_BADA, I_F1W1, I_F1W3, I_F1W2, I_F2W1, I_F2W3, I_F2W2, I_WIN, I_WDW, I_BDW, I_CLNG, I_CLNB, I_RPB, I_WGATE, I_BGATE, I_WBNA, I_WBF, I_WBC, I_WO, I_LNG, I_LNB, N_IN };

constexpr size_t MiB = 1u << 20;
constexpr size_t WS_CTL = 0, CTL_ZERO_BYTES = 1 * MiB;
constexpr int MODP_CH = 16;
constexpr size_t WS_MODP = 2 * MiB;
constexpr size_t WS_MOD = 6 * MiB;
constexpr size_t WS_W = 8 * MiB;
constexpr size_t WL_W13A = 0, WL_W2A = 44 * MiB, WL_W13B = 66 * MiB, WL_W2B = 110 * MiB, WL_WIN = 132 * MiB, WL_WG = 150 * MiB, WL_WB = 174 * MiB, WL_WO = 182 * MiB, WL_SIZE = 190 * MiB;
constexpr size_t WS_X = 388 * MiB;
constexpr size_t WS_T = 454 * MiB;
constexpr size_t WS_H = 520 * MiB;
constexpr size_t WS_G = 553 * MiB;
constexpr size_t WS_ZIN = 644 * MiB;
constexpr size_t WS_YALL = 719 * MiB;
constexpr size_t WS_GATES = 752 * MiB;
constexpr size_t WS_MB = 851 * MiB;
constexpr size_t WS_FY = 884 * MiB;
constexpr size_t WS_VT = 917 * MiB;
constexpr size_t WS_PART = 934 * MiB;
constexpr size_t WS_END = 978 * MiB;
static_assert(WS_W + 2 * WL_SIZE <= WS_X && WS_G + (size_t)MTOT * DFF * 2 <= WS_ZIN && WS_ZIN + (size_t)MTOT * DIN * 2 <= WS_YALL && WS_GATES + (size_t)MTOT * 3 * DM * 2 <= WS_MB && WS_FY + (size_t)MTOT * DFOUR * 8 <= WS_END, "d_ws map");
constexpr int CW_TMO = 0, CW_BAR = 4096;

constexpr int RING_OFF = 0, RING_BYTES = 131072;
constexpr int LDSCTL_OFF = RING_BYTES, MISC_OFF = LDSCTL_OFF + 320;
constexpr int LDS_BYTES = 147456;

#define GAS __attribute__((address_space(1)))
#define LAS __attribute__((address_space(3)))
typedef unsigned short bf16;
typedef unsigned v4u __attribute__((ext_vector_type(4)));
typedef unsigned v2u __attribute__((ext_vector_type(2)));
typedef float f32x4 __attribute__((ext_vector_type(4)));
typedef float f32x2 __attribute__((ext_vector_type(2)));
typedef short bf16x8 __attribute__((ext_vector_type(8)));
typedef GAS unsigned gu32;
typedef float xh;
typedef float xh4 __attribute__((ext_vector_type(4)));
__device__ __forceinline__ f32x4 xld4(const xh* p) { return __builtin_convertvector(*(const GAS xh4*)p, f32x4); }
__device__ __forceinline__ void xst4(xh* p, f32x4 v) { *(GAS xh4*)p = __builtin_convertvector(v, xh4); }
#define RLX_AGENT __ATOMIC_RELAXED, __HIP_MEMORY_SCOPE_AGENT
#define LDS_WAIT() asm volatile("s_waitcnt lgkmcnt(0)" ::: "memory")
#define VM_WAIT() asm volatile("s_waitcnt vmcnt(0)" ::: "memory")
__device__ __forceinline__ unsigned f2bf(float f) { unsigned u = __builtin_bit_cast(unsigned, f); return (u + 0x7fffu + ((u >> 16) & 1u)) >> 16; }
__device__ __forceinline__ unsigned pk2(float lo, float hi) { return f2bf(lo) | (f2bf(hi) << 16); }
typedef __bf16 bf16x2v __attribute__((ext_vector_type(2)));
__device__ __forceinline__ unsigned pkbf(float lo, float hi) { const f32x2 v = {lo, hi}; const bf16x2v b = __builtin_convertvector(v, bf16x2v); return __builtin_bit_cast(unsigned, b); }
__device__ __forceinline__ float bf2f(bf16 b) { return __builtin_bit_cast(float, (unsigned)b << 16); }
__device__ __forceinline__ float sigm(float x) { return 1.0f / (1.0f + __expf(-x)); }
template <int CTRL> __device__ __forceinline__ float dppf(float v) { return __builtin_bit_cast(float, __builtin_amdgcn_update_dpp(0, __builtin_bit_cast(int, v), CTRL, 0xF, 0xF, false)); }
template <int CTRL, int ROWMASK> __device__ __forceinline__ float dppfm(float v) { return __builtin_bit_cast(float, __builtin_amdgcn_update_dpp(0, __builtin_bit_cast(int, v), CTRL, ROWMASK, 0xF, true)); }
__device__ __forceinline__ float wave_sum(float v) {
    v += dppf<0x128>(v); v += dppf<0x124>(v); v += dppf<0x122>(v); v += dppf<0x121>(v);
    v += dppfm<0x142, 0xA>(v);
    v += dppfm<0x143, 0xC>(v);
    return __builtin_bit_cast(float, __builtin_amdgcn_readlane(__builtin_bit_cast(int, v), 63));
}
__device__ __forceinline__ float wave_max(float v) {
#pragma unroll
    for (int o = 1; o < 64; o <<= 1) v = fmaxf(v, __shfl_xor(v, o));
    return v;
}
#define XB_TMO      128
#define XB_XCNT(j)  (256  + 64 * (j))
#define XB_XSUB(j)  (1280 + 64 * (j))
#define XB_XGEN(j)  (2304 + 64 * (j))
#define XB_TOP      3328
#define XB_TOPGEN   3392
#define XCD_BAR_WORDS 3456
#define XB_SPIN_CAP (1u << 18)

__device__ __forceinline__ unsigned xb_ld(unsigned* p)              { return __hip_atomic_load(p, __ATOMIC_RELAXED, __HIP_MEMORY_SCOPE_AGENT); }
__device__ __forceinline__ unsigned xb_add(unsigned* p, unsigned v) { return __hip_atomic_fetch_add(p, v, __ATOMIC_RELAXED, __HIP_MEMORY_SCOPE_AGENT); }
__device__ __forceinline__ unsigned xb_xcc_id() { return (unsigned)__builtin_amdgcn_s_getreg((3 << 11) | 20) & 0xFu; }
#define XB_SPIN(cond, bar) do { unsigned _sp = 0; while (cond) { __builtin_amdgcn_s_sleep(1); \
    if ((++_sp & 255u) == 0u) { if (xb_ld(&(bar)[XB_TMO])) break; if (_sp > XB_SPIN_CAP) { atomicAdd(&(bar)[XB_TMO], 1u); break; } } } } while (0)

struct XcdBarrier {
    unsigned* bar; unsigned x; int wave;
    volatile LAS unsigned* st;
};

__device__ __forceinline__ XcdBarrier xcd_barrier_post(unsigned* bar, volatile LAS unsigned* st) {
    XcdBarrier b; b.bar = bar; b.x = xb_xcc_id(); b.st = st; b.wave = __builtin_amdgcn_readfirstlane(threadIdx.x >> 6);
    if (threadIdx.x == 0) (void)xb_add(&bar[XB_XCNT(b.x)], 1u);
    return b;
}
__device__ __forceinline__ void xcd_barrier_complete(unsigned* bar, unsigned x, unsigned& nloc, unsigned& nx) {
    const unsigned G = gridDim.x * gridDim.y * gridDim.z;
    unsigned sum, cnt, mine, sp = 0u;
    for (;;) {
        sum = 0u; cnt = 0u; mine = 0u;
#pragma unroll
        for (unsigned j = 0; j < 16; ++j) { const unsigned c = xb_ld(&bar[XB_XCNT(j)]); sum += c; cnt += (c > 0u) ? 1u : 0u; mine = (j == x) ? c : mine; }
        if (sum == G) break;
        __builtin_amdgcn_s_sleep(1);
        if ((++sp & 255u) == 0u) { if (xb_ld(&bar[XB_TMO])) break; if (sp > XB_SPIN_CAP) { atomicAdd(&bar[XB_TMO], 1u); break; } }
    }
    nloc = mine > 0u ? mine : 1u; nx = cnt > 0u ? cnt : 1u;
}

__device__ __forceinline__ void xcd_barrier(const XcdBarrier& b) {
    asm volatile("s_waitcnt vmcnt(0)" ::: "memory");
    __syncthreads();
    if (b.wave == 0 && hw_lane() == 0) {
        unsigned* bar = b.bar;
        __builtin_amdgcn_s_waitcnt(0);
        unsigned nloc = b.st[0], nx = b.st[1];
        if (nloc == 0u) { xcd_barrier_complete(bar, b.x, nloc, nx); b.st[0] = nloc; b.st[1] = nx; }
        const unsigned old = xb_add(&bar[XB_XSUB(b.x)], 1u);
        const unsigned gen = old / nloc;
        if (old + 1u == (gen + 1u) * nloc) {
            __builtin_amdgcn_fence(__ATOMIC_RELEASE, "agent");
            asm volatile("s_waitcnt vmcnt(0)" ::: "memory");
            const unsigned og = xb_add(&bar[XB_TOP], 1u);
            const unsigned tg = og / nx;
            if (og + 1u == (tg + 1u) * nx) xb_add(&bar[XB_TOPGEN], 1u);
            else XB_SPIN(xb_ld(&bar[XB_TOPGEN]) == tg, bar);
            __builtin_amdgcn_fence(__ATOMIC_ACQUIRE, "agent");
            xb_add(&bar[XB_XGEN(b.x)], 1u);
            asm volatile("s_waitcnt vmcnt(0)" ::: "memory");
        } else {
            XB_SPIN(xb_ld(&bar[XB_XGEN(b.x)]) == gen, bar);
            __builtin_amdgcn_fence(__ATOMIC_ACQUIRE, "agent");
            asm volatile("s_waitcnt vmcnt(0)" ::: "memory");
        }
    }
    __syncthreads();
}


struct Ctx {
    LAS unsigned char* lds; int tid, lane, wave, bx, G, gw, NGW;
};
struct Args { const float* in[26]; float* out; unsigned char* ws; int ph_lo, ph_hi, use_bar, pad; };
typedef const __attribute__((address_space(4))) Args* KAp;
typedef unsigned u32x4p __attribute__((ext_vector_type(4)));
__device__ __forceinline__ KAp ka_opaque() { KAp p = (KAp)__builtin_amdgcn_kernarg_segment_ptr(); asm volatile("" : "+s"(p)); return p; }

struct TrDesc { const float* W; int N; bf16* WT; int ldk, koff, grp, gstride, goff, item; };
#ifndef TR_MAP
#define TR_MAP 1
#endif
__device__ __forceinline__ void tr_kn(const TrDesc& d, int& kb, int& nb) {
    const int nblk = d.N / 64;
#if TR_MAP == 1
    const int pr = d.item / (2 * nblk), j = d.item % (2 * nblk); kb = 2 * pr + ((j >> 2) & 1); nb = 4 * (j >> 3) + (j & 3);
#elif TR_MAP == 2
    const int pr = d.item / (8 * nblk), j = d.item % (8 * nblk); kb = 8 * pr + (j & 7); nb = j >> 3;
#else
    kb = d.item / nblk; nb = d.item % nblk;
#endif
}
__device__ __forceinline__ void tr_load(const TrDesc& d, f32x4 (&a)[8], f32x4 (&b)[8], int lane) {
    int kb, nb; tr_kn(d, kb, nb); const int k0 = 64 * kb, n0 = 64 * nb, nq = lane & 15, kr = lane >> 4;
#pragma unroll
    for (int i = 0; i < 8; ++i) { const float* wp = d.W + (size_t)(k0 + 8 * i + 2 * kr) * d.N + n0 + 4 * nq; a[i] = *(const GAS f32x4*)wp; b[i] = *(const GAS f32x4*)(wp + d.N); }
}
__device__ __forceinline__ void tr_finish(const TrDesc& d, const f32x4 (&a)[8], const f32x4 (&b)[8], LAS unsigned* scr, int lane) {
    int kb, nb; tr_kn(d, kb, nb); const int k0 = 64 * kb, n0 = 64 * nb, nq = lane & 15, kr = lane >> 4;
#pragma unroll
    for (int i = 0; i < 8; ++i) { const int kd = 4 * i + kr;
#pragma unroll
        for (int e = 0; e < 4; ++e) scr[(4 * nq + e) * 33 + kd] = pkbf(a[i][e], b[i][e]); }
    LDS_WAIT(); asm volatile("" ::: "memory");
#pragma unroll
    for (int j = 0; j < 8; ++j) { const int n = (lane >> 3) + 8 * j, ch = lane & 7; const LAS unsigned* s = scr + n * 33 + 4 * ch;
        v4u o; o.x = s[0]; o.y = s[1]; o.z = s[2]; o.w = s[3];
        const int nn = n0 + n, drow = (nn / d.grp) * d.gstride + d.goff + (nn % d.grp);
        *(GAS v4u*)(d.WT + (size_t)drow * d.ldk + d.koff + k0 + 8 * ch) = o; }
    LDS_WAIT(); asm volatile("" ::: "memory");
}
constexpr int TI_FF = (DM / 64) * (DFF / 64);
constexpr int TI_IN = (DM / 64) * (DIN / 64), TI_G = (DM / 64) * (3 * DM / 64), TI_BNA = (DNA / 64) * (DM / 64), TI_BF = (DFOUR / 64) * (DM / 64), TI_BC = (DCONV / 64) * (DM / 64), TI_O = (DM / 64) * (DM / 64);
constexpr int TI_LAYER = 6 * TI_FF + TI_IN + TI_G + TI_BNA + TI_BF + TI_BC + TI_O;
constexpr int MOD_CB = NMODU * DM / 256;
constexpr int MODI = DEPTH * MOD_CB * MODP_CH;

__device__ __forceinline__ TrDesc weight_desc(const KAp ka, unsigned char* ws, int l, int r) {
    unsigned char* wl = ws + WS_W + (size_t)l * WL_SIZE;
    const float* W; int N; bf16* WT; int ldk, koff = 0, grp, gstride = 0, goff = 0;
    if (r < TI_FF) { W = ka->in[I_F1W1] + (size_t)l * DM * DFF; N = DFF; WT = (bf16*)(wl + WL_W13A); ldk = DM; grp = 128; gstride = 256; goff = 0; }
    else if ((r -= TI_FF) < TI_FF) { W = ka->in[I_F1W3] + (size_t)l * DM * DFF; N = DFF; WT = (bf16*)(wl + WL_W13A); ldk = DM; grp = 128; gstride = 256; goff = 128; }
    else if ((r -= TI_FF) < TI_FF) { W = ka->in[I_F1W2] + (size_t)l * DFF * DM; N = DM; WT = (bf16*)(wl + WL_W2A); ldk = DFF; grp = DM; }
    else if ((r -= TI_FF) < TI_FF) { W = ka->in[I_F2W1] + (size_t)l * DM * DFF; N = DFF; WT = (bf16*)(wl + WL_W13B); ldk = DM; grp = 128; gstride = 256; goff = 0; }
    else if ((r -= TI_FF) < TI_FF) { W = ka->in[I_F2W3] + (size_t)l * DM * DFF; N = DFF; WT = (bf16*)(wl + WL_W13B); ldk = DM; grp = 128; gstride = 256; goff = 128; }
    else if ((r -= TI_FF) < TI_FF) { W = ka->in[I_F2W2] + (size_t)l * DFF * DM; N = DM; WT = (bf16*)(wl + WL_W2B); ldk = DFF; grp = DM; }
    else if ((r -= TI_FF) < TI_IN) { W = ka->in[I_WIN] + (size_t)l * DM * DIN; N = DIN; WT = (bf16*)(wl + WL_WIN); ldk = DM; grp = DIN; }
    else if ((r -= TI_IN) < TI_G) { W = ka->in[I_WGATE] + (size_t)l * DM * 3 * DM; N = 3 * DM; WT = (bf16*)(wl + WL_WG); ldk = DM; grp = 3 * DM; }
    else if ((r -= TI_G) < TI_BNA) { W = ka->in[I_WBNA] + (size_t)l * DNA * DM; N = DM; WT = (bf16*)(wl + WL_WB); ldk = DM; grp = DM; koff = 0; }
    else if ((r -= TI_BNA) < TI_BF) { W = ka->in[I_WBF] + (size_t)l * DFOUR * DM; N = DM; WT = (bf16*)(wl + WL_WB); ldk = DM; grp = DM; koff = DNA; }
    else if ((r -= TI_BF) < TI_BC) { W = ka->in[I_WBC] + (size_t)l * DCONV * DM; N = DM; WT = (bf16*)(wl + WL_WB); ldk = DM; grp = DM; koff = DNA + DFOUR; }
    else { r -= TI_BC; W = ka->in[I_WO] + (size_t)l * DM * DM; N = DM; WT = (bf16*)(wl + WL_WO); ldk = DM; grp = DM; }
    TrDesc d; d.W = W; d.N = N; d.WT = WT; d.ldk = ldk; d.koff = koff; d.grp = grp; d.gstride = gstride; d.goff = goff; d.item = r; return d;
}
__device__ __forceinline__ void weight_item(const KAp ka, unsigned char* ws, int l, int r, LAS unsigned* scr, int lane) {
    const TrDesc d = weight_desc(ka, ws, l, r); f32x4 a[8], b[8]; tr_load(d, a, b, lane); tr_finish(d, a, b, scr, lane);
}
__device__ __forceinline__ int w2_lo(int f) { return f == 0 ? 2 * TI_FF : 5 * TI_FF; }
constexpr int L1_OTHER = TI_LAYER - 2 * TI_FF;
constexpr int TI_MIX = TI_LAYER - 6 * TI_FF;
__device__ __forceinline__ int l1_other_item(int q) { return q < 2 * TI_FF ? q : (q < 4 * TI_FF ? q + TI_FF : q + 2 * TI_FF); }
__device__ __forceinline__ void helper_convert(const Ctx& F, int first_idle_block, int la, int qa0, int nA, int lb = 0, int qb0 = 0, int nB = 0) {
    if (F.bx < first_idle_block) return;
    const KAp ka = ka_opaque(); unsigned char* const ws = ka->ws;
    LAS unsigned* scr = (LAS unsigned*)(F.lds + RING_OFF + F.wave * 16384);
    const int hw = (F.bx - first_idle_block) * NWAVES + F.wave, nhw = (F.G - first_idle_block) * NWAVES;
    const int lane = hw_lane();
    for (int q = hw; q < nA + nB; q += nhw) { const bool inA = q < nA; weight_item(ka, ws, inA ? la : lb, inA ? qa0 + q : qb0 + (q - nA), scr, lane); }
}
__device__ __forceinline__ TrDesc p0_desc(const KAp ka, unsigned char* ws, int r) {
    return weight_desc(ka, ws, 0, r < 2 * TI_FF ? r : r + 4 * TI_FF);
}
__device__ __forceinline__ void p0_prologue(const Ctx& F) {
    const KAp ka = ka_opaque(); unsigned char* const ws = ka->ws;
    LAS unsigned* scr = (LAS unsigned*)(F.lds + RING_OFF + F.wave * 16384);
    for (int it = F.gw; it < MODI; it += F.NGW) {
        const int l = it / (MOD_CB * MODP_CH), r = it % (MOD_CB * MODP_CH), cb = r / MODP_CH, kc = r % MODP_CH;
        const float* cv = ka->in[I_C]; const float* cc = ka->in[I_CCTX];
        const float a0 = cv[kc * 128 + F.lane], a1 = cv[kc * 128 + 64 + F.lane], b0 = cc[kc * 128 + F.lane], b1 = cc[kc * 128 + 64 + F.lane];
        const float sl0 = a0 * sigm(a0), sl1 = a1 * sigm(a1), sc0 = b0 * sigm(b0), sc1 = b1 * sigm(b1);
        const float* W = ka->in[I_WADA] + (size_t)l * DM * ADA_N + (size_t)(kc * 128) * ADA_N + cb * 256 + 4 * F.lane;
        f32x4 aL = {0.f, 0.f, 0.f, 0.f}, aC = {0.f, 0.f, 0.f, 0.f};
#pragma unroll 16
        for (int k = 0; k < 64; ++k) { const f32x4 w = *(const GAS f32x4*)(W + (size_t)k * ADA_N); aL += w * __shfl(sl0, k); aC += w * __shfl(sc0, k); }
#pragma unroll 16
        for (int k = 0; k < 64; ++k) { const f32x4 w = *(const GAS f32x4*)(W + (size_t)(64 + k) * ADA_N); aL += w * __shfl(sl1, k); aC += w * __shfl(sc1, k); }
        float* P = (float*)(ws + WS_MODP);
        *(GAS f32x4*)(P + (size_t)((kc * 2 + l) * 2 + 0) * (NMODU * DM) + cb * 256 + 4 * F.lane) = aL;
        *(GAS f32x4*)(P + (size_t)((kc * 2 + l) * 2 + 1) * (NMODU * DM) + cb * 256 + 4 * F.lane) = aC;
    }
    const int NT = 2 * TI_FF + (TI_LAYER - 6 * TI_FF);
    int r = (F.gw + MODI) % F.NGW;
    f32x4 a0[8], b0[8], a1[8], b1[8];
    if (r < NT) { TrDesc d0 = p0_desc(ka, ws, r); tr_load(d0, a0, b0, F.lane);
        for (;;) {
            const int r1 = r + F.NGW; const bool v1 = r1 < NT; TrDesc d1 = d0;
            if (v1) { d1 = p0_desc(ka, ws, r1); tr_load(d1, a1, b1, F.lane); }
            tr_finish(d0, a0, b0, scr, F.lane);
            if (!v1) break;
            const int r2 = r1 + F.NGW; const bool v2 = r2 < NT;
            if (v2) { d0 = p0_desc(ka, ws, r2); tr_load(d0, a0, b0, F.lane); }
            tr_finish(d1, a1, b1, scr, F.lane);
            if (!v2) break;
            r = r2;
        } }
}

__device__ __forceinline__ const float* mod_vec(unsigned char* ws, int l, int s, int i) { return (const float*)(ws + WS_MOD) + (size_t)((l * 2 + s) * NMODU + i) * DM; }
__device__ __forceinline__ void p1_prologue(const Ctx& F) {
    const KAp ka = ka_opaque(); unsigned char* const ws = ka->ws;
    const float* P = (const float*)(ws + WS_MODP); const float* bada = ka->in[I_BADA];
    LAS float* mv = (LAS float*)(F.lds + RING_OFF);
#pragma unroll 1
    for (int v = 0; v < 4; ++v) { const int s = v >> 1, i = v & 1;
        float pa[4][MODP_CH], a0[4];
#pragma unroll
        for (int q = 0; q < 4; ++q) { const int col = F.tid + 512 * q; a0[q] = bada[i * DM + col];
#pragma unroll
            for (int kc = 0; kc < MODP_CH; ++kc) pa[q][kc] = P[(size_t)((kc * 2 + 0) * 2 + s) * (NMODU * DM) + i * DM + col]; }
#pragma unroll
        for (int q = 0; q < 4; ++q) { float a = a0[q];
#pragma unroll
            for (int kc = 0; kc < MODP_CH; ++kc) a += pa[q][kc];
            mv[v * DM + F.tid + 512 * q] = a; } }
    const int gt = F.bx * 512 + F.tid;
    if (gt < DEPTH * 2 * NMODU * DM) { const int l = gt / (2 * NMODU * DM), s = (gt / (NMODU * DM)) & 1, j = gt % (NMODU * DM); float a = bada[(size_t)l * ADA_N + j];
        for (int kc = 0; kc < MODP_CH; ++kc) a += P[(size_t)((kc * 2 + l) * 2 + s) * (NMODU * DM) + j];
        ((float*)(ws + WS_MOD))[(size_t)(l * 2 + s) * (NMODU * DM) + j] = a; }
    __syncthreads();
    xh* X = (xh*)(ws + WS_X); bf16* H = (bf16*)(ws + WS_H);
    for (int row0 = F.gw; row0 < MTOT; row0 += 2 * F.NGW) {
        const int row1 = row0 + F.NGW; const bool two = row1 < MTOT;
        f32x4 va[8], vb[8];
        { const float* src = row0 < SEQ ? ka->in[I_X] + (size_t)row0 * DM : ka->in[I_CTX] + (size_t)(row0 - SEQ) * DM;
#pragma unroll
          for (int j = 0; j < 8; ++j) va[j] = *(const GAS f32x4*)(src + 4 * F.lane + 256 * j); }
        if (two) { const float* src = row1 < SEQ ? ka->in[I_X] + (size_t)row1 * DM : ka->in[I_CTX] + (size_t)(row1 - SEQ) * DM;
#pragma unroll
          for (int j = 0; j < 8; ++j) vb[j] = *(const GAS f32x4*)(src + 4 * F.lane + 256 * j); }
#pragma unroll
        for (int h2 = 0; h2 < 2; ++h2) { if (h2 == 1 && !two) break;
            const int row = h2 ? row1 : row0;
            const LAS float* sh = mv + (row < SEQ ? 0 : 2 * DM); const LAS float* sc = sh + DM;
#pragma unroll
            for (int j = 0; j < 8; ++j) { const int col = 4 * F.lane + 256 * j; const f32x4 v = h2 ? vb[j] : va[j];
                xst4(X + (size_t)row * DM + col, v);
                const f32x4 s4 = *(const LAS f32x4*)(sc + col), h4 = *(const LAS f32x4*)(sh + col); const f32x4 h = v * (s4 + 1.0f) + h4;
                v2u o; o.x = pk2(h[0], h[1]); o.y = pk2(h[2], h[3]); *(GAS v2u*)(H + (size_t)row * DM + col) = o; } }
    }
    __syncthreads();
}

#ifndef DIAG_ZERO_NA
#define DIAG_ZERO_NA 0
#endif
#ifndef DIAG_ZERO_C
#define DIAG_ZERO_C 0
#endif
#ifndef DIAG_ZERO_ROW0
#define DIAG_ZERO_ROW0 0
#endif
__device__ __forceinline__ f32x4 bf4(v2u w) { return (f32x4){pg8::bf_lo(w.x), pg8::bf_hi(w.x), pg8::bf_lo(w.y), pg8::bf_hi(w.y)}; }
__device__ __forceinline__ void ln_load_row(const Ctx& F, f32x4 (&v)[8], int row, const bf16* Dl, const xh* Xin, const bf16* parts, int nparts, const float* gate_ctx, float gmul) {
    if (parts && row >= SEQ) {
        f32x4 a[8];
#pragma unroll
        for (int j = 0; j < 8; ++j) a[j] = (f32x4){0.f, 0.f, 0.f, 0.f};
#pragma unroll 2
        for (int ch = 0; ch < nparts; ++ch) { const bf16* pp = parts + ((size_t)ch * 256 + (row - SEQ)) * DM + 4 * F.lane;
#pragma unroll
            for (int j = 0; j < 8; ++j) a[j] += bf4(*(const GAS v2u*)(pp + 256 * j)); }
#pragma unroll
        for (int j = 0; j < 8; ++j) { const int col = 4 * F.lane + 256 * j; v[j] = xld4(Xin + (size_t)row * DM + col) * ALPHA + a[j] * (*(const GAS f32x4*)(gate_ctx + col) * gmul); }
    } else {
#pragma unroll
        for (int j = 0; j < 8; ++j) { const int col = 4 * F.lane + 256 * j; v[j] = xld4(Xin + (size_t)row * DM + col) * ALPHA + bf4(*(const GAS v2u*)(Dl + (size_t)row * DM + col)); }
    }
}
__device__ __forceinline__ void ln_stats2(f32x4 (&v0)[8], f32x4 (&v1)[8], bool two, float& r0, float& r1) {
    float s0 = 0.f, s1 = 0.f;
#pragma unroll
    for (int j = 0; j < 8; ++j) { s0 += (v0[j][0] + v0[j][1]) + (v0[j][2] + v0[j][3]); if (two) s1 += (v1[j][0] + v1[j][1]) + (v1[j][2] + v1[j][3]); }
    s0 = wave_sum(s0); s1 = wave_sum(s1);
    const float m0 = s0 * (1.0f / DM), m1 = s1 * (1.0f / DM); float q0 = 0.f, q1 = 0.f;
#pragma unroll
    for (int j = 0; j < 8; ++j) { v0[j] = v0[j] - m0; q0 += (v0[j][0] * v0[j][0] + v0[j][1] * v0[j][1]) + (v0[j][2] * v0[j][2] + v0[j][3] * v0[j][3]);
        if (two) { v1[j] = v1[j] - m1; q1 += (v1[j][0] * v1[j][0] + v1[j][1] * v1[j][1]) + (v1[j][2] * v1[j][2] + v1[j][3] * v1[j][3]); } }
    q0 = wave_sum(q0); q1 = wave_sum(q1);
    r0 = 1.0f / sqrtf(q0 * (1.0f / DM) + LN_EPS); r1 = 1.0f / sqrtf(q1 * (1.0f / DM) + LN_EPS);
}
__device__ __forceinline__ void ln_finish_row(const Ctx& F, f32x4 (&v)[8], float rstd, int row, float* Xo32, xh* Xo, bf16* H, const f32x4 (&gv)[8], const f32x4 (&bv)[8], const float* shL, const float* scL, const float* shC, const float* scC) {
    const float* sh = row < SEQ ? shL : shC; const float* sc = row < SEQ ? scL : scC;
#pragma unroll
    for (int j = 0; j < 8; ++j) { const int col = 4 * F.lane + 256 * j; const f32x4 y = v[j] * rstd * gv[j] + bv[j];
        if (Xo32) *(GAS f32x4*)(Xo32 + (size_t)row * DM + col) = y; else xst4(Xo + (size_t)row * DM + col, y);
        if (H) { const f32x4 s4 = *(const GAS f32x4*)(sc + col), h4 = *(const GAS f32x4*)(sh + col); const f32x4 h = y * (s4 + 1.0f) + h4;
            v2u o; o.x = pk2(h[0], h[1]); o.y = pk2(h[2], h[3]); *(GAS v2u*)(H + (size_t)row * DM + col) = o; } }
}
template <int NP>
__device__ __forceinline__ void ln_ctx_row_wg(const Ctx& F, int row, xh* Xo, bf16* H, const float* g, const float* b, const float* shC, const float* scC, const xh* Xin, const bf16* parts, const float* gate_ctx, float gmul) {
    LAS float* red = (LAS float*)(F.lds + RING_OFF);
    const int col = 256 * F.wave + 4 * F.lane;
    const bf16* pp0 = parts + (size_t)(row - SEQ) * DM + col;
    v2u t[NP];
#pragma unroll
    for (int ch = 0; ch < NP; ++ch) t[ch] = *(const GAS v2u*)(pp0 + (size_t)ch * 256 * DM);
    const f32x4 x = xld4(Xin + (size_t)row * DM + col), gt = *(const GAS f32x4*)(gate_ctx + col);
    f32x4 a = {0.f, 0.f, 0.f, 0.f};
#pragma unroll
    for (int ch = 0; ch < NP; ++ch) a += bf4(t[ch]);
    f32x4 v = x * ALPHA + a * (gt * gmul);
    const float s = wave_sum((v[0] + v[1]) + (v[2] + v[3])), mw = s * (1.0f / 256.0f);
    const f32x4 dw = v - mw;
    const float m2 = wave_sum((dw[0] * dw[0] + dw[1] * dw[1]) + (dw[2] * dw[2] + dw[3] * dw[3]));
    if (F.lane == 0) { red[F.wave] = s; red[8 + F.wave] = m2; }
    __syncthreads();
    const float mean = (((red[0] + red[1]) + (red[2] + red[3])) + ((red[4] + red[5]) + (red[6] + red[7]))) * (1.0f / DM);
    float q = ((red[8] + red[9]) + (red[10] + red[11])) + ((red[12] + red[13]) + (red[14] + red[15]));
#pragma unroll
    for (int w = 0; w < 8; ++w) { const float dm = red[w] * (1.0f / 256.0f) - mean; q += 256.0f * dm * dm; }
    v = v - mean;
    const float rstd = 1.0f / sqrtf(q * (1.0f / DM) + LN_EPS);
    const f32x4 y = v * rstd * *(const GAS f32x4*)(g + col) + *(const GAS f32x4*)(b + col);
    xst4(Xo + (size_t)row * DM + col, y);
    if (H) { const f32x4 s4 = *(const GAS f32x4*)(scC + col), h4 = *(const GAS f32x4*)(shC + col); const f32x4 h = y * (s4 + 1.0f) + h4;
        v2u o; o.x = pk2(h[0], h[1]); o.y = pk2(h[2], h[3]); *(GAS v2u*)(H + (size_t)row * DM + col) = o; }
    __syncthreads();
}
__device__ __forceinline__ void ln_raw_load(const Ctx& F, f32x4 (&xr)[8], v2u (&dr)[8], int row, const bf16* Dl, const xh* Xin) {
#pragma unroll
    for (int j = 0; j < 8; ++j) { const int col = 4 * F.lane + 256 * j; xr[j] = xld4(Xin + (size_t)row * DM + col); dr[j] = *(const GAS v2u*)(Dl + (size_t)row * DM + col); }
}
__device__ __forceinline__ void ln_phase(const Ctx& F, const bf16* Dl, float* Xo32, xh* Xo, bf16* H, const float* g, const float* b, const float* shL, const float* scL, const float* shC, const float* scC, int nrows,
                                         const xh* Xin, const bf16* parts, int nparts, const float* gate_ctx, float gmul) {
    const int nlat = parts ? SEQ : nrows;
    int row = F.gw; int row1 = row + F.NGW; bool two = row1 < nlat;
    f32x4 v0[8], v1[8]; v2u d0[8], d1[8];
    if (row < nlat) { ln_raw_load(F, v0, d0, row, Dl, Xin); if (two) ln_raw_load(F, v1, d1, row1, Dl, Xin); }
    if (parts) {
        for (int crow = SEQ + F.bx; crow < nrows; crow += F.G) { if (nparts == 22) ln_ctx_row_wg<22>(F, crow, Xo, H, g, b, shC, scC, Xin, parts, gate_ctx, gmul); else ln_ctx_row_wg<8>(F, crow, Xo, H, g, b, shC, scC, Xin, parts, gate_ctx, gmul); } }
    f32x4 gv[8], bv[8];
#pragma unroll
    for (int j = 0; j < 8; ++j) { const int col = 4 * F.lane + 256 * j; gv[j] = *(const GAS f32x4*)(g + col); bv[j] = *(const GAS f32x4*)(b + col); }
    while (row < nlat) {
#pragma unroll
        for (int j = 0; j < 8; ++j) { v0[j] = v0[j] * ALPHA + bf4(d0[j]); if (two) v1[j] = v1[j] * ALPHA + bf4(d1[j]); }
        float r0, r1; ln_stats2(v0, v1, two, r0, r1);
        ln_finish_row(F, v0, r0, row, Xo32, Xo, H, gv, bv, shL, scL, shC, scC);
        if (two) ln_finish_row(F, v1, r1, row1, Xo32, Xo, H, gv, bv, shL, scL, shC, scC);
        row += 2 * F.NGW; row1 = row + F.NGW; two = row1 < nlat;
        if (row < nlat) { ln_raw_load(F, v0, d0, row, Dl, Xin); if (two) ln_raw_load(F, v1, d1, row1, Dl, Xin); }
    }
}

__device__ __forceinline__ void attn_item_v1(const bf16* ZIN, bf16* YALL, const float* rpb, int tok, int head, LAS float* pb, int lane) {
    const bool isctx = tok >= SEQ;
    const int r = tok / GRID_W, c = tok % GRID_W;
    const int r0 = min(max(r - WIN_R / 2, 0), NROWS - WIN_R), c0 = min(max(c - WIN_C / 2, 0), GRID_W - WIN_C);
    const int nband = isctx ? 0 : WIN_R * WIN_C, nkeys = nband + CTX;
    const int sub = lane & 15, grp = lane >> 4;
    float q[8];
    { const v4u w = *(const GAS v4u*)(ZIN + (size_t)tok * DIN + ZQ + head * HD + 8 * sub);
      q[0] = pg8::bf_lo(w.x); q[1] = pg8::bf_hi(w.x); q[2] = pg8::bf_lo(w.y); q[3] = pg8::bf_hi(w.y); q[4] = pg8::bf_lo(w.z); q[5] = pg8::bf_hi(w.z); q[6] = pg8::bf_lo(w.w); q[7] = pg8::bf_hi(w.w); }
    const float scale = 0.08838834764831845f;
    for (int kk0 = 0; kk0 < nkeys; kk0 += 4) {
        const int kk = kk0 + grp; int ktok; float bias = 0.f;
        if (kk < nband) { const int i = kk >> 4, j = kk & 15; ktok = (r0 + i) * GRID_W + c0 + j; bias = rpb[(head * (2 * WIN_R - 1) + (r0 + i - r + WIN_R - 1)) * (2 * WIN_C - 1) + (c0 + j - c + WIN_C - 1)]; }
        else ktok = SEQ + (kk - nband);
        const v4u w = *(const GAS v4u*)(ZIN + (size_t)ktok * DIN + ZK + head * HD + 8 * sub);
        float d = q[0] * pg8::bf_lo(w.x) + q[1] * pg8::bf_hi(w.x) + q[2] * pg8::bf_lo(w.y) + q[3] * pg8::bf_hi(w.y) + q[4] * pg8::bf_lo(w.z) + q[5] * pg8::bf_hi(w.z) + q[6] * pg8::bf_lo(w.w) + q[7] * pg8::bf_hi(w.w);
        d += __shfl_xor(d, 1); d += __shfl_xor(d, 2); d += __shfl_xor(d, 4); d += __shfl_xor(d, 8);
        if (sub == 0) pb[kk] = d * scale + bias;
    }
    LDS_WAIT(); asm volatile("" ::: "memory");
    float mx = -3.0e38f;
    for (int kk = lane; kk < nkeys; kk += 64) mx = fmaxf(mx, pb[kk]);
    mx = wave_max(mx);
    float sum = 0.f;
    for (int kk = lane; kk < nkeys; kk += 64) { const float e = __expf(pb[kk] - mx); pb[kk] = e; sum += e; }
    sum = wave_sum(sum);
    LDS_WAIT(); asm volatile("" ::: "memory");
    float o0 = 0.f, o1 = 0.f;
#pragma unroll 8
    for (int kk = 0; kk < nkeys; ++kk) {
        int ktok; if (kk < nband) { const int i = kk >> 4, j = kk & 15; ktok = (r0 + i) * GRID_W + c0 + j; } else ktok = SEQ + (kk - nband);
        const unsigned vw = *(const GAS unsigned*)(ZIN + (size_t)ktok * DIN + ZV + head * HD + 2 * lane); const float p = pb[kk];
        o0 += p * pg8::bf_lo(vw); o1 += p * pg8::bf_hi(vw); }
    const float inv = 1.0f / sum;
    *(GAS unsigned*)(YALL + (size_t)tok * DM + YNA + head * HD + 2 * lane) = DIAG_ZERO_NA ? 0u : pk2(o0 * inv, o1 * inv);
    LDS_WAIT(); asm volatile("" ::: "memory");
}


__device__ __forceinline__ void vt_item(const bf16* ZIN, bf16* VT, int item, LAS bf16* scr, int lane) {
    const int t0 = (item >> 4) * 64, c0 = (item & 15) * 64;
#pragma unroll
    for (int i = 0; i < 8; ++i) { const int row = 8 * i + (lane >> 3); const v4u w = *(const GAS v4u*)(ZIN + (size_t)(t0 + row) * DIN + ZV + c0 + 8 * (lane & 7)); *(LAS v4u*)(scr + row * 72 + 8 * (lane & 7)) = w; }
    LDS_WAIT(); asm volatile("" ::: "memory");
#pragma unroll
    for (int i = 0; i < 8; ++i) { const int dd = 8 * i + (lane >> 3), ch = lane & 7; unsigned short e[8];
#pragma unroll
        for (int k = 0; k < 8; ++k) e[k] = scr[(8 * ch + k) * 72 + dd];
        v4u o; o.x = e[0] | ((unsigned)e[1] << 16); o.y = e[2] | ((unsigned)e[3] << 16); o.z = e[4] | ((unsigned)e[5] << 16); o.w = e[6] | ((unsigned)e[7] << 16);
        *(GAS v4u*)(VT + (size_t)(c0 + dd) * MTOT + t0 + 8 * ch) = o; }
    LDS_WAIT(); asm volatile("" ::: "memory");
}

__device__ __forceinline__ void attn_task_v2(const bf16* ZIN, const bf16* VT, bf16* YALL, const float* rpb, int tok0, int head, int lane) {
    const bool isctx = tok0 >= SEQ;
    const int qn = lane & 15, g = lane >> 4;
    const int r = tok0 >> 6, cq0 = tok0 & 63, c = cq0 + qn;
    const int r0 = min(max(r - WIN_R / 2, 0), NROWS - WIN_R), cb = min(max(cq0 - WIN_C / 2, 0), GRID_W - 32), c0 = min(max(c - WIN_C / 2, 0), GRID_W - WIN_C);
    const float C1 = 0.08838834764831845f * 1.4426950408889634f, LOG2E = 1.4426950408889634f;
    bf16x8 qf[4];
#pragma unroll
    for (int s = 0; s < 4; ++s) qf[s] = *(const GAS bf16x8*)(ZIN + (size_t)(tok0 + qn) * DIN + ZQ + head * HD + 32 * s + 8 * g);
    f32x4 o[8];
#pragma unroll
    for (int db = 0; db < 8; ++db) o[db] = (f32x4){0.f, 0.f, 0.f, 0.f};
    float m_run = -1.0e30f, l_run = 0.f;
    const float* rpbh = rpb + head * (2 * WIN_R - 1) * (2 * WIN_C - 1) + (r0 - r + WIN_R - 1) * (2 * WIN_C - 1);
    int bo[8]; unsigned okm = 0u;
#pragma unroll
    for (int i = 0; i < 8; ++i) { const int kc = cb + 8 * g + i; okm |= ((kc >= c0) && (kc < c0 + WIN_C)) ? (1u << i) : 0u; bo[i] = min(max(kc - c + WIN_C - 1, 0), 2 * WIN_C - 2); }
    const int km = lane & 15, kmo = 8 * (km >> 2) + (km & 3);
    bf16x8 kc0[4], kc1[4];
    { const int ksf = isctx ? 8 : 0; const int kb0 = ksf < 8 ? (r0 + ksf) * GRID_W + cb : SEQ + (ksf - 8) * 32;
      const bf16* kp0 = ZIN + (size_t)(kb0 + kmo) * DIN + ZK + head * HD + 8 * g;
#pragma unroll
      for (int s = 0; s < 4; ++s) { kc0[s] = *(const GAS bf16x8*)(kp0 + 32 * s); kc1[s] = *(const GAS bf16x8*)(kp0 + 4 * DIN + 32 * s); } }
    for (int ks = isctx ? 8 : 0; ks < 16; ++ks) {
        const bool band = ks < 8;
        const int kbase = band ? (r0 + ks) * GRID_W + cb : SEQ + (ks - 8) * 32;
        bf16x8 vf[8];
        { const bf16* vp = VT + (size_t)(head * HD + (lane & 15)) * MTOT + kbase + 8 * g;
#pragma unroll
          for (int db = 0; db < 8; ++db) vf[db] = *(const GAS bf16x8*)(vp + (size_t)(16 * db) * MTOT); }
        f32x4 s0 = {0.f, 0.f, 0.f, 0.f}, s1 = {0.f, 0.f, 0.f, 0.f};
#pragma unroll
        for (int s = 0; s < 4; ++s) { s0 = __builtin_amdgcn_mfma_f32_16x16x32_bf16(kc0[s], qf[s], s0, 0, 0, 0); s1 = __builtin_amdgcn_mfma_f32_16x16x32_bf16(kc1[s], qf[s], s1, 0, 0, 0); }
        if (ks + 1 < 16) { const int kn = ks + 1; const int kb1 = kn < 8 ? (r0 + kn) * GRID_W + cb : SEQ + (kn - 8) * 32;
            const bf16* kp0 = ZIN + (size_t)(kb1 + kmo) * DIN + ZK + head * HD + 8 * g;
#pragma unroll
            for (int s = 0; s < 4; ++s) { kc0[s] = *(const GAS bf16x8*)(kp0 + 32 * s); kc1[s] = *(const GAS bf16x8*)(kp0 + 4 * DIN + 32 * s); } }
        float sc[8];
        if (band) { const float* brow = rpbh + ks * (2 * WIN_C - 1);
#pragma unroll
            for (int i = 0; i < 8; ++i) { const float sv = (i < 4 ? s0[i & 3] : s1[i & 3]); sc[i] = ((okm >> i) & 1u) ? sv * C1 + brow[bo[i]] * LOG2E : -1.0e30f; } }
        else {
#pragma unroll
            for (int i = 0; i < 8; ++i) sc[i] = (i < 4 ? s0[i & 3] : s1[i & 3]) * C1; }
        float mx = fmaxf(fmaxf(fmaxf(sc[0], sc[1]), fmaxf(sc[2], sc[3])), fmaxf(fmaxf(sc[4], sc[5]), fmaxf(sc[6], sc[7])));
        mx = fmaxf(mx, __shfl_xor(mx, 16)); mx = fmaxf(mx, __shfl_xor(mx, 32));
        const bool resc = __any(mx > m_run + 6.0f);
        float alpha = 1.0f;
        if (resc) { const float m_new = fmaxf(m_run, mx); alpha = __builtin_amdgcn_exp2f(m_run - m_new); m_run = m_new; l_run *= alpha;
#pragma unroll
            for (int db = 0; db < 8; ++db) o[db] = o[db] * alpha; }
        float p[8], ps = 0.f;
#pragma unroll
        for (int i = 0; i < 8; ++i) { p[i] = __builtin_amdgcn_exp2f(sc[i] - m_run); ps += p[i]; }
        l_run += ps;
        u32x4p pfw; pfw.x = pkbf(p[0], p[1]); pfw.y = pkbf(p[2], p[3]); pfw.z = pkbf(p[4], p[5]); pfw.w = pkbf(p[6], p[7]);
        const bf16x8 pf = __builtin_bit_cast(bf16x8, pfw);
#pragma unroll
        for (int db = 0; db < 8; ++db) o[db] = __builtin_amdgcn_mfma_f32_16x16x32_bf16(vf[db], pf, o[db], 0, 0, 0);
    }
    float lt = l_run; lt += __shfl_xor(lt, 16); lt += __shfl_xor(lt, 32);
    const float inv = 1.0f / lt;
#pragma unroll
    for (int db = 0; db < 8; ++db) { v2u w; w.x = pkbf(o[db][0] * inv, o[db][1] * inv); w.y = pkbf(o[db][2] * inv, o[db][3] * inv);
        *(GAS v2u*)(YALL + (size_t)(tok0 + qn) * DM + YNA + head * HD + 16 * db + 4 * g) = w; }
}


__device__ __forceinline__ size_t fy2_idx(int k1, int grp, int cp, int n2) { return (size_t)((((k1 * 4 + grp) * (GRID_W / 4) + (n2 >> 2)) * FG + cp) * 4 + (n2 & 3)); }
__device__ __forceinline__ v4u pk8(const float (&v)[8]) { v4u o; o.x = pkbf(v[0], v[1]); o.y = pkbf(v[2], v[3]); o.z = pkbf(v[4], v[5]); o.w = pkbf(v[6], v[7]); return o; }
__device__ __forceinline__ void fourAB_item_v3(const Ctx& F0, const bf16* ZIN, unsigned* FY2, int nq, int grp, int cblk) {
    Ctx F = F0; asm volatile("" : "+v"(F.tid)); F.lane = F.tid & 63;
    LAS f32x2* tab = (LAS f32x2*)(F.lds + RING_OFF); LAS v4u* CwP = (LAS v4u*)(F.lds + RING_OFF + 1024); LAS v4u* SwP = CwP + 2048;
    LAS f32x2* twt = (LAS f32x2*)(F.lds + RING_OFF + 1024 + 65536);
    LAS unsigned* XB = (LAS unsigned*)(F.lds + RING_OFF + 1024);
    if (F.tid < 128) { float s, c; sincospif((float)F.tid * (1.0f / 64.0f), &s, &c); tab[F.tid] = (f32x2){c, s}; }
    { const int k1 = F.tid & 127, jj = F.tid >> 7; float s, c; sincospif((float)((4 * nq + jj) * k1) * (2.0f / (float)(NROWS * GRID_W)), &s, &c); twt[jj * 128 + k1] = (f32x2){c, s}; }
    __syncthreads();
#pragma unroll
    for (int q = 0; q < 4; ++q) { const int e = F.tid + 512 * q, ln = e & 63, ks = (e >> 6) & 3, kt = e >> 8; const int k1 = 16 * kt + (ln & 15), gg = ln >> 4; float cv[8], sv[8];
#pragma unroll
        for (int j = 0; j < 8; ++j) { const int n1 = 32 * ks + 16 * (j >> 2) + 4 * gg + (j & 3); const f32x2 t = tab[(k1 * n1) & 127]; cv[j] = t.x; sv[j] = t.y; }
        CwP[e] = pk8(cv); SwP[e] = pk8(sv); }
    const int lane = F.lane, g = lane >> 4, jw = F.wave & 3, n2 = 4 * nq + jw, cpl = 16 * (F.wave >> 2) + (lane & 15), cp = 32 * cblk + cpl;
    bf16x8 Bc[4], Bs[4];
#pragma unroll
    for (int s = 0; s < 4; ++s) { float cv[8], sv[8];
#pragma unroll
        for (int j = 0; j < 8; ++j) { const f32x2 t = tab[((32 * s + 8 * g + j) * cp) & 127]; cv[j] = t.x; sv[j] = t.y; }
        Bc[s] = __builtin_bit_cast(bf16x8, pk8(cv)); Bs[s] = __builtin_bit_cast(bf16x8, pk8(sv)); }
    __syncthreads();
    f32x4 Zc[8], Zs[8];
#pragma unroll
    for (int rt = 0; rt < 8; ++rt) { Zc[rt] = (f32x4){0.f, 0.f, 0.f, 0.f}; Zs[rt] = (f32x4){0.f, 0.f, 0.f, 0.f};
        const bf16* fp = ZIN + (size_t)((16 * rt + (lane & 15)) * GRID_W + n2) * DIN + ZF + grp * FG + 8 * g;
#pragma unroll
        for (int s = 0; s < 4; ++s) { const bf16x8 a = *(const GAS bf16x8*)(fp + 32 * s);
            Zc[rt] = __builtin_amdgcn_mfma_f32_16x16x32_bf16(a, Bc[s], Zc[rt], 0, 0, 0); Zs[rt] = __builtin_amdgcn_mfma_f32_16x16x32_bf16(a, Bs[s], Zs[rt], 0, 0, 0); }
        if (rt & 1) asm volatile("" ::: "memory"); }
    bf16x8 zc[4], zs[4], zn[4];
#pragma unroll
    for (int ks = 0; ks < 4; ++ks) { v4u a, b; a.x = pkbf(Zc[2 * ks][0], Zc[2 * ks][1]); a.y = pkbf(Zc[2 * ks][2], Zc[2 * ks][3]); a.z = pkbf(Zc[2 * ks + 1][0], Zc[2 * ks + 1][1]); a.w = pkbf(Zc[2 * ks + 1][2], Zc[2 * ks + 1][3]);
        b.x = pkbf(Zs[2 * ks][0], Zs[2 * ks][1]); b.y = pkbf(Zs[2 * ks][2], Zs[2 * ks][3]); b.z = pkbf(Zs[2 * ks + 1][0], Zs[2 * ks + 1][1]); b.w = pkbf(Zs[2 * ks + 1][2], Zs[2 * ks + 1][3]);
        zc[ks] = __builtin_bit_cast(bf16x8, a); zs[ks] = __builtin_bit_cast(bf16x8, b); v4u n = b ^ 0x80008000u; zn[ks] = __builtin_bit_cast(bf16x8, n); }
    unsigned ow[8][4];
#pragma unroll
    for (int kt = 0; kt < 8; ++kt) { f32x4 yr = {0.f, 0.f, 0.f, 0.f}, yi = {0.f, 0.f, 0.f, 0.f};
#pragma unroll
        for (int ks = 0; ks < 4; ++ks) { const bf16x8 aC = __builtin_bit_cast(bf16x8, CwP[(kt * 4 + ks) * 64 + lane]), aS = __builtin_bit_cast(bf16x8, SwP[(kt * 4 + ks) * 64 + lane]);
            yr = __builtin_amdgcn_mfma_f32_16x16x32_bf16(aC, zc[ks], yr, 0, 0, 0); yr = __builtin_amdgcn_mfma_f32_16x16x32_bf16(aS, zn[ks], yr, 0, 0, 0);
            yi = __builtin_amdgcn_mfma_f32_16x16x32_bf16(aC, zs[ks], yi, 0, 0, 0); yi = __builtin_amdgcn_mfma_f32_16x16x32_bf16(aS, zc[ks], yi, 0, 0, 0); }
#pragma unroll
        for (int rg = 0; rg < 4; ++rg) { const int k1 = 16 * kt + 4 * g + rg; const f32x2 tw = twt[jw * 128 + k1]; const float ct = tw.x, st = tw.y;
            const float a = yr[rg], b = -yi[rg];
            ow[kt][rg] = pkbf(a * ct + b * st, b * ct - a * st); } }
    __syncthreads();
#pragma unroll
    for (int kt = 0; kt < 8; ++kt)
#pragma unroll
        for (int rg = 0; rg < 4; ++rg) XB[((16 * kt + 4 * g + rg) * 32 + cpl) * 4 + jw] = ow[kt][rg];
    __syncthreads();
#pragma unroll
    for (int i = 0; i < 8; ++i) { const int s = F.tid + 512 * i, k1 = s >> 5, c2 = s & 31;
        *(GAS v4u*)(FY2 + fy2_idx(k1, grp, 32 * cblk + c2, 4 * nq)) = *(const LAS v4u*)(XB + 4 * s); }
    __syncthreads();
}
__device__ __forceinline__ void fourC_table_v2(const Ctx& F, LAS v4u* CS) {
    LAS f32x2* t64 = (LAS f32x2*)(CS + 1024);
    if (F.tid < 64) { float s, c; sincospif((float)F.tid * (1.0f / 32.0f), &s, &c); t64[F.tid] = (f32x2){c, s}; }
    __syncthreads();
#pragma unroll
    for (int q = 0; q < 2; ++q) { const int e = F.tid + 512 * q, ln = e & 63, nt = (e >> 6) & 3, ks = e >> 8; const int k2 = 16 * nt + (ln & 15), gg = ln >> 4; float v[8];
#pragma unroll
        for (int j = 0; j < 8; ++j) { const int k = 32 * ks + 8 * gg + j, n2v = k >> 1; const f32x2 t = t64[(n2v * k2) & 63]; v[j] = (k & 1) ? t.y : t.x; }
        CS[e] = pk8(v); }
}
__device__ __forceinline__ void fourC_item_v2(const unsigned* FY2, bf16* YALL, const LAS v4u* CS, int base, int N1, int k1, int grp, int cq, int lane) {
    const int g = lane >> 4; const float norm = 1.0f / sqrtf((float)(N1 * GRID_W * FG));
    f32x4 acc[2][4];
#pragma unroll
    for (int mt = 0; mt < 2; ++mt)
#pragma unroll
        for (int nt = 0; nt < 4; ++nt) acc[mt][nt] = (f32x4){0.f, 0.f, 0.f, 0.f};
#pragma unroll
    for (int ks = 0; ks < 4; ++ks) { bf16x8 bfr[4];
#pragma unroll
        for (int nt = 0; nt < 4; ++nt) bfr[nt] = __builtin_bit_cast(bf16x8, CS[(ks * 4 + nt) * 64 + lane]);
#pragma unroll
        for (int mt = 0; mt < 2; ++mt) { const int cp = 32 * cq + 16 * mt + (lane & 15);
            const bf16x8 a = *(const GAS bf16x8*)(FY2 + fy2_idx(k1, grp, cp, 16 * ks + 4 * g));
#pragma unroll
            for (int nt = 0; nt < 4; ++nt) acc[mt][nt] = __builtin_amdgcn_mfma_f32_16x16x32_bf16(a, bfr[nt], acc[mt][nt], 0, 0, 0); } }
#pragma unroll
    for (int mt = 0; mt < 2; ++mt)
#pragma unroll
        for (int nt = 0; nt < 4; ++nt) { const int k2 = 16 * nt + (lane & 15), cp0 = 32 * cq + 16 * mt + 4 * g; v2u w; w.x = pkbf(acc[mt][nt][0] * norm, acc[mt][nt][1] * norm); w.y = pkbf(acc[mt][nt][2] * norm, acc[mt][nt][3] * norm);
            *(GAS v2u*)(YALL + (size_t)(base + k1 + N1 * k2) * DM + YF + grp * FG + cp0) = w; }
}


constexpr int A3_KROW = 272, A3_VROW = 144, A3_KB = 64 * A3_KROW, A3_BUF = A3_KB + 128 * A3_VROW;
typedef short s16x4 __attribute__((ext_vector_type(4)));
__device__ __forceinline__ void attn_item_v3(const Ctx& F, const bf16* ZIN, bf16* YALL, const float* rpb, int qtok0, int head) {
    const bool isctx = qtok0 >= SEQ;
    const int lane = F.lane, qn = lane & 15, g = lane >> 4, tid = F.tid;
    const int tok0 = qtok0 + 16 * F.wave;
    const int r = tok0 >> 6, cq0 = tok0 & 63, c = cq0 + qn;
    const int r0w = min(max(r - WIN_R / 2, 0), NROWS - WIN_R), cb = min(max(cq0 - WIN_C / 2, 0), GRID_W - 32), c0 = min(max(c - WIN_C / 2, 0), GRID_W - WIN_C);
    const int rA = qtok0 >> 6, r0A = min(max(rA - WIN_R / 2, 0), NROWS - WIN_R), r0B = min(max(rA + 1 - WIN_R / 2, 0), NROWS - WIN_R);
    const int nband = isctx ? 0 : WIN_R + (r0B - r0A), nsteps = nband + CTX / 64;
    const float C1 = 0.08838834764831845f * 1.4426950408889634f, LOG2E = 1.4426950408889634f;
    LAS unsigned char* const lb = F.lds + RING_OFF;
    bf16x8 qf[4];
#pragma unroll
    for (int s = 0; s < 4; ++s) qf[s] = *(const GAS bf16x8*)(ZIN + (size_t)(tok0 + qn) * DIN + ZQ + head * HD + 32 * s + 8 * g);
    f32x4 o[8];
#pragma unroll
    for (int db = 0; db < 8; ++db) o[db] = (f32x4){0.f, 0.f, 0.f, 0.f};
    float m_run = -1.0e30f, l_run = 0.f;
    const float* rpbh = rpb + head * (2 * WIN_R - 1) * (2 * WIN_C - 1);
    LAS float* bl = (LAS float*)(lb + 2 * A3_BUF);
    if (tid < (2 * WIN_R - 1) * (2 * WIN_C - 1)) bl[tid] = rpbh[tid] * LOG2E;
    int bo[8]; unsigned okm = 0u;
#pragma unroll
    for (int i = 0; i < 8; ++i) { const int kc = cb + 8 * g + i; okm |= ((kc >= c0) && (kc < c0 + WIN_C)) ? (1u << i) : 0u; bo[i] = min(max(kc - c + WIN_C - 1, 0), 2 * WIN_C - 2); }
    v4u st[4];
    const bf16* kp0[2];
#pragma unroll
    for (int i = 0; i < 2; ++i) { const int ch = tid + 512 * i; kp0[i] = ZIN + (size_t)(ch >> 4) * DIN + ZK + head * HD + 8 * (ch & 15); }
#define A3_LOAD(s_) do { const int s__ = (s_); const int tb = s__ < nband ? (r0A + s__) * GRID_W : SEQ + 64 * (s__ - nband); const size_t toff = (size_t)tb * DIN; \
        _Pragma("unroll") for (int i = 0; i < 2; ++i) { st[i] = *(const GAS v4u*)(kp0[i] + toff); st[2 + i] = *(const GAS v4u*)(kp0[i] + toff + (ZV - ZK)); } } while (0)
#define A3_STORE(b_) do { LAS unsigned char* bb = lb + (b_) * A3_BUF; \
        _Pragma("unroll") for (int i = 0; i < 2; ++i) { const int ch = tid + 512 * i; *(LAS v4u*)(bb + (ch >> 4) * A3_KROW + 16 * (ch & 15)) = st[i]; { const int r_ = ch >> 4, c_ = ch & 15, sv_ = (r_ & 3) | (((r_ >> 3) & 1) << 2); *(LAS v4u*)(bb + A3_KB + r_ * 256 + ((((c_ >> 1) ^ sv_) << 5) | ((c_ & 1) << 4))) = st[2 + i]; } } } while (0)
    A3_LOAD(0); A3_STORE(0);
    __builtin_amdgcn_s_waitcnt(0x0F70);
    __syncthreads();
    if (nsteps > 1) A3_LOAD(1);
    const int km = lane & 15, kmo = 8 * (km >> 2) + (km & 3);
    for (int s = 0; s < nsteps; ++s) {
        if (s + 1 < nsteps) A3_STORE((s + 1) & 1);
        if (s + 2 < nsteps) A3_LOAD(s + 2);
        const LAS unsigned char* bb = lb + (s & 1) * A3_BUF;
        const bool band = s < nband; const int rb = r0A + s;
        const int nk = band ? ((rb >= r0w && rb < r0w + WIN_R) ? 1 : 0) : 2;
        for (int kq = 0; kq < nk; ++kq) {
            const int koff = band ? cb : 32 * kq;
            const LAS unsigned char* kp = bb + (koff + kmo) * A3_KROW + 16 * g;
            f32x4 s0 = {0.f, 0.f, 0.f, 0.f}, s1 = {0.f, 0.f, 0.f, 0.f};
#pragma unroll
            for (int sk = 0; sk < 4; ++sk) { const bf16x8 k0 = *(const LAS bf16x8*)(kp + 64 * sk), k1 = *(const LAS bf16x8*)(kp + 4 * A3_KROW + 64 * sk);
                s0 = __builtin_amdgcn_mfma_f32_16x16x32_bf16(k0, qf[sk], s0, 0, 0, 0); s1 = __builtin_amdgcn_mfma_f32_16x16x32_bf16(k1, qf[sk], s1, 0, 0, 0); }
            const int tq = (lane & 15) >> 2, tp = lane & 3, vsw = tq | ((((koff >> 3) + g) & 1) << 2);
            const LAS unsigned char* vb0 = bb + A3_KB + (koff + 8 * g + tq) * 256 + 8 * tp;
            bf16x8 vf[8];
#pragma unroll
            for (int db = 0; db < 8; ++db) { const int blk = (db ^ vsw) << 5;
                const s16x4 lo = __builtin_amdgcn_ds_read_tr16_b64_v4i16((LAS s16x4*)(vb0 + blk)), hi = __builtin_amdgcn_ds_read_tr16_b64_v4i16((LAS s16x4*)(vb0 + 4 * 256 + blk));
                vf[db] = (bf16x8){lo[0], lo[1], lo[2], lo[3], hi[0], hi[1], hi[2], hi[3]}; }
            float sc[8];
            if (band) { const LAS float* brow = bl + (rb - r + WIN_R - 1) * (2 * WIN_C - 1); float bv[8];
#pragma unroll
                for (int i = 0; i < 8; ++i) bv[i] = brow[bo[i]];
                asm volatile("" : "+v"(bv[0]), "+v"(bv[1]), "+v"(bv[2]), "+v"(bv[3]), "+v"(bv[4]), "+v"(bv[5]), "+v"(bv[6]), "+v"(bv[7]));
#pragma unroll
                for (int i = 0; i < 8; ++i) { const float sv = (i < 4 ? s0[i & 3] : s1[i & 3]); sc[i] = ((okm >> i) & 1u) ? sv * C1 + bv[i] : -1.0e30f; } }
            else {
#pragma unroll
                for (int i = 0; i < 8; ++i) sc[i] = (i < 4 ? s0[i & 3] : s1[i & 3]) * C1; }
            float mx = fmaxf(fmaxf(fmaxf(sc[0], sc[1]), fmaxf(sc[2], sc[3])), fmaxf(fmaxf(sc[4], sc[5]), fmaxf(sc[6], sc[7])));
            const bool resc = __any(mx > m_run + 6.0f);
            if (resc) { mx = fmaxf(mx, __shfl_xor(mx, 16)); mx = fmaxf(mx, __shfl_xor(mx, 32));
                const float m_new = fmaxf(m_run, mx); const float alpha = __builtin_amdgcn_exp2f(m_run - m_new); m_run = m_new; l_run *= alpha;
#pragma unroll
                for (int db = 0; db < 8; ++db) o[db] = o[db] * alpha; }
            float p[8], ps = 0.f;
#pragma unroll
            for (int i = 0; i < 8; ++i) { p[i] = __builtin_amdgcn_exp2f(sc[i] - m_run); ps += p[i]; }
            l_run += ps;
            u32x4p pfw; pfw.x = pkbf(p[0], p[1]); pfw.y = pkbf(p[2], p[3]); pfw.z = pkbf(p[4], p[5]); pfw.w = pkbf(p[6], p[7]);
            const bf16x8 pf = __builtin_bit_cast(bf16x8, pfw);
#pragma unroll
            for (int db = 0; db < 8; ++db) o[db] = __builtin_amdgcn_mfma_f32_16x16x32_bf16(vf[db], pf, o[db], 0, 0, 0);
        }
        __syncthreads();
    }
#undef A3_LOAD
#undef A3_STORE
    float lt = l_run; lt += __shfl_xor(lt, 16); lt += __shfl_xor(lt, 32);
    const float inv = 1.0f / lt;
#pragma unroll
    for (int db = 0; db < 8; ++db) { v2u w; w.x = pkbf(o[db][0] * inv, o[db][1] * inv); w.y = pkbf(o[db][2] * inv, o[db][3] * inv);
        *(GAS v2u*)(YALL + (size_t)(tok0 + qn) * DM + YNA + head * HD + 16 * db + 4 * g) = w; }
}

__device__ __forceinline__ void conv_item_v1(const Ctx& F, const bf16* ZIN, bf16* YALL, const float* wdw, const float* bdw, const float* lg, const float* lb, int base, int len, int t0) {
    LAS float* ut = (LAS float*)(F.lds + RING_OFF);
    const int ch = F.tid;
    { const int chunk = F.tid & 63, rsub = F.tid >> 6;
        v4u aw[4], gw[4];
#define CV_LOAD(slot_, ps_) do { const int rr_ = 8 * (ps_) + rsub, t_ = t0 - CONVW / 2 + rr_; aw[slot_] = (v4u){0u, 0u, 0u, 0u}; gw[slot_] = aw[slot_]; \
            if (rr_ < 32 + CONVW - 1 && t_ >= 0 && t_ < len) { const bf16* zp = ZIN + (size_t)(base + t_) * DIN + 8 * chunk; aw[slot_] = *(const GAS v4u*)(zp + ZA); gw[slot_] = *(const GAS v4u*)(zp + ZG); } } while (0)
#define CV_COMP(slot_, ps_) do { const int rr_ = 8 * (ps_) + rsub; \
            if (rr_ < 32 + CONVW - 1) { f32x4 u0, u1; const v4u A_ = aw[slot_], G_ = gw[slot_]; \
                u0[0] = pg8::bf_lo(A_.x) * sigm(pg8::bf_lo(G_.x)); u0[1] = pg8::bf_hi(A_.x) * sigm(pg8::bf_hi(G_.x)); u0[2] = pg8::bf_lo(A_.y) * sigm(pg8::bf_lo(G_.y)); u0[3] = pg8::bf_hi(A_.y) * sigm(pg8::bf_hi(G_.y)); \
                u1[0] = pg8::bf_lo(A_.z) * sigm(pg8::bf_lo(G_.z)); u1[1] = pg8::bf_hi(A_.z) * sigm(pg8::bf_hi(G_.z)); u1[2] = pg8::bf_lo(A_.w) * sigm(pg8::bf_lo(G_.w)); u1[3] = pg8::bf_hi(A_.w) * sigm(pg8::bf_hi(G_.w)); \
                *(LAS f32x4*)(ut + rr_ * DCONV + 8 * chunk) = u0; *(LAS f32x4*)(ut + rr_ * DCONV + 8 * chunk + 4) = u1; } } while (0)
        CV_LOAD(0, 0); CV_LOAD(1, 1); CV_LOAD(2, 2); CV_LOAD(3, 3);
#pragma unroll
        for (int s = 0; s < 8; ++s) { CV_COMP(s & 3, s); if (s + 4 < 8) CV_LOAD(s & 3, s + 4); asm volatile("" ::: "memory"); }
#undef CV_LOAD
#undef CV_COMP
    }
    float w[CONVW];
#pragma unroll
    for (int j = 0; j < CONVW; ++j) w[j] = wdw[j * DCONV + ch];
    const float bias = bdw[ch];
    __syncthreads();
    float y[32];
#pragma unroll
    for (int n = 0; n < 32; ++n) { float a = bias;
#pragma unroll
        for (int j = 0; j < CONVW; ++j) a += ut[(n + j) * DCONV + ch] * w[j];
        y[n] = a; }
    __syncthreads();
#pragma unroll
    for (int n = 0; n < 32; ++n) ut[n * DCONV + ch] = y[n];
    __syncthreads();
    { float v[4][8], s[4], q[4];
#pragma unroll
      for (int qn = 0; qn < 4; ++qn) { const int n = F.wave * 4 + qn; s[qn] = 0.f;
#pragma unroll
        for (int i = 0; i < 8; ++i) { v[qn][i] = ut[n * DCONV + F.lane + 64 * i]; s[qn] += v[qn][i]; } }
#pragma unroll
      for (int qn = 0; qn < 4; ++qn) s[qn] = wave_sum(s[qn]);
#pragma unroll
      for (int qn = 0; qn < 4; ++qn) { const float mean = s[qn] * (1.0f / DCONV); q[qn] = 0.f;
#pragma unroll
        for (int i = 0; i < 8; ++i) { v[qn][i] -= mean; q[qn] += v[qn][i] * v[qn][i]; } }
#pragma unroll
      for (int qn = 0; qn < 4; ++qn) q[qn] = wave_sum(q[qn]);
#pragma unroll
      for (int qn = 0; qn < 4; ++qn) { const int n = F.wave * 4 + qn; const float rstd = 1.0f / sqrtf(q[qn] * (1.0f / DCONV) + LN_EPS);
#pragma unroll
        for (int i = 0; i < 8; ++i) { const int c2 = F.lane + 64 * i; const float z = v[qn][i] * rstd * lg[c2] + lb[c2]; YALL[(size_t)(base + t0 + n) * DM + YC + c2] = DIAG_ZERO_C ? (bf16)0 : (bf16)f2bf(z * sigm(z)); } } }
    __syncthreads();
}

__device__ __forceinline__ void four_cs_table(const Ctx& F, LAS f32x2* cs) { if (F.tid < 128) { float s, c; sincospif((float)F.tid * (1.0f / 64.0f), &s, &c); cs[F.tid] = (f32x2){c, s}; } }
__device__ __forceinline__ void fourAB_ctx_v3(const Ctx& F, const bf16* ZIN, unsigned* FY2s, int nq, int grp) {
    constexpr int N1 = CTX / GRID_W;
    LAS f32x2* tab = (LAS f32x2*)(F.lds + RING_OFF);
    LAS f32x2* tw = (LAS f32x2*)(F.lds + RING_OFF + 1024);
    LAS unsigned char* fin = F.lds + RING_OFF + 2048;
    LAS unsigned* XO = (LAS unsigned*)(F.lds + RING_OFF + 8192);
    if (F.tid < 128) { float s, c; sincospif((float)F.tid * (1.0f / 64.0f), &s, &c); tab[F.tid] = (f32x2){c, s}; }
    else if (F.tid < 144) { const int e = F.tid - 128, jj = e >> 2, k1 = e & 3; float s, c; sincospif(2.0f * (float)((4 * nq + jj) * k1) / (float)(N1 * GRID_W), &s, &c); tw[e] = (f32x2){c, s}; }
    else if (F.tid >= 256) { const int e = F.tid - 256, r = e >> 4, chn = e & 15, jj = r >> 2, n1 = r & 3;
        *(LAS v4u*)(fin + r * 272 + 16 * chn) = *(const GAS v4u*)(ZIN + (size_t)(SEQ + n1 * GRID_W + 4 * nq + jj) * DIN + ZF + grp * FG + 8 * chn); }
    __syncthreads();
    const int lane = F.lane, g = lane >> 4, cp = 16 * F.wave + (lane & 15);
    f32x4 Zc = {0.f, 0.f, 0.f, 0.f}, Zs = {0.f, 0.f, 0.f, 0.f};
#pragma unroll
    for (int s = 0; s < 4; ++s) { float cv[8], sv[8];
#pragma unroll
        for (int j = 0; j < 8; ++j) { const f32x2 t = tab[((32 * s + 8 * g + j) * cp) & 127]; cv[j] = t.x; sv[j] = t.y; }
        const bf16x8 bc = __builtin_bit_cast(bf16x8, pk8(cv)), bs = __builtin_bit_cast(bf16x8, pk8(sv));
        const bf16x8 a = *(const LAS bf16x8*)(fin + (lane & 15) * 272 + 64 * s + 16 * g);
        Zc = __builtin_amdgcn_mfma_f32_16x16x32_bf16(a, bc, Zc, 0, 0, 0); Zs = __builtin_amdgcn_mfma_f32_16x16x32_bf16(a, bs, Zs, 0, 0, 0); }
#pragma unroll
    for (int k1 = 0; k1 < N1; ++k1) { float yr = 0.f, yi = 0.f;
#pragma unroll
        for (int n1 = 0; n1 < N1; ++n1) { const int m = (k1 * n1) & 3; const float c4 = (m == 0) ? 1.f : (m == 2 ? -1.f : 0.f), s4 = (m == 1) ? 1.f : (m == 3 ? -1.f : 0.f);
            const float a = Zc[n1], b = Zs[n1]; yr += c4 * a - s4 * b; yi -= c4 * b + s4 * a; }
        const f32x2 t = tw[g * 4 + k1]; const float ct = t.x, st = t.y;
        XO[(k1 * 128 + cp) * 4 + g] = pkbf(yr * ct + yi * st, yi * ct - yr * st); }
    __syncthreads();
    { const int k1 = F.tid >> 7, c2 = F.tid & 127; *(GAS v4u*)(FY2s + fy2_idx(k1, grp, c2, 4 * nq)) = *(const LAS v4u*)(XO + 4 * F.tid); }
    __syncthreads();
}
__device__ __forceinline__ void fourAB_ctx_v2(const Ctx& F, const bf16* ZIN, unsigned* FY2s, int nq, int grp, int half) {
    constexpr int N1 = CTX / GRID_W;
    LAS f32x2* cs = (LAS f32x2*)(F.lds + RING_OFF); LAS bf16* fin = (LAS bf16*)(F.lds + RING_OFF + 1024);
    LAS float* Fc = (LAS float*)(F.lds + RING_OFF + 1024 + 4096); LAS float* Fs = Fc + 1024;
    LAS unsigned* XO = (LAS unsigned*)(F.lds + RING_OFF + 1024 + 3 * 4096);
    four_cs_table(F, cs);
#pragma unroll
    for (int i = 0; i < 4; ++i) { const int idx = F.tid + 512 * i, jj = idx >> 9, n1 = (idx >> 7) & 3, c = idx & 127; fin[idx] = ZIN[(size_t)(SEQ + n1 * GRID_W + 4 * nq + jj) * DIN + ZF + grp * FG + c]; }
    __syncthreads();
    const int cpp = F.tid & 63, h2 = (F.tid >> 6) & 1, j = F.tid >> 7, cp = half * 64 + cpp, n2 = 4 * nq + j;
#pragma unroll
    for (int u = 0; u < 2; ++u) { const int n1 = 2 * h2 + u; float fc = 0.f, fs = 0.f;
        for (int c = 0; c < 128; ++c) { const float x = bf2f(fin[(j * 4 + n1) * 128 + c]); const f32x2 t = cs[(c * cp) & 127]; fc += x * t.x; fs += x * t.y; }
        Fc[(j * 4 + n1) * 64 + cpp] = fc; Fs[(j * 4 + n1) * 64 + cpp] = fs; }
    __syncthreads();
    const int tstep = 128 / N1;
#pragma unroll
    for (int u = 0; u < 2; ++u) { const int k1 = 2 * h2 + u; float yr = 0.f, yi = 0.f;
#pragma unroll
        for (int n1 = 0; n1 < N1; ++n1) { const f32x2 t = cs[((k1 * n1) & (N1 - 1)) * tstep]; const float a = Fc[(j * 4 + n1) * 64 + cpp], b = Fs[(j * 4 + n1) * 64 + cpp]; yr += t.x * a - t.y * b; yi -= t.x * b + t.y * a; }
        float st, ct; sincospif(2.0f * (float)(n2 * k1) / (float)(N1 * GRID_W), &st, &ct);
        XO[(k1 * 64 + cpp) * 4 + j] = pkbf(yr * ct + yi * st, yi * ct - yr * st); }
    __syncthreads();
    if (F.tid < 256) { const int k1 = F.tid >> 6, c2 = F.tid & 63; *(GAS v4u*)(FY2s + fy2_idx(k1, grp, half * 64 + c2, 4 * nq)) = *(const LAS v4u*)(XO + 4 * F.tid); }
    __syncthreads();
}
__device__ __forceinline__ void fourC_item_v1(const Ctx& F, const float* FY, bf16* YALL, int base, int N1, int k1, int grp) {
    LAS f32x2* cs = (LAS f32x2*)(F.lds + RING_OFF); LAS f32x2* Yt = (LAS f32x2*)(F.lds + RING_OFF + 1024);
    four_cs_table(F, cs);
    for (int idx = F.tid; idx < 64 * 128; idx += 512) { const int n2 = idx >> 7, cp = idx & 127; Yt[idx] = *(const GAS f32x2*)(FY + ((size_t)(base + k1 * GRID_W + n2) * DFOUR + grp * FG + cp) * 2); }
    __syncthreads();
    const int cp = F.tid & 127, kg = F.tid >> 7; const float norm = 1.0f / sqrtf((float)(N1 * GRID_W * FG));
    for (int k2 = kg; k2 < 64; k2 += 4) { float a = 0.f;
        for (int n2 = 0; n2 < 64; ++n2) { const f32x2 t = cs[((n2 * k2) & 63) * 2]; const f32x2 y = Yt[n2 * 128 + cp]; a += t.x * y.x + t.y * y.y; }
        YALL[(size_t)(base + k1 + N1 * k2) * DM + YF + grp * FG + cp] = (bf16)f2bf(a * norm); }
    __syncthreads();
}

#if MK_DIAG
constexpr int CW_DIAG = 64;
__device__ __forceinline__ unsigned dg_hash(unsigned x) { x ^= x >> 16; x *= 0x7feb352du; x ^= x >> 15; x *= 0x846ca68bu; x ^= x >> 16; return x; }
__device__ __forceinline__ void dg_fail(unsigned char* ws, int id) { atomicMax((unsigned*)(ws + WS_CTL) + CW_DIAG, (unsigned)(200 - id)); }
__device__ __forceinline__ bool dg_bad(float got, float exp, float rel, float ab) { return !(fabsf(got - exp) <= ab + rel * fabsf(exp)); }
__device__ __forceinline__ float dg_dot(const bf16* a, const bf16* b, int K, int lane) { float s = 0.f; for (int k = lane; k < K; k += 64) s += bf2f(a[k]) * bf2f(b[k]); return wave_sum(s); }

__global__ void __launch_bounds__(256) dg_gemm(Args a, int mode, int l, int f, int nrows, int id, float gmul, int gi) {
    unsigned char* ws = a.ws; unsigned char* wl = ws + WS_W + (size_t)l * WL_SIZE; const int lane = threadIdx.x & 63;
    const int smp = blockIdx.x * 4 + (threadIdx.x >> 6);
    const unsigned h1 = dg_hash(smp * 2 + 1 + 7919u * id), h2 = dg_hash(smp * 2 + 2 + 104729u * id);
    const int row = h1 % nrows;
    const bf16* H = (const bf16*)(ws + WS_H); const bf16* G = (const bf16*)(ws + WS_G); const bf16* YALL = (const bf16*)(ws + WS_YALL); const bf16* MB = (const bf16*)(ws + WS_MB); const bf16* GATES = (const bf16*)(ws + WS_GATES);
    if (mode == 0) { const int c = h2 % DFF; const bf16* W = (const bf16*)(wl + (f == 0 ? WL_W13A : WL_W13B));
        const float av = dg_dot(H + (size_t)row * DM, W + (size_t)((c / 128) * 256 + c % 128) * DM, DM, lane), bv = dg_dot(H + (size_t)row * DM, W + (size_t)((c / 128) * 256 + 128 + c % 128) * DM, DM, lane);
        const float exp = av * sigm(av) * bv, got = bf2f(G[(size_t)row * DFF + c]);
        if (lane == 0 && dg_bad(got, exp, 1e-2f, 2e-3f)) dg_fail(ws, id); }
    else if (mode == 1) { const int c = h2 % DM; float d;
        if (gi == 5 && gmul == 1.0f) d = dg_dot(MB + (size_t)row * DM, (const bf16*)(wl + WL_WO) + (size_t)c * DM, DM, lane);
        else d = dg_dot(G + (size_t)row * DFF, (const bf16*)(wl + (f == 0 ? WL_W2A : WL_W2B)) + (size_t)c * DFF, DFF, lane);
        const float gate = mod_vec(ws, l, row >= SEQ ? 1 : 0, gi)[c];
        const float exp = gmul * gate * d, got = bf2f(((const bf16*)(ws + WS_T))[(size_t)row * DM + c]);
        if (lane == 0 && dg_bad(got, exp, 1e-2f, 1e-3f)) dg_fail(ws, id); }
    else if (mode == 2) { const int c = h2 % DIN;
        const float exp = dg_dot(H + (size_t)row * DM, (const bf16*)(wl + WL_WIN) + (size_t)c * DM, DM, lane), got = bf2f(((const bf16*)(ws + WS_ZIN))[(size_t)row * DIN + c]);
        if (lane == 0 && dg_bad(got, exp, 1e-2f, 2e-3f)) dg_fail(ws, id); }
    else if (mode == 3) { const int c = h2 % (3 * DM);
        const float pre = dg_dot(H + (size_t)row * DM, (const bf16*)(wl + WL_WG) + (size_t)c * DM, DM, lane) + a.in[I_BGATE][(size_t)l * 3 * DM + c];
        const float exp = sigm(pre), got = bf2f(GATES[(size_t)row * 3 * DM + c]);
        if (lane == 0 && dg_bad(got, exp, 1e-2f, 2e-3f)) { dg_fail(ws, id); unsigned* D = (unsigned*)(ws + WS_CTL) + CW_DIAG; atomicAdd(D + 2, 1u);
            const float bias = a.in[I_BGATE][(size_t)l * 3 * DM + c]; int hyp = 4;
            if (!dg_bad(got, sigm(pre - bias), 1e-2f, 2e-3f)) hyp = 1; else if (!dg_bad(got, pre, 1e-2f, 2e-3f)) hyp = 2; else if (got == 0.5f || got < 1e-6f) hyp = 3;
            atomicAdd(D + 4 + hyp, 1u); atomicMax(D + 10, (unsigned)(100 - row / 256)); } }
    else { const int c = h2 % DM; const bf16* W = (const bf16*)(wl + WL_WB) + (size_t)c * DM; const bf16* y = YALL + (size_t)row * DM;
        const float p0 = dg_dot(y, W, DNA, lane), p1 = dg_dot(y + DNA, W + DNA, DFOUR, lane), p2 = dg_dot(y + DNA + DFOUR, W + DNA + DFOUR, DCONV, lane);
        const float g0 = bf2f(GATES[(size_t)row * 3 * DM + c]), g1 = bf2f(GATES[(size_t)row * 3 * DM + DM + c]), g2 = bf2f(GATES[(size_t)row * 3 * DM + 2 * DM + c]);
        const float exp = g0 * p0 + g1 * p1 + g2 * p2, got = bf2f(MB[(size_t)row * DM + c]);
        if (lane == 0 && dg_bad(got, exp, 1.5e-2f, 3e-3f)) dg_fail(ws, id); }
}
__global__ void __launch_bounds__(256) dg_trans(Args a, int id, int l, unsigned wmask) {
    unsigned char* ws = a.ws; const int t = blockIdx.x * 256 + threadIdx.x; const int which = (t >> 1) % 12; if (!((wmask >> which) & 1u)) return; const unsigned h1 = dg_hash(t * 3 + 1), h2 = dg_hash(t * 3 + 2);
    unsigned char* wl = ws + WS_W + (size_t)l * WL_SIZE; float src; bf16 got;
    if (which < 6) { const int ff = which / 3, w = which % 3;
        if (w < 2) { const int k = h1 % DM, n = h2 % DFF; src = a.in[(ff ? I_F2W1 : I_F1W1) + w][(size_t)l * DM * DFF + (size_t)k * DFF + n]; got = ((const bf16*)(wl + (ff ? WL_W13B : WL_W13A)))[(size_t)((n / 128) * 256 + w * 128 + n % 128) * DM + k]; }
        else { const int k = h1 % DFF, n = h2 % DM; src = a.in[ff ? I_F2W2 : I_F1W2][(size_t)l * DFF * DM + (size_t)k * DM + n]; got = ((const bf16*)(wl + (ff ? WL_W2B : WL_W2A)))[(size_t)n * DFF + k]; } }
    else if (which == 6) { const int k = h1 % DM, n = h2 % DIN; src = a.in[I_WIN][(size_t)l * DM * DIN + (size_t)k * DIN + n]; got = ((const bf16*)(wl + WL_WIN))[(size_t)n * DM + k]; }
    else if (which == 7) { const int k = h1 % DM, n = h2 % (3 * DM); src = a.in[I_WGATE][(size_t)l * DM * 3 * DM + (size_t)k * 3 * DM + n]; got = ((const bf16*)(wl + WL_WG))[(size_t)n * DM + k]; }
    else if (which == 8) { const int k = h1 % DNA, n = h2 % DM; src = a.in[I_WBNA][(size_t)l * DNA * DM + (size_t)k * DM + n]; got = ((const bf16*)(wl + WL_WB))[(size_t)n * DM + k]; }
    else if (which == 9) { const int k = h1 % DFOUR, n = h2 % DM; src = a.in[I_WBF][(size_t)l * DFOUR * DM + (size_t)k * DM + n]; got = ((const bf16*)(wl + WL_WB))[(size_t)n * DM + DNA + k]; }
    else if (which == 10) { const int k = h1 % DCONV, n = h2 % DM; src = a.in[I_WBC][(size_t)l * DCONV * DM + (size_t)k * DM + n]; got = ((const bf16*)(wl + WL_WB))[(size_t)n * DM + DNA + DFOUR + k]; }
    else { const int k = h1 % DM, n = h2 % DM; src = a.in[I_WO][(size_t)l * DM * DM + (size_t)k * DM + n]; got = ((const bf16*)(wl + WL_WO))[(size_t)n * DM + k]; }
    if (got != (bf16)f2bf(src)) dg_fail(ws, id);
}
__global__ void __launch_bounds__(256) dg_mod(Args a, int id) {
    unsigned char* ws = a.ws; const int lane = threadIdx.x & 63; const int smp = blockIdx.x * 4 + (threadIdx.x >> 6);
    const int l = smp & 1, s = (smp >> 1) & 1, j = dg_hash(smp) % (NMODU * DM);
    const float* cv = s ? a.in[I_CCTX] : a.in[I_C]; float acc = 0.f;
    for (int k = lane; k < DM; k += 64) { const float c = cv[k]; acc += c * sigm(c) * a.in[I_WADA][(size_t)l * DM * ADA_N + (size_t)k * ADA_N + j]; }
    acc = wave_sum(acc) + a.in[I_BADA][(size_t)l * ADA_N + j];
    const float got = ((const float*)(ws + WS_MOD))[(size_t)(l * 2 + s) * (NMODU * DM) + j];
    if (lane == 0 && dg_bad(got, acc, 1e-4f, 1e-4f)) dg_fail(ws, id);
    const int row = dg_hash(smp + 77777u) % MTOT, col = dg_hash(smp + 99991u) % DM; const int sx = row >= SEQ;
    const float xv = sx ? a.in[I_CTX][(size_t)(row - SEQ) * DM + col] : a.in[I_X][(size_t)row * DM + col];
    const float sh = mod_vec(ws, 0, sx, 0)[col], sc = mod_vec(ws, 0, sx, 1)[col];
    if (lane == 0 && (dg_bad((float)((const xh*)(ws + WS_X))[(size_t)row * DM + col], xv, 1e-3f, 1e-4f) || dg_bad(bf2f(((const bf16*)(ws + WS_H))[(size_t)row * DM + col]), xv * (1.f + sc) + sh, 1e-2f, 1e-3f))) dg_fail(ws, id + 1);
}
__global__ void __launch_bounds__(256) dg_ln(Args a, int l, int which, int nrows, int final_out, int id) {
    unsigned char* ws = a.ws; const int lane = threadIdx.x & 63; const int smp = blockIdx.x * 4 + (threadIdx.x >> 6); const int row = dg_hash(smp + 31u * id) % nrows;
    const float* Xo32 = a.out + (size_t)row * DM; const xh* Xo16 = (const xh*)(ws + WS_X) + (size_t)row * DM;
#define Xo(k_) (final_out ? Xo32[k_] : (float)Xo16[k_])
    const float* lg = a.in[I_LNG] + (size_t)(l * 3 + which) * DM; const float* lb = a.in[I_LNB] + (size_t)(l * 3 + which) * DM;
    float s = 0.f, q = 0.f;
    for (int k = lane; k < DM; k += 64) { const float z = (Xo(k) - lb[k]) / lg[k]; s += z; q += z * z; }
    s = wave_sum(s) / DM; q = wave_sum(q) / DM; bool bad = fabsf(s) > 1e-3f || fabsf(q - 1.0f) > 1e-2f;
    const int ml = which == 2 ? l + 1 : l, mi = which == 2 ? 0 : 3, sx = row >= SEQ;
    if (!final_out) for (int k = lane; k < DM; k += 64) { const float h = Xo(k) * (1.f + mod_vec(ws, ml, sx, mi + 1)[k]) + mod_vec(ws, ml, sx, mi)[k]; bad |= dg_bad(bf2f(((const bf16*)(ws + WS_H))[(size_t)row * DM + k]), h, 1e-2f, 2e-3f); }
    if (bad) dg_fail(ws, id);
#undef Xo
}
__global__ void __launch_bounds__(256) dg_attn(Args a, int l, int ntok, int id) {
    __shared__ float P[4][384];
    unsigned char* ws = a.ws; const int lane = threadIdx.x & 63, wv = threadIdx.x >> 6; const int smp = blockIdx.x * 4 + wv;
    const int tok = dg_hash(smp * 2 + 5u) % ntok, head = dg_hash(smp * 2 + 6u) % NH; const bf16* Z = (const bf16*)(ws + WS_ZIN);
    const float* rpb = a.in[I_RPB] + (size_t)l * NH * 15 * 31;
    const int r = tok / 64, c = tok % 64, r0 = min(max(r - 4, 0), 120), c0 = min(max(c - 8, 0), 48); const bool cx = tok >= SEQ; const int nk = cx ? 256 : 384;
    float mx = -1e30f;
    for (int kk = lane; kk < nk; kk += 64) { int kt; float bias = 0.f;
        if (!cx && kk < 128) { const int kr = r0 + kk / 16, kc = c0 + kk % 16; kt = kr * 64 + kc; bias = rpb[(head * 15 + (kr - r + 7)) * 31 + (kc - c + 15)]; } else kt = SEQ + (cx ? kk : kk - 128);
        float d = 0.f; for (int e = 0; e < 128; ++e) d += bf2f(Z[(size_t)tok * DIN + head * 128 + e]) * bf2f(Z[(size_t)kt * DIN + 1024 + head * 128 + e]);
        d = d * 0.08838834764831845f + bias; P[wv][kk] = d; mx = fmaxf(mx, d); }
    mx = wave_max(mx); float sum = 0.f;
    for (int kk = lane; kk < nk; kk += 64) { const float e = expf(P[wv][kk] - mx); P[wv][kk] = e; sum += e; }
    sum = wave_sum(sum); __syncthreads(); bool bad = false;
    for (int d = lane; d < 128; d += 64) { float o = 0.f;
        for (int kk = 0; kk < nk; ++kk) { int kt; if (!cx && kk < 128) kt = (r0 + kk / 16) * 64 + c0 + kk % 16; else kt = SEQ + (cx ? kk : kk - 128); o += P[wv][kk] * bf2f(Z[(size_t)kt * DIN + 2048 + head * 128 + d]); }
        o /= sum; bad |= dg_bad(bf2f(((const bf16*)(ws + WS_YALL))[(size_t)tok * DM + head * 128 + d]), o, 1e-2f, 2e-3f); }
    if (bad) dg_fail(ws, id);
}
__global__ void __launch_bounds__(256) dg_conv(Args a, int l, int ntok, int id) {
    unsigned char* ws = a.ws; const int lane = threadIdx.x & 63; const int smp = blockIdx.x * 4 + (threadIdx.x >> 6); const int tok = dg_hash(smp + 1234567u) % ntok;
    const bf16* Z = (const bf16*)(ws + WS_ZIN); const int base = tok >= SEQ ? SEQ : 0, len = tok >= SEQ ? CTX : SEQ, t = tok - base;
    float y[8]; float s = 0.f;
#pragma unroll
    for (int i = 0; i < 8; ++i) { const int ch = lane + 64 * i; float acc = a.in[I_BDW][l * DCONV + ch];
        for (int j = 0; j < CONVW; ++j) { const int tt = t + j - 15; if (tt >= 0 && tt < len) { const float av = bf2f(Z[(size_t)(base + tt) * DIN + 3584 + ch]), gv = bf2f(Z[(size_t)(base + tt) * DIN + 4096 + ch]); acc += av * sigm(gv) * a.in[I_WDW][(size_t)l * CONVW * DCONV + j * DCONV + ch]; } }
        y[i] = acc; s += acc; }
    const float mean = wave_sum(s) / DCONV; float q = 0.f;
#pragma unroll
    for (int i = 0; i < 8; ++i) { const float d = y[i] - mean; q += d * d; }
    const float rstd = 1.0f / sqrtf(wave_sum(q) / DCONV + LN_EPS); bool bad = false;
#pragma unroll
    for (int i = 0; i < 8; ++i) { const int ch = lane + 64 * i; const float z = (y[i] - mean) * rstd * a.in[I_CLNG][l * DCONV + ch] + a.in[I_CLNB][l * DCONV + ch];
        bad |= dg_bad(bf2f(((const bf16*)(ws + WS_YALL))[(size_t)tok * DM + 1536 + ch]), z * sigm(z), 1e-2f, 3e-3f); }
    if (bad) dg_fail(ws, id);
}
__global__ void __launch_bounds__(256) dg_four(Args a, int ntok, int id) {
    unsigned char* ws = a.ws; const int lane = threadIdx.x & 63; const int smp = blockIdx.x * 4 + (threadIdx.x >> 6);
    const int tok = smp == 0 ? 0 : (int)(dg_hash(smp + 424242u) % ntok), col = dg_hash(smp + 31337u) % DFOUR; const int grp = col / 128, cp = col % 128;
    const int base = tok >= SEQ ? SEQ : 0, N = tok >= SEQ ? CTX : SEQ, k = tok - base; const bf16* Z = (const bf16*)(ws + WS_ZIN);
    float acc = 0.f;
    for (int n = lane; n < N; n += 64) { const int pn = (int)(((long)n * k) % N);
        for (int c = 0; c < 128; ++c) { const float ang = 2.0f * (float)pn / (float)N + 2.0f * (float)((c * cp) & 127) / 128.0f; acc += bf2f(Z[(size_t)(base + n) * DIN + 3072 + grp * 128 + c]) * cospif(ang); } }
    acc = wave_sum(acc) / sqrtf((float)N * 128.f);
    const float gotf = bf2f(((const bf16*)(ws + WS_YALL))[(size_t)tok * DM + 1024 + col]);
    if (lane == 0 && dg_bad(gotf, acc, 2e-2f, 1e-2f)) dg_fail(ws, id);
    if (lane == 0 && DIAG_PREC == 3 && tok != 0 && tok != SEQ) { float* D = (float*)((unsigned*)(ws + WS_CTL) + CW_DIAG + 8); atomicAdd(D, (gotf - acc) * (gotf - acc)); atomicAdd(D + 1, acc * acc); }
}

__global__ void __launch_bounds__(256) dg_prec_up(Args a) {
    unsigned char* ws = a.ws; const int lane = threadIdx.x & 63; const int smp = blockIdx.x * 4 + (threadIdx.x >> 6);
    const int row = dg_hash(smp * 2 + 11u) % SEQ, c = dg_hash(smp * 2 + 12u) % DFF;
    const float* x = a.in[I_X] + (size_t)row * DM; const float* sh = mod_vec(ws, 0, 0, 0); const float* sc = mod_vec(ws, 0, 0, 1);
    float av = 0.f, bv = 0.f;
    for (int k = lane; k < DM; k += 64) { const float h = x[k] * (1.f + sc[k]) + sh[k]; av += h * a.in[I_F1W1][(size_t)k * DFF + c]; bv += h * a.in[I_F1W3][(size_t)k * DFF + c]; }
    av = wave_sum(av); bv = wave_sum(bv);
    const float exp = av * sigm(av) * bv, got = bf2f(((const bf16*)(ws + WS_G))[(size_t)row * DFF + c]);
    if (lane == 0) { float* D = (float*)((unsigned*)(ws + WS_CTL) + CW_DIAG + 8); atomicAdd(D, (got - exp) * (got - exp)); atomicAdd(D + 1, exp * exp); }
}

__global__ void __launch_bounds__(256) dg_prec_dn(Args a) {
    __shared__ float red[256]; __shared__ float hs[DM];
    unsigned char* ws = a.ws; const int tid = threadIdx.x; const int smp = blockIdx.x;
    const int row = dg_hash(smp * 2 + 21u) % SEQ, c = dg_hash(smp * 2 + 22u) % DM;
    const float* x = a.in[I_X] + (size_t)row * DM; const float* sh = mod_vec(ws, 0, 0, 0); const float* sc = mod_vec(ws, 0, 0, 1);
    for (int k = tid; k < DM; k += 256) hs[k] = x[k] * (1.f + sc[k]) + sh[k];
    __syncthreads();
    float y = 0.f;
    for (int j = tid; j < DFF; j += 256) { float av = 0.f, bv = 0.f;
        for (int k = 0; k < DM; ++k) { const float h = hs[k]; av += h * a.in[I_F1W1][(size_t)k * DFF + j]; bv += h * a.in[I_F1W3][(size_t)k * DFF + j]; }
        y += av * sigm(av) * bv * a.in[I_F1W2][(size_t)j * DM + c]; }
    red[tid] = y; __syncthreads();
    for (int s = 128; s > 0; s >>= 1) { if (tid < s) red[tid] += red[tid + s]; __syncthreads(); }
    if (tid == 0) { const float exp = 0.5f * mod_vec(ws, 0, 0, 2)[c] * red[0], got = bf2f(((const bf16*)(ws + WS_T))[(size_t)row * DM + c]);
        float* D = (float*)((unsigned*)(ws + WS_CTL) + CW_DIAG + 8); atomicAdd(D, (got - exp) * (got - exp)); atomicAdd(D + 1, exp * exp); }
}

__global__ void __launch_bounds__(256) dg_prec_mix(Args a) {
    __shared__ float red[256]; __shared__ float hs[DM]; __shared__ float ms[DM];
    unsigned char* ws = a.ws; const int tid = threadIdx.x; const int smp = blockIdx.x;
    const int row = dg_hash(smp * 2 + 31u) % SEQ, c = dg_hash(smp * 2 + 32u) % DM;
    const xh* x = (const xh*)(ws + WS_X) + (size_t)row * DM; const float* sh = mod_vec(ws, 0, 0, 3); const float* sc = mod_vec(ws, 0, 0, 4);
    const bf16* y = (const bf16*)(ws + WS_YALL) + (size_t)row * DM;
    for (int k = tid; k < DM; k += 256) hs[k] = (float)x[k] * (1.f + sc[k]) + sh[k];
    __syncthreads();
    for (int i = tid; i < DM; i += 256) { float g[3];
        for (int b = 0; b < 3; ++b) { float pre = a.in[I_BGATE][b * DM + i]; for (int k = 0; k < DM; ++k) pre += hs[k] * a.in[I_WGATE][(size_t)k * 3 * DM + b * DM + i]; g[b] = sigm(pre); }
        float p0 = 0.f, p1 = 0.f, p2 = 0.f;
        for (int k = 0; k < DNA; ++k) p0 += bf2f(y[k]) * a.in[I_WBNA][(size_t)k * DM + i];
        for (int k = 0; k < DFOUR; ++k) p1 += bf2f(y[DNA + k]) * a.in[I_WBF][(size_t)k * DM + i];
        for (int k = 0; k < DCONV; ++k) p2 += bf2f(y[DNA + DFOUR + k]) * a.in[I_WBC][(size_t)k * DM + i];
        ms[i] = g[0] * p0 + g[1] * p1 + g[2] * p2; }
    __syncthreads();
    float o = 0.f; for (int i = tid; i < DM; i += 256) o += ms[i] * a.in[I_WO][(size_t)i * DM + c];
    red[tid] = o; __syncthreads();
    for (int s = 128; s > 0; s >>= 1) { if (tid < s) red[tid] += red[tid + s]; __syncthreads(); }
    if (tid == 0) { const float exp = mod_vec(ws, 0, 0, 5)[c] * red[0], got = bf2f(((const bf16*)(ws + WS_T))[(size_t)row * DM + c]);
        float* D = (float*)((unsigned*)(ws + WS_CTL) + CW_DIAG + 8); atomicAdd(D, (got - exp) * (got - exp)); atomicAdd(D + 1, exp * exp); }
}
__global__ void dg_final(Args a) { const unsigned* D = (const unsigned*)(a.ws + WS_CTL) + CW_DIAG; const unsigned d = D[0];
    const float* P = (const float*)(D + 8);
    if (P[1] > 0.f) { a.out[0] = 1000.0f * rintf(-10.0f * log10f(sqrtf(P[0] / P[1]))); return; }
    if (d) { float code = (float)(200 - (int)d);
        a.out[0] = 1000.0f * code; } }
#endif

#ifndef DIAG_SKIP_FC
#define DIAG_SKIP_FC 0
#endif
#ifndef PROBE_REPEAT_MASK
#define PROBE_REPEAT_MASK 0u
#endif
#define REPN(id) (1 + (int)(((PROBE_REPEAT_MASK) >> (id)) & 1u))
#ifndef PROBE_EXTRA_BARRIERS
#ifndef PROBE_MIXA
#define PROBE_MIXA 0
#endif
#define PROBE_EXTRA_BARRIERS 0
#endif
#ifndef PROBE_REPEAT_MIX
#define PROBE_REPEAT_MIX 0
#endif
#ifndef PH_MASK
#define PH_MASK 0xFFFFFFFFu
#endif
#define PH_ON(id) (((PH_MASK) >> (id)) & 1u)
constexpr int N_PHASES = 28;
constexpr int CTXK_DN = 22, CTXK_O = 8;
constexpr size_t FY2_CTX = (size_t)NROWS * 4 * FG * GRID_W;
__device__ __forceinline__ Ctx ctx_local(const Ctx& F) { Ctx L = F; L.lane = hw_lane(); L.tid = (F.wave << 6) | L.lane; return L; }

__device__ __forceinline__ void site_up(const Ctx& F, int l, int f, int nM) {
    const KAp ka = ka_opaque(); unsigned char* const ws = ka->ws; unsigned char* wl = ws + WS_W + (size_t)l * WL_SIZE;
    pg8::Gemm g{(const bf16*)(ws + WS_H), (const bf16*)(wl + (f == 0 ? WL_W13A : WL_W13B)), 0, 0, DM, DM}; pg8::StaticOrder S; S.init(nM, 2 * DFF / 256, F.G, F.bx, DM / 64);
    pg8::EpiSwiGLU E{(bf16*)(ws + WS_G), DFF};
    pg8::gemm_phase<pg8::EpiSwiGLU, pg8::StaticOrder, true, true>(F.lds + RING_OFF, g, S, E, F.wave);
    helper_convert(F, (nM * (2 * DFF / 256)) % F.G, l, w2_lo(f), TI_FF);
}
__device__ __forceinline__ void site_down(const Ctx& F, int l, int f, int nM) {
    const KAp ka = ka_opaque(); unsigned char* const ws = ka->ws; unsigned char* wl = ws + WS_W + (size_t)l * WL_SIZE;
    const int gi = f == 0 ? 2 : 5;
    const bf16* Gb = (const bf16*)(ws + WS_G); const bf16* W2 = (const bf16*)(wl + (f == 0 ? WL_W2A : WL_W2B));
    pg8::Gemm g{Gb, W2, 0, 0, DFF, DFF};
    pg8::OrderPlus S; S.base.init(32, DM / 256, F.G, F.bx, DFF / 64); S.ext.init((nM == 33) ? 1 : 0, DM / 256, F.G, F.bx, 0); S.chunks = CTXK_DN; S.ntc = DFF / 64 / CTXK_DN; S.pmx = 32;
    pg8::EpiDelta E{(bf16*)(ws + WS_T), DM, mod_vec(ws, l, 0, gi), mod_vec(ws, l, 1, gi), 0.5f, (long)((WS_PART - WS_T) / 2)};
    pg8::gemm_phase<pg8::EpiDelta, pg8::OrderPlus, true, true>(F.lds + RING_OFF, g, S, E, F.wave);
}
__device__ __forceinline__ void site_ln(const Ctx& F0, int l, int which, int nrows, bool final_out) {
    const Ctx F = ctx_local(F0);
    const KAp ka = ka_opaque(); unsigned char* const ws = ka->ws;
    const float* lg = ka->in[I_LNG] + (size_t)(l * 3 + which) * DM; const float* lb = ka->in[I_LNB] + (size_t)(l * 3 + which) * DM;
    const int ml = which == 2 ? l + 1 : l, mi = which == 2 ? 0 : 3;
    const int gi = which == 0 ? 2 : 5; const float gmul = which == 1 ? 1.0f : 0.5f; const int nparts = which == 1 ? CTXK_O : CTXK_DN;
    if (final_out) ln_phase(F, (const bf16*)(ws + WS_T), ka->out, nullptr, nullptr, lg, lb, nullptr, nullptr, nullptr, nullptr, nrows, (const xh*)(ws + WS_X), nullptr, 0, nullptr, 0.f);
    else ln_phase(F, (const bf16*)(ws + WS_T), nullptr, (xh*)(ws + WS_X), (bf16*)(ws + WS_H), lg, lb, mod_vec(ws, ml, 0, mi), mod_vec(ws, ml, 0, mi + 1), mod_vec(ws, ml, 1, mi), mod_vec(ws, ml, 1, mi + 1), nrows,
                  (const xh*)(ws + WS_X), nrows > SEQ ? (const bf16*)(ws + WS_PART) : nullptr, nparts, mod_vec(ws, l, 1, gi), gmul);
}
__device__ __forceinline__ void site_in(const Ctx& F, int l, bool last) {
    const KAp ka = ka_opaque(); unsigned char* const ws = ka->ws; unsigned char* wl = ws + WS_W + (size_t)l * WL_SIZE;
    const bf16* Hb = (const bf16*)(ws + WS_H);
    pg8::Gemm g{Hb, (const bf16*)(wl + WL_WIN), 0, (long)WL_WG - (long)WL_WIN, DM, DM};
    pg8::OrderPlus S; S.base.init(33, DIN / 256, F.G, F.bx, DM / 64); S.ext.init(last ? 0 : 1, 3 * DM / 256, F.G, F.bx, 0); S.chunks = 1; S.ntc = DM / 64; S.pmx = 32;
    pg8::EpiBf16<2> E{(bf16*)(ws + WS_ZIN), DIN, ka->in[I_BGATE] + (size_t)l * 3 * DM, (bf16*)(ws + WS_GATES), 3 * DM};
    pg8::gemm_phase<pg8::EpiBf16<2>, pg8::OrderPlus, true, true>(F.lds + RING_OFF, g, S, E, F.wave);
    { const int q0 = last ? 3 * TI_FF : 0; helper_convert(F, (33 * (DIN / 256) + (last ? 0 : 3 * DM / 256)) % F.G, 1, q0, 2 * TI_FF); }
}
__device__ __forceinline__ void site_mixA(const Ctx& F0, int l, bool last) {
    const Ctx F = ctx_local(F0);
    const KAp ka = ka_opaque(); unsigned char* const ws = ka->ws;
    const bf16* ZIN = (const bf16*)(ws + WS_ZIN); bf16* YALL = (bf16*)(ws + WS_YALL); unsigned* FY2 = (unsigned*)(ws + WS_FY);
    const int nFAB = last ? 256 : 320, nConv = last ? 256 : 264;
    const float* wdw = ka->in[I_WDW] + (size_t)l * CONVW * DCONV; const float* bdw = ka->in[I_BDW] + (size_t)l * DCONV;
    const float* clg = ka->in[I_CLNG] + (size_t)l * DCONV; const float* clb = ka->in[I_CLNB] + (size_t)l * DCONV;
    for (int it = F.bx; it < nFAB + nConv; it += F.G) {
      const int reps = 1 + ((PROBE_MIXA == 2 && it < 256) || (PROBE_MIXA == 3 && it >= 256 && it < nFAB) || (PROBE_MIXA == 4 && it >= nFAB) ? 3 : 0);
      for (int rep = 0; rep < reps; ++rep) {
        int r = it;
        if (r < nFAB) { if (r < 256) fourAB_item_v3(F, ZIN, FY2, r & 15, (r >> 4) & 3, r >> 6); else { const int rr = r - 256; fourAB_ctx_v3(F, ZIN, FY2 + FY2_CTX, rr & 15, rr >> 4); } continue; }
        r -= nFAB;
        { const bool cx = r >= 256; conv_item_v1(F, ZIN, YALL, wdw, bdw, clg, clb, cx ? SEQ : 0, cx ? CTX : SEQ, (cx ? r - 256 : r) * 32); }
      }
    }
    const float* rpb = ka->in[I_RPB] + (size_t)l * NH * (2 * WIN_R - 1) * (2 * WIN_C - 1);
    const int nA = (NROWS / 2) * NH + (last ? 0 : (CTX / 128) * NH);
    for (int k = 0; k * F.G < nA; ++k) { const int rem = nA - k * F.G; const int it = k * F.G + (rem >= F.G ? F.bx : (F.bx + rem) % F.G);
        if (it >= nA) break;
        const int head = it & 7, qi = it >> 3;
        attn_item_v3(F, ZIN, YALL, rpb, qi < NROWS / 2 ? qi * 2 * GRID_W : SEQ + (qi - NROWS / 2) * 128, head); }
}
__device__ __forceinline__ void four_stageC(const Ctx& F0, bool last) {
    const Ctx F = ctx_local(F0);
    const KAp ka = ka_opaque(); unsigned char* const ws = ka->ws;
    LAS v4u* CS = (LAS v4u*)(F.lds + RING_OFF + 2 * A3_BUF + 2048);
    fourC_table_v2(F, CS); __syncthreads();
    const int nFC = last ? 2048 : 2048 + 64;
    for (int q = F.gw; q < nFC; q += F.NGW) { const unsigned* FY2 = (const unsigned*)(ws + WS_FY);
        if (q < 2048) fourC_item_v2(FY2, (bf16*)(ws + WS_YALL), CS, 0, NROWS, q >> 4, (q >> 2) & 3, q & 3, F.lane);
        else { const int qq = q - 2048; fourC_item_v2(FY2 + FY2_CTX, (bf16*)(ws + WS_YALL), CS, SEQ, CTX / GRID_W, qq >> 4, (qq >> 2) & 3, qq & 3, F.lane); } }
    __syncthreads();
}
__device__ __forceinline__ void site_gate(const Ctx& F, int l, bool last) {
    four_stageC(F, last);
    const KAp ka = ka_opaque(); unsigned char* const ws = ka->ws; unsigned char* wl = ws + WS_W + (size_t)l * WL_SIZE;
    pg8::Gemm g{(const bf16*)(ws + WS_H), (const bf16*)(wl + WL_WG), 0, 0, DM, DM}; pg8::StaticOrder S; S.init(32, 3 * DM / 256, F.G, F.bx, DM / 64);
    pg8::EpiBf16<1> E{(bf16*)(ws + WS_GATES), 3 * DM, ka->in[I_BGATE] + (size_t)l * 3 * DM, nullptr, 0};
    pg8::gemm_phase<pg8::EpiBf16<1>, pg8::StaticOrder, true, true>(F.lds + RING_OFF, g, S, E, F.wave);
}
__device__ __forceinline__ void site_branch(const Ctx& F, int l, bool last) {
    const KAp ka = ka_opaque(); unsigned char* const ws = ka->ws; unsigned char* wl = ws + WS_W + (size_t)l * WL_SIZE;
    pg8::Gemm g{(const bf16*)(ws + WS_YALL), (const bf16*)(wl + WL_WB), 0, 0, DM, DM}; pg8::StaticOrder S; S.init(last ? 32 : 33, DM / 256, F.G, F.bx, DM / 64);
    pg8::EpiBranch E{(bf16*)(ws + WS_MB), DM, (const bf16*)(ws + WS_GATES), 3 * DM};
    pg8::gemm_phase<pg8::EpiBranch, pg8::StaticOrder, true, true>(F.lds + RING_OFF, g, S, E, F.wave);
    if (l == 0) helper_convert(F, (33 * (DM / 256)) % F.G, 1, 6 * TI_FF, TI_LAYER - 6 * TI_FF, 0, 3 * TI_FF, 2 * TI_FF);
}
__device__ __forceinline__ void site_o(const Ctx& F, int l, bool last) {
    const KAp ka = ka_opaque(); unsigned char* const ws = ka->ws; unsigned char* wl = ws + WS_W + (size_t)l * WL_SIZE;
    const bf16* Mb = (const bf16*)(ws + WS_MB); const bf16* Wo = (const bf16*)(wl + WL_WO);
    pg8::Gemm g{Mb, Wo, 0, 0, DM, DM};
    pg8::OrderPlus S; S.base.init(32, DM / 256, F.G, F.bx, DM / 64); S.ext.init(last ? 0 : 1, DM / 256, F.G, F.bx, 0); S.chunks = CTXK_O; S.ntc = DM / 64 / CTXK_O; S.pmx = 32;
    pg8::EpiDelta E{(bf16*)(ws + WS_T), DM, mod_vec(ws, l, 0, 5), mod_vec(ws, l, 1, 5), 1.0f, (long)((WS_PART - WS_T) / 2)};
    pg8::gemm_phase<pg8::EpiDelta, pg8::OrderPlus, true, true>(F.lds + RING_OFF, g, S, E, F.wave);
}

__global__ void __launch_bounds__(NWAVES * 64, 2) mk_fwd(Args args) {
    extern __shared__ __attribute__((aligned(16))) unsigned char lds[];
    Ctx F;
    F.lds = (LAS unsigned char*)lds; F.tid = -1; F.lane = -1; F.wave = __builtin_amdgcn_readfirstlane(threadIdx.x >> 6);
    F.bx = blockIdx.x; F.G = gridDim.x; F.gw = F.bx * NWAVES + F.wave; F.NGW = F.G * NWAVES;
    volatile LAS unsigned* MISC = (volatile LAS unsigned*)(F.lds + MISC_OFF);
    for (int u = threadIdx.x; u < (LDS_BYTES - LDSCTL_OFF) / 4; u += NWAVES * 64) ((LAS unsigned*)(F.lds + LDSCTL_OFF))[u] = 0u;
    __syncthreads();
    unsigned* barw = (unsigned*)(args.ws + WS_CTL) + CW_BAR;
    XcdBarrier bar; bar.bar = barw; bar.x = 0; bar.st = nullptr; bar.wave = F.wave;
    if (args.use_bar) bar = xcd_barrier_post(barw, MISC + 8);
    const int lo = args.ph_lo, hi = args.ph_hi;
#define IN(k) (lo <= (k) && (k) < hi)
#define SEAM(k) do { if (IN(k) && IN((k) + 1)) xcd_barrier(bar); } while (0)
#if MK_STAMP
    unsigned long long t_prev = __builtin_amdgcn_s_memrealtime(), t_cat0 = 0, t_cat1 = 0, t_cat2 = 0, t_cat3 = 0, t_cat4 = 0;
#define STAMP(cat) do { const unsigned long long t_now = __builtin_amdgcn_s_memrealtime(); t_cat##cat += t_now - t_prev; t_prev = t_now; } while (0)
#else
#define STAMP(cat) do { } while (0)
#endif

    for (int rp = 0; rp < REPN(0); ++rp) { if (rp) xcd_barrier(bar); if (PH_ON(0)) { if (IN(0)) p0_prologue(ctx_local(F)); } }
    SEAM(0); STAMP(4);
    for (int rp = 0; rp < REPN(1); ++rp) { if (rp) xcd_barrier(bar); if (PH_ON(1)) { if (IN(1)) p1_prologue(ctx_local(F)); } }
    SEAM(1); STAMP(4);

    for (int hl = 0; hl < 2 * DEPTH; ++hl) {
        const int l = hl >> 1, f = hl & 1; const bool last = (l == DEPTH - 1);
        const int pb = 2 + 3 * hl + 7 * ((hl + 1) >> 1);
        const int nMf = (last && f == 1) ? 32 : 33;
        for (int rp = 0; rp < REPN(2); ++rp) { if (rp) xcd_barrier(bar); if (PH_ON(2)) { if (IN(pb + 0)) site_up(F, l, f, nMf); } }
        SEAM(pb + 0); STAMP(0);
        for (int rp = 0; rp < REPN(3); ++rp) { if (rp) xcd_barrier(bar); if (PH_ON(3)) { if (IN(pb + 1)) site_down(F, l, f, nMf); } }
        SEAM(pb + 1); STAMP(0);
        for (int rp = 0; rp < REPN(4); ++rp) { if (rp) xcd_barrier(bar); if (PH_ON(4)) { if (IN(pb + 2)) site_ln(F, l, f == 0 ? 0 : 2, (rp || (last && f == 1)) ? SEQ : MTOT, last && f == 1); } }
        if (!(last && f == 1)) SEAM(pb + 2);
        STAMP(2);
        if (f == 1) continue;
        const int mb = pb + 3;
        for (int rp = 0; rp < REPN(5); ++rp) { if (rp) xcd_barrier(bar); if (PH_ON(5)) { if (IN(mb + 0)) site_in(F, l, last); } }
        SEAM(mb + 0); STAMP(0);
        for (int rp = 0; rp < REPN(6); ++rp) { if (rp) xcd_barrier(bar); if (PH_ON(6)) { if (IN(mb + 1)) site_mixA(F, l, last); } }
        SEAM(mb + 1); STAMP(1);
        for (int rp = 0; rp < REPN(7); ++rp) { if (rp) xcd_barrier(bar); if (PH_ON(7)) { if (IN(mb + 3)) site_gate(F, l, last); } }
        SEAM(mb + 3); STAMP(0);
        for (int rp = 0; rp < REPN(8); ++rp) { if (rp) xcd_barrier(bar); if (PH_ON(8)) { if (IN(mb + 4)) site_branch(F, l, last); } }
        SEAM(mb + 4); STAMP(0);
        for (int rp = 0; rp < REPN(9); ++rp) { if (rp) xcd_barrier(bar); if (PH_ON(9)) { if (IN(mb + 5)) site_o(F, l, last); } }
        SEAM(mb + 5); STAMP(0);
        for (int rp = 0; rp < REPN(10); ++rp) { if (rp) xcd_barrier(bar); if (PH_ON(10)) { if (IN(mb + 6)) site_ln(F, l, 1, (rp || last) ? SEQ : MTOT, false); } }
        SEAM(mb + 6); STAMP(2);
    }
    for (int eb = 0; eb < PROBE_EXTRA_BARRIERS; ++eb) xcd_barrier(bar);
#if MK_STAMP
    if (F.bx == 0 && threadIdx.x == 0) { const KAp ka = ka_opaque(); float* o = ka->out;
#define QZ(t) (1000.0f * 0.01f * exp2f(rintf(log2f((float)(t) + 1.0f) * 6.0f) / 6.0f))
        const float a0 = QZ(t_cat0), a1 = QZ(t_cat1), a2 = QZ(t_cat2), a3 = QZ(t_cat3), a4 = QZ(t_cat4);
        if (MK_STAMP == 1) { o[0] = a1; o[1] = a3; } else if (MK_STAMP == 2) { o[0] = a4; o[1] = a2; } else { o[0] = a0; o[1] = 0.f; } }

#endif
#undef IN
#undef SEAM
}

extern "C" void kernel_launch(void* const* d_in, const int* in_sizes, int n_in, void* d_out, int out_size, void* d_ws, size_t ws_size, hipStream_t stream) {
    static int grid = 0;
    if (grid == 0) {
        if (n_in != N_IN || in_sizes[0] != SEQ * DM || out_size != SEQ * DM || ws_size < WS_END) { fprintf(stderr, "kernel_launch: unexpected shapes (n_in %d, in0 %d, out %d, ws %zu); nothing launched\n", n_in, n_in > 0 ? in_sizes[0] : -1, out_size, ws_size); grid = -1; return; }
        int dev = 0, cus = 0, per_cu = 0;
        if (hipGetDevice(&dev) != hipSuccess || hipDeviceGetAttribute(&cus, hipDeviceAttributeMultiprocessorCount, dev) != hipSuccess) { grid = -1; return; }
        if (hipFuncSetAttribute((const void*)mk_fwd, hipFuncAttributeMaxDynamicSharedMemorySize, LDS_BYTES) != hipSuccess) { fprintf(stderr, "kernel_launch: hipFuncSetAttribute failed\n"); grid = -1; return; }
        if (hipOccupancyMaxActiveBlocksPerMultiprocessor(&per_cu, (const void*)mk_fwd, NWAVES * 64, LDS_BYTES) != hipSuccess || per_cu < 1) fprintf(stderr, "kernel_launch: note: occupancy query reports %d\n", per_cu);
        (void)hipGetLastError();
        grid = cus;
    }
    if (grid < 0) return;
    if (hipMemsetAsync((char*)d_ws + WS_CTL, 0, CTL_ZERO_BYTES, stream) != hipSuccess) return;
    Args a{};
    for (int i = 0; i < N_IN; ++i) a.in[i] = (const float*)d_in[i];
    a.out = (float*)d_out; a.ws = (unsigned char*)d_ws; a.pad = 0;
#if MK_PER_PHASE
    for (int k = 0; k < N_PHASES; ++k) { a.ph_lo = k; a.ph_hi = k + 1; a.use_bar = 0; hipLaunchKernelGGL(mk_fwd, dim3(grid), dim3(NWAVES * 64), LDS_BYTES, stream, a);
#if MK_DIAG
        const int id = 2 * k + 4;
        if (k == 0) hipLaunchKernelGGL(dg_trans, dim3(4096), dim3(256), 0, stream, a, id, 0, 0xFDBu);
        else if (k == 1) hipLaunchKernelGGL(dg_mod, dim3(1024), dim3(256), 0, stream, a, id);
        else for (int hl = 0; hl < 2 * DEPTH; ++hl) { const int pb = 2 + 3 * hl + 7 * ((hl + 1) >> 1), l = hl >> 1, f = hl & 1; const bool last = l == DEPTH - 1;
            const int nMf = (last && f == 1) ? 32 : 33, nMm = last ? 32 : 33; int type = -1;
            if (k >= pb && k <= pb + 2) type = k - pb; else if (f == 0 && k >= pb + 3 && k <= pb + 9) type = k - pb;
            if (type == 0) hipLaunchKernelGGL(dg_gemm, dim3(2048), dim3(256), 0, stream, a, 0, l, f, nMf * 256, id, 0.f, 0);
            if (type == 0 && hl == 0 && DIAG_PREC == 1) hipLaunchKernelGGL(dg_prec_up, dim3(512), dim3(256), 0, stream, a);
            if (type == 1 && hl == 0 && DIAG_PREC == 2) hipLaunchKernelGGL(dg_prec_dn, dim3(512), dim3(256), 0, stream, a);
            if (type == 0 && hl == 1) hipLaunchKernelGGL(dg_trans, dim3(4096), dim3(256), 0, stream, a, id + 1, 0, 0x024u);
            if (type == 0 && hl == 3) hipLaunchKernelGGL(dg_trans, dim3(4096), dim3(256), 0, stream, a, id + 1, 1, 0xFFFu);
            if (type == 1) hipLaunchKernelGGL(dg_gemm, dim3(2048), dim3(256), 0, stream, a, 1, l, f, SEQ, id, 0.5f, f == 0 ? 2 : 5);
            if (type == 2) hipLaunchKernelGGL(dg_ln, dim3(512), dim3(256), 0, stream, a, l, f == 0 ? 0 : 2, SEQ, (last && f == 1) ? 1 : 0, id);
            if (type == 3) hipLaunchKernelGGL(dg_gemm, dim3(2048), dim3(256), 0, stream, a, 2, l, 0, MTOT, id, 0.f, 0);
            if (type == 4) hipLaunchKernelGGL(dg_conv, dim3(1024), dim3(256), 0, stream, a, l, last ? SEQ : MTOT, id + 1);
            if (type == 5) hipLaunchKernelGGL(dg_attn, dim3(1024), dim3(256), 0, stream, a, l, last ? SEQ : MTOT, id);
            if (type == 6) { hipLaunchKernelGGL(dg_gemm, dim3(2048), dim3(256), 0, stream, a, 3, l, 0, nMm * 256, id, 0.f, 0); hipLaunchKernelGGL(dg_four, dim3(64), dim3(256), 0, stream, a, last ? SEQ : MTOT, id + 1); }
            if (type == 7) hipLaunchKernelGGL(dg_gemm, dim3(2048), dim3(256), 0, stream, a, 4, l, 0, nMm * 256, id, 0.f, 0);
            if (type == 8) hipLaunchKernelGGL(dg_gemm, dim3(2048), dim3(256), 0, stream, a, 1, l, 0, SEQ, id, 1.0f, 5);
            if (type == 8 && l == 0 && DIAG_PREC == 4) hipLaunchKernelGGL(dg_prec_mix, dim3(256), dim3(256), 0, stream, a);
            if (type == 9) hipLaunchKernelGGL(dg_ln, dim3(512), dim3(256), 0, stream, a, l, 1, SEQ, 0, id);
        }
#endif
    }
#if MK_DIAG
    hipLaunchKernelGGL(dg_final, dim3(1), dim3(1), 0, stream, a);
#endif
#else
    a.ph_lo = 0; a.ph_hi = N_PHASES; a.use_bar = 1;
    hipLaunchKernelGGL(mk_fwd, dim3(grid), dim3(NWAVES * 64), LDS_BYTES, stream, a);
#endif
    const hipError_t le = hipPeekAtLastError();
    if (le != hipSuccess) fprintf(stderr, "kernel_launch: launch failed: %s\n", hipGetErrorName(le));
}
```
